# Optimizing an MI355X kernel written in HIP

```python
import jax, jax.numpy as jnp
from jax import lax
import numpy as np

D_MODEL = 1024
BATCH = 16
SEQ = 2048
DEPTH = 2
DEC_BATCH = 1
DEC_SEQ = 16384
PAST_LEN = 128

N_MIXERS = 2
D_FF = 2816
PLE_DIM = 256
NORM_EPS = 1e-6
RW_HEAD = 64
RW_HEADS = D_MODEL // RW_HEAD
RW_DECAY_LORA = 64
RW_ICLR_LORA = 64
RW_GATE_LORA = 128
RW_LNX_EPS = 64e-5
NA_HEAD = 32
NA_HEADS = D_MODEL // NA_HEAD
GRID_W = 64
NA_KH_MAX = 8
NA_KW = 16
NA_QB = 16
NA_KVB = NA_QB + NA_KW
N_RWKV = (DEPTH + 1) // 2
N_NA = DEPTH // 2

kernel_name = 'hybrid_rwkv7_natten_macaron_encoder'


def rms_norm(x, gain):
    xf = x.astype(jnp.float32)
    y = xf * lax.rsqrt(jnp.mean(xf * xf, axis=-1, keepdims=True) + NORM_EPS)
    return (y * gain.astype(jnp.float32)).astype(x.dtype)


def swiglu(x, w_in, w_out):
    gate, up = jnp.split(x @ w_in, 2, axis=-1)
    return (jax.nn.silu(gate) * up) @ w_out


def _heads(t):
    return t.reshape(t.shape[:-1] + (RW_HEADS, RW_HEAD)).astype(jnp.float32)


def rwkv7_bidir_scan(r, w, k, v, kk, a):
    def step(s, inp):
        r_t, w_t, k_t, v_t, kk_t, a_t = inp
        s_kk = jnp.einsum('zbhvk,zbhk->zbhv', s, kk_t)
        s = (s * w_t[..., None, :]
             - s_kk[..., :, None] * (kk_t * a_t)[..., None, :]
             + v_t[..., :, None] * k_t[..., None, :])
        return s, jnp.einsum('zbhvk,zbhk->zbhv', s, r_t)
    xs = tuple(jnp.moveaxis(t, 2, 0) for t in (r, w, k, v, kk, a))
    z, b, _, h, n = r.shape
    s0 = jnp.zeros((z, b, h, n, n), jnp.float32)
    _, y = lax.scan(step, s0, xs)
    return jnp.moveaxis(y, 0, 2)


def rwkv7_time_mix(x, mu, w_rkv, w0, w1, w2, a0, a1, a2, g1, g2, k_k, k_a, r_k, lnx_w, lnx_b, w_o):
    bsz, seq, d = x.shape
    f32 = jnp.float32
    prev = jnp.pad(x[:, :-1], ((0, 0), (1, 0), (0, 0)))
    nxt = jnp.pad(x[:, 1:], ((0, 0), (0, 1), (0, 0)))
    xm = x[None] + (0.5 * (prev + nxt) - x)[None] * mu[:, None, None, :]
    r, k, v = jnp.einsum('nbtd,nde->nbte', xm[:3], w_rkv)
    xw, xa, xg = xm[3], xm[4], xm[5]
    w_lora = jnp.einsum('zbtr,zrd->zbtd', jnp.tanh(jnp.einsum('btd,zdr->zbtr', xw, w1)), w2)
    log_w = -jax.nn.softplus(-(w0[:, None, None, :] + w_lora).astype(f32)) - 0.5
    decay = jnp.exp(-jnp.exp(log_w))
    a = jax.nn.sigmoid((a0[:, None, None, :]
                        + jnp.einsum('zbtr,zrd->zbtd', jnp.einsum('btd,zdr->zbtr', xa, a1), a2)).astype(f32))
    g = jax.nn.sigmoid(xg @ g1) @ g2
    kd = k.astype(f32)[None] * (1.0 + (a - 1.0) * k_a.astype(f32))
    kk = _heads(k * k_k)
    kk = kk * lax.rsqrt(jnp.maximum(jnp.sum(kk * kk, axis=-1, keepdims=True), 1e-24))
    rh, vh, kdh, ah, wh = _heads(r), _heads(v), _heads(kd), _heads(a), _heads(decay)
    both = lambda t: jnp.stack([t, jnp.flip(t, axis=1)])
    per_dir = lambda t: jnp.stack([t[0], jnp.flip(t[1], axis=1)])
    y = rwkv7_bidir_scan(both(rh), per_dir(wh), per_dir(kdh), both(vh), both(kk), per_dir(ah))
    y = y[0] + jnp.flip(y[1], axis=1)
    mean = jnp.mean(y, axis=-1, keepdims=True)
    var = jnp.mean(jnp.square(y - mean), axis=-1, keepdims=True)
    yn = (y - mean) * lax.rsqrt(var + RW_LNX_EPS)
    yn = yn * _heads(lnx_w) + _heads(lnx_b)
    bonus = jnp.sum(rh[None] * kdh * r_k.astype(f32), axis=(0, -1))[..., None] * vh
    out = (yn + bonus).reshape(bsz, seq, d).astype(x.dtype) * g
    return out @ w_o


def _na_column_layout():
    ncb = GRID_W // NA_QB
    q_cols = np.arange(ncb)[:, None] * NA_QB + np.arange(NA_QB)[None, :]
    kv_start = np.clip(np.arange(ncb) * NA_QB - NA_KW // 2, 0, GRID_W - NA_KVB)
    kv_cols = kv_start[:, None] + np.arange(NA_KVB)[None, :]
    win_start = np.clip(q_cols - NA_KW // 2, 0, GRID_W - NA_KW)
    kc = kv_cols[:, None, :]
    col_mask = (kc >= win_start[:, :, None]) & (kc < win_start[:, :, None] + NA_KW)
    col_idx = np.clip(kc - q_cols[:, :, None], -(NA_KW - 1), NA_KW - 1) + NA_KW - 1
    return kv_cols, col_mask, col_idx


def neighbourhood_attention(x, w_qkv, b_qkv, rpb, w_o, b_o):
    bsz, seq, d = x.shape
    rows = seq // GRID_W
    kh = min(NA_KH_MAX, rows)
    ncb = GRID_W // NA_QB
    kv_cols, col_mask, col_idx = _na_column_layout()
    q, k, v = jnp.split(x @ w_qkv + b_qkv, 3, axis=-1)
    grid = lambda t: t.reshape(bsz, rows, GRID_W, NA_HEADS, NA_HEAD)
    q, k, v = grid(q) * (NA_HEAD ** -0.5), grid(k), grid(v)
    rpb_c = rpb[:, :, col_idx]
    mask = col_mask[:, :, None, :]

    def row_block(i):
        rs = jnp.clip(i - kh // 2, 0, rows - kh)
        q_i = lax.dynamic_index_in_dim(q, i, axis=1, keepdims=False).reshape(bsz, ncb, NA_QB, NA_HEADS, NA_HEAD)
        k_i = lax.dynamic_slice_in_dim(k, rs, kh, axis=1)[:, :, kv_cols]
        v_i = lax.dynamic_slice_in_dim(v, rs, kh, axis=1)[:, :, kv_cols]
        s = jnp.einsum('bcqhd,brckhd->bhcqrk', q_i, k_i).astype(jnp.float32)
        row_idx = rs + jnp.arange(kh) - i + NA_KH_MAX - 1
        bias = jnp.transpose(rpb_c[:, row_idx], (0, 2, 3, 1, 4)).astype(jnp.float32)
        s = jnp.where(mask, s + bias, -1e30)
        pr = jax.nn.softmax(s.reshape(s.shape[:4] + (kh * NA_KVB,)), axis=-1).reshape(s.shape)
        o = jnp.einsum('bhcqrk,brckhd->bcqhd', pr.astype(v.dtype), v_i)
        return o.reshape(bsz, GRID_W, d)

    o = lax.map(row_block, jnp.arange(rows))
    o = jnp.moveaxis(o, 0, 1).reshape(bsz, seq, d)
    return o @ w_o + b_o


def encoder_trunk(x, p, prm):
    h = x
    for i in range(DEPTH):
        j = i // N_MIXERS
        h = h + 0.5 * swiglu(rms_norm(h, prm['ffn_norm'][i, 0]), prm['ffn_w_in'][i, 0], prm['ffn_w_out'][i, 0])
        hn = rms_norm(h, prm['mix_norm'][i])
        if i % N_MIXERS == 0:
            h = h + rwkv7_time_mix(hn, prm['rw_mu'][j], prm['rw_w_rkv'][j], prm['rw_w0'][j], prm['rw_w1'][j],
                                   prm['rw_w2'][j], prm['rw_a0'][j], prm['rw_a1'][j], prm['rw_a2'][j],
                                   prm['rw_g1'][j], prm['rw_g2'][j], prm['rw_k_k'][j], prm['rw_k_a'][j],
                                   prm['rw_r_k'][j], prm['rw_lnx_w'][j], prm['rw_lnx_b'][j], prm['rw_w_o'][j])
        else:
            h = h + neighbourhood_attention(hn, prm['na_w_qkv'][j], prm['na_b_qkv'][j], prm['na_rpb'][j],
                                            prm['na_w_o'][j], prm['na_b_o'][j])
        h = h + 0.5 * swiglu(rms_norm(h, prm['ffn_norm'][i, 1]), prm['ffn_w_in'][i, 1], prm['ffn_w_out'][i, 1])
        gate = jax.nn.sigmoid(rms_norm(h, prm['ple_norm'][i]) @ prm['ple_w_gate'][i])
        h = h + gate * (p[i] @ prm['ple_w_proj'][i])
    return rms_norm(h, prm['final_norm'])


def setup_inputs(seed: int = 0) -> dict:
    key = jax.random.key(seed)
    ks = iter(jax.random.split(key, 48))
    f32 = jnp.float32
    nrm = lambda shape, scale: jax.random.normal(next(ks), shape, f32) * scale
    uni = lambda shape, lo, hi: jax.random.uniform(next(ks), shape, f32, lo, hi)
    D = D_MODEL
    return {
        'x_prompt': nrm((BATCH, SEQ, D), 1.0),
        'x_sample': nrm((DEC_BATCH, DEC_SEQ, D), 1.0),
        'p_prompt': nrm((DEPTH, BATCH, SEQ, PLE_DIM), 1.0),
        'p_sample': nrm((DEPTH, DEC_BATCH, DEC_SEQ, PLE_DIM), 1.0),
        'ffn_norm': 1.0 + nrm((DEPTH, 2, D), 0.02),
        'ffn_w_in': nrm((DEPTH, 2, D, 2 * D_FF), D ** -0.5),
        'ffn_w_out': nrm((DEPTH, 2, D_FF, D), D_FF ** -0.5),
        'mix_norm': 1.0 + nrm((DEPTH, D), 0.02),
        'ple_norm': 1.0 + nrm((DEPTH, D), 0.02),
        'ple_w_gate': nrm((DEPTH, D, D), D ** -0.5),
        'ple_w_proj': nrm((DEPTH, PLE_DIM, D), PLE_DIM ** -0.5),
        'final_norm': 1.0 + nrm((D,), 0.02),
        'rw_mu': uni((N_RWKV, 6, D), 0.0, 1.0),
        'rw_w_rkv': nrm((N_RWKV, 3, D, D), D ** -0.5),
        'rw_w0': uni((N_RWKV, 2, D), -6.0, 1.0),
        'rw_w1': nrm((N_RWKV, 2, D, RW_DECAY_LORA), D ** -0.5),
        'rw_w2': nrm((N_RWKV, 2, RW_DECAY_LORA, D), 0.5 * RW_DECAY_LORA ** -0.5),
        'rw_a0': nrm((N_RWKV, 2, D), 0.5),
        'rw_a1': nrm((N_RWKV, 2, D, RW_ICLR_LORA), D ** -0.5),
        'rw_a2': nrm((N_RWKV, 2, RW_ICLR_LORA, D), 0.5 * RW_ICLR_LORA ** -0.5),
        'rw_g1': nrm((N_RWKV, D, RW_GATE_LORA), D ** -0.5),
        'rw_g2': nrm((N_RWKV, RW_GATE_LORA, D), RW_GATE_LORA ** -0.5),
        'rw_k_k': 1.0 + nrm((N_RWKV, D), 0.02),
        'rw_k_a': 1.0 + nrm((N_RWKV, D), 0.02),
        'rw_r_k': nrm((N_RWKV, RW_HEADS, RW_HEAD), 0.1),
        'rw_lnx_w': 1.0 + nrm((N_RWKV, D), 0.02),
        'rw_lnx_b': nrm((N_RWKV, D), 0.02),
        'rw_w_o': nrm((N_RWKV, D, D), D ** -0.5),
        'na_w_qkv': nrm((N_NA, D, 3 * D), D ** -0.5),
        'na_b_qkv': nrm((N_NA, 3 * D), 0.02),
        'na_rpb': nrm((N_NA, NA_HEADS, 2 * NA_KH_MAX - 1, 2 * NA_KW - 1), 0.1),
        'na_w_o': nrm((N_NA, D, D), D ** -0.5),
        'na_b_o': nrm((N_NA, D), 0.02),
    }


def reference(x_prompt, x_sample, p_prompt, p_sample, ffn_norm, ffn_w_in, ffn_w_out, mix_norm, ple_norm,
              ple_w_gate, ple_w_proj, final_norm, rw_mu, rw_w_rkv, rw_w0, rw_w1, rw_w2, rw_a0, rw_a1, rw_a2,
              rw_g1, rw_g2, rw_k_k, rw_k_a, rw_r_k, rw_lnx_w, rw_lnx_b, rw_w_o, na_w_qkv, na_b_qkv, na_rpb,
              na_w_o, na_b_o):
    prm = dict(ffn_norm=ffn_norm, ffn_w_in=ffn_w_in, ffn_w_out=ffn_w_out, mix_norm=mix_norm,
               ple_norm=ple_norm, ple_w_gate=ple_w_gate, ple_w_proj=ple_w_proj, final_norm=final_norm,
               rw_mu=rw_mu, rw_w_rkv=rw_w_rkv, rw_w0=rw_w0, rw_w1=rw_w1, rw_w2=rw_w2, rw_a0=rw_a0,
               rw_a1=rw_a1, rw_a2=rw_a2, rw_g1=rw_g1, rw_g2=rw_g2, rw_k_k=rw_k_k, rw_k_a=rw_k_a,
               rw_r_k=rw_r_k, rw_lnx_w=rw_lnx_w, rw_lnx_b=rw_lnx_b, rw_w_o=rw_w_o, na_w_qkv=na_w_qkv,
               na_b_qkv=na_b_qkv, na_rpb=na_rpb, na_w_o=na_w_o, na_b_o=na_b_o)
    y_prompt = encoder_trunk(x_prompt, p_prompt, prm)
    y_sample = encoder_trunk(x_sample, p_sample, prm)
    return (y_prompt, y_sample)
```

```cpp
#include <hip/hip_runtime.h>
#include <hip/hip_cooperative_groups.h>
#include <cstdio>
#include <cstdint>
namespace cg = cooperative_groups;

typedef unsigned short u16;
using bf16x8 = __attribute__((ext_vector_type(8))) short;
using f32x4 = __attribute__((ext_vector_type(4))) float;
using f32x2 = __attribute__((ext_vector_type(2))) float;
using i32x4 = __attribute__((ext_vector_type(4))) int;
typedef __attribute__((address_space(3))) char LDSC;
typedef __attribute__((address_space(3))) unsigned LDSU;
typedef __attribute__((address_space(3))) bf16x8 LDS_BF8;

constexpr int MT = 49152;
constexpr int MPROMPT = 32768;
constexpr int MR = MT;
constexpr int D = 1024;
constexpr int DFF = 2816;
constexpr int NTHR = 512;

constexpr size_t SZ_WIN = (size_t)5632 * 1024 * 2;
constexpr size_t SZ_WOUT = (size_t)1024 * 2816 * 2;
constexpr size_t OFF_WIN = 0;
constexpr size_t OFF_WOUT = OFF_WIN + 4 * SZ_WIN;
constexpr size_t OFF_WPG = OFF_WOUT + 4 * SZ_WOUT;
constexpr size_t OFF_WPP = OFF_WPG + 2 * (size_t)1024 * 1024 * 2;
constexpr size_t OFF_WRKV = OFF_WPP + 2 * (size_t)1024 * 256 * 2;
constexpr size_t OFF_W2W = OFF_WRKV + (size_t)3584 * 2048 * 2;
constexpr size_t OFF_W2A = OFF_W2W + 2 * (size_t)1024 * 64 * 2;
constexpr size_t OFF_WG2 = OFF_W2A + 2 * (size_t)1024 * 64 * 2;
constexpr size_t OFF_WRWO = OFF_WG2 + (size_t)1024 * 128 * 2;
constexpr size_t OFF_WQKV = OFF_WRWO + (size_t)1024 * 1024 * 2;
constexpr size_t OFF_WNAO = OFF_WQKV + (size_t)3072 * 1024 * 2;
constexpr size_t OFF_SS = OFF_WNAO + (size_t)1024 * 1024 * 2;
constexpr size_t OFF_BONUS = OFF_SS + 9 * (size_t)MT * 4;
constexpr size_t OFF_BAR = OFF_BONUS + 2 * (size_t)MR * 16 * 4;
constexpr size_t OFF_HB = OFF_BAR + 256;
constexpr size_t OFF_PBI = OFF_HB + (size_t)MT * 1024 * 2;
constexpr size_t OFF_BIG = OFF_PBI + (size_t)MT * 256 * 2;
constexpr size_t BIG_ACTB = 0;
constexpr size_t BIG_PB = 0;
constexpr size_t BIG_HBALT = (size_t)MT * 2816 * 2;
constexpr size_t BIG_A2 = 0;
constexpr size_t BIG_Y0 = 0;
constexpr size_t BIG_Y1 = (size_t)MR * 1024 * 2;
constexpr size_t BIG_RKV = (size_t)MR * 2048 * 2;
constexpr size_t SZ_RKV1 = (size_t)MR * 1024 * 2;
constexpr size_t BIG_T = BIG_RKV + 3 * SZ_RKV1;
constexpr size_t SZ_T1 = (size_t)MR * 128 * 2;
constexpr size_t BIG_Q = 0;
constexpr size_t BIG_K = (size_t)MT * 1024 * 2;
constexpr size_t BIG_VT = 2 * (size_t)MT * 1024 * 2;

struct Params {
  const float* in[33];
  float* h;
  char* ws;
};

__device__ __forceinline__ u16 f2bf(float f) {
  unsigned u = __float_as_uint(f);
  u += 0x7fffu + ((u >> 16) & 1u);
  return (u16)(u >> 16);
}
__device__ __forceinline__ float bf2f(u16 h) { return __uint_as_float(((unsigned)h) << 16); }
__device__ __forceinline__ unsigned pack2(float a, float b) { return (unsigned)f2bf(a) | ((unsigned)f2bf(b) << 16); }
__device__ __forceinline__ float sigm(float x) { return __builtin_amdgcn_rcpf(1.f + __expf(-x)); }
template <int CTRL> __device__ __forceinline__ float dppf(float v) {
  return __int_as_float(__builtin_amdgcn_update_dpp(0, __float_as_int(v), CTRL, 0xf, 0xf, true));
}
__device__ __forceinline__ float rowsum16(float v) {
  v += dppf<0xB1>(v);
  v += dppf<0x4E>(v);
  v += dppf<0x141>(v);
  v += dppf<0x140>(v);
  return v;
}
__device__ __forceinline__ int otid() { int t = __builtin_amdgcn_workitem_id_x(); asm volatile("" : "+v"(t)); return t; }
__device__ __forceinline__ float rstd_of(float ss) { return rsqrtf(ss * (1.f / 1024.f) + 1e-6f); }

struct PrepJob {
  const float* src; int K, N, ldsrc;
  u16* dst; int dld, koff, noff;
  const float* sc; int mode;
  int perm;
};

__device__ __forceinline__ void prep_tiles(const PrepJob& j, char* shm) {
  u16* tl = (u16*)shm;
  int kt = j.K >> 6, nt = j.N >> 6, tiles = kt * nt;
  int tid = otid();
  for (int t = blockIdx.x; t < tiles; t += gridDim.x) {
    int k0 = (t / nt) << 6, n0 = (t % nt) << 6;
#pragma unroll
    for (int it = 0; it < 2; ++it) {
      int kk = (tid >> 4) + 32 * it, nn4 = (tid & 15) * 4;
      float4 v = *(const float4*)(j.src + (size_t)(k0 + kk) * j.ldsrc + n0 + nn4);
      float s = 1.f;
      if (j.mode == 1 || j.mode == 3) s = j.sc[k0 + kk];
      else if (j.mode == 2) s = 1.f - j.sc[k0 + kk];
      tl[(nn4 + 0) * 72 + kk] = f2bf(v.x * s);
      tl[(nn4 + 1) * 72 + kk] = f2bf(v.y * s);
      tl[(nn4 + 2) * 72 + kk] = f2bf(v.z * s);
      tl[(nn4 + 3) * 72 + kk] = f2bf(v.w * s);
    }
    __syncthreads();
    {
      int nn = tid >> 3, kk8 = (tid & 7) * 8;
      int c = n0 + nn, drow;
      if (j.perm) { int half = c / DFF, cp = c % DFF; drow = (cp >> 5) * 64 + half * 32 + (cp & 31); }
      else drow = c;
      i32x4 v = *(const i32x4*)(tl + nn * 72 + kk8);
      *(i32x4*)(j.dst + (size_t)(j.noff + drow) * j.dld + j.koff + k0 + kk8) = v;
    }
    __syncthreads();
  }
}

__device__ __forceinline__ void phase_prep(const Params& p, char* shm) {
  char* ws = p.ws;
  for (int jj = 0; jj < 38; ++jj) {
    PrepJob j; j.mode = 0; j.sc = nullptr; j.perm = 0; j.koff = 0; j.noff = 0;
    if (jj < 4) {
      j.src = p.in[5] + (size_t)jj * 1024 * 5632; j.K = 1024; j.N = 5632; j.ldsrc = 5632;
      j.dst = (u16*)(ws + OFF_WIN + jj * SZ_WIN); j.dld = 1024; j.sc = p.in[4] + jj * 1024; j.mode = 1; j.perm = 1;
    } else if (jj < 8) {
      int q = jj - 4;
      j.src = p.in[6] + (size_t)q * 2816 * 1024; j.K = 2816; j.N = 1024; j.ldsrc = 1024;
      j.dst = (u16*)(ws + OFF_WOUT + q * SZ_WOUT); j.dld = 2816;
    } else if (jj < 10) {
      int q = jj - 8;
      j.src = p.in[9] + (size_t)q * 1024 * 1024; j.K = 1024; j.N = 1024; j.ldsrc = 1024;
      j.dst = (u16*)(ws + OFF_WPG) + (size_t)q * 1024 * 1024; j.dld = 1024; j.sc = p.in[8] + q * 1024; j.mode = 1;
    } else if (jj < 12) {
      int q = jj - 10;
      j.src = p.in[10] + (size_t)q * 256 * 1024; j.K = 256; j.N = 1024; j.ldsrc = 1024;
      j.dst = (u16*)(ws + OFF_WPP) + (size_t)q * 1024 * 256; j.dld = 256;
    } else if (jj < 28) {
      int q = (jj - 12) >> 1, hf = (jj - 12) & 1;
      j.K = 1024; j.dst = (u16*)(ws + OFF_WRKV); j.dld = 2048; j.koff = hf * 1024; j.mode = hf ? 3 : 2;
      if (q < 3) { j.src = p.in[13] + (size_t)q * 1024 * 1024; j.N = 1024; j.ldsrc = 1024; j.noff = q * 1024; j.sc = p.in[12] + q * 1024; }
      else if (q < 5) { int z = q - 3; j.src = p.in[15] + (size_t)z * 1024 * 64; j.N = 64; j.ldsrc = 64; j.noff = 3072 + z * 64; j.sc = p.in[12] + 3 * 1024; }
      else if (q < 7) { int z = q - 5; j.src = p.in[18] + (size_t)z * 1024 * 64; j.N = 64; j.ldsrc = 64; j.noff = 3200 + z * 64; j.sc = p.in[12] + 4 * 1024; }
      else { j.src = p.in[20]; j.N = 128; j.ldsrc = 128; j.noff = 3328; j.sc = p.in[12] + 5 * 1024; }
    } else if (jj < 30) {
      int z = jj - 28;
      j.src = p.in[16] + (size_t)z * 64 * 1024; j.K = 64; j.N = 1024; j.ldsrc = 1024;
      j.dst = (u16*)(ws + OFF_W2W) + (size_t)z * 1024 * 64; j.dld = 64;
    } else if (jj < 32) {
      int z = jj - 30;
      j.src = p.in[19] + (size_t)z * 64 * 1024; j.K = 64; j.N = 1024; j.ldsrc = 1024;
      j.dst = (u16*)(ws + OFF_W2A) + (size_t)z * 1024 * 64; j.dld = 64;
    } else if (jj == 32) {
      j.src = p.in[21]; j.K = 128; j.N = 1024; j.ldsrc = 1024; j.dst = (u16*)(ws + OFF_WG2); j.dld = 128;
    } else if (jj == 33) {
      j.src = p.in[27]; j.K = 1024; j.N = 1024; j.ldsrc = 1024; j.dst = (u16*)(ws + OFF_WRWO); j.dld = 1024;
    } else if (jj == 34) {
      j.src = p.in[28]; j.K = 1024; j.N = 3072; j.ldsrc = 3072; j.dst = (u16*)(ws + OFF_WQKV); j.dld = 1024; j.sc = p.in[7] + 1024; j.mode = 1;
    } else if (jj == 35) {
      j.src = p.in[31]; j.K = 1024; j.N = 1024; j.ldsrc = 1024; j.dst = (u16*)(ws + OFF_WNAO); j.dld = 1024;
    } else continue;
    prep_tiles(j, shm);
  }
  float* ss = (float*)(ws + OFF_SS);
  u16* hb = (u16*)(ws + OFF_HB);
  int tid = otid(), half = tid >> 8, t4 = (tid & 255) * 4;
  float* red = (float*)shm;
  for (int r0 = blockIdx.x * 2; r0 < MT; r0 += gridDim.x * 2) {
    int row = r0 + half;
    const float* src = row < MPROMPT ? p.in[0] + (size_t)row * D : p.in[1] + (size_t)(row - MPROMPT) * D;
    float4 v = *(const float4*)(src + t4);
    *(float4*)(p.h + (size_t)row * D + t4) = v;
    uint2 pk; pk.x = pack2(v.x, v.y); pk.y = pack2(v.z, v.w);
    *(uint2*)(hb + (size_t)row * D + t4) = pk;
    float s = v.x * v.x + v.y * v.y + v.z * v.z + v.w * v.w;
#pragma unroll
    for (int o = 32; o > 0; o >>= 1) s += __shfl_xor(s, o);
    __syncthreads();
    if ((tid & 63) == 0) red[tid >> 6] = s;
    __syncthreads();
    if ((tid & 255) == 0) {
      float tot = red[half * 4] + red[half * 4 + 1] + red[half * 4 + 2] + red[half * 4 + 3];
      ss[row] = tot;
#pragma unroll
      for (int q = 1; q < 9; ++q) ss[(size_t)q * MT + row] = 0.f;
    }
  }
}

__device__ __forceinline__ void conv_p(const Params& p, int layer) {
  u16* pbi = (u16*)(p.ws + OFF_PBI);
  const float* pp = p.in[2] + (size_t)layer * MPROMPT * 256;
  const float* ps = p.in[3] + (size_t)layer * (MT - MPROMPT) * 256;
  size_t n4 = (size_t)MT * 256 / 4;
  for (size_t i = (size_t)blockIdx.x * NTHR + otid(); i < n4; i += (size_t)gridDim.x * NTHR) {
    size_t e = i * 4;
    const float* s = e < (size_t)MPROMPT * 256 ? pp + e : ps + (e - (size_t)MPROMPT * 256);
    float4 v = *(const float4*)s;
    uint2 pk; pk.x = pack2(v.x, v.y); pk.y = pack2(v.z, v.w);
    *(uint2*)(pbi + e) = pk;
  }
}

__device__ __forceinline__ void conv_h(const Params& p) {
  u16* hb = (u16*)(p.ws + OFF_HB);
  size_t n4 = (size_t)MT * D / 4;
  for (size_t i = (size_t)blockIdx.x * NTHR + otid(); i < n4; i += (size_t)gridDim.x * NTHR) {
    float4 v = *(const float4*)(p.h + i * 4);
    uint2 pk; pk.x = pack2(v.x, v.y); pk.y = pack2(v.z, v.w);
    *(uint2*)(hb + i * 4) = pk;
  }
}

enum { E_SWIGLU = 0, E_RESID = 1, E_PLEPROJ = 2, E_PLEGATE = 3, E_RKV = 4, E_RWFIN = 5, E_QKV = 6 };

struct GA {
  const u16* A; const u16* Bt; int K; int N;
  int mtiles, ntiles;
  int rowoff;
  const float* ss_in; float* ss_out;
  const float* bias; float scale;
  float* h; u16* hb;
  u16* o0; u16* o1; u16* o2;
  const float* f0; const float* f1; const float* f2;
};

template <int KS> __device__ __forceinline__ int lds_byte(int r, int c) {
  int st = (r >> 4) * KS + (c >> 5), ob = (r & 15) * 64 + (c & 31) * 2;
  return st * 1024 + (ob ^ (((ob >> 9) & 1) << 5));
}
template <int KS> __device__ __forceinline__ void stage_rc(int b, int& R, int& C) {
  int st = b >> 10, sb = b & 1023, swz = sb ^ (((sb >> 9) & 1) << 5);
  R = (st / KS) * 16 + swz / 64;
  C = (st % KS) * 32 + (swz % 64) / 2;
}

template <int EPI>
__device__ __forceinline__ void gemm_tile(const GA& g, int pm, int pn, bool prefetched, bool has_next, int pm_next, int pn_next, LDSC* shm) {
  constexpr int BK = 64, KS = 2, TILE_B = 256 * BK * 2, GL = 4, STAGE_B = 2 * TILE_B;
  const int K = g.K;
  const int tid = otid(), wid = tid >> 6, lane = tid & 63, wr = wid >> 2, wc = wid & 3, fr = lane & 15, fq = lane >> 4;
  const int brow = pm * 256, bcol = pn * 256;
  const u16* Ab = g.A + (size_t)brow * K;
  const u16* Bb = g.Bt + (size_t)bcol * K;
  const u16* Abn = g.A + (size_t)(pm_next * 256) * K;
  const u16* Bbn = g.Bt + (size_t)(pn_next * 256) * K;
  int sO[GL];
#pragma unroll
  for (int i = 0; i < GL; ++i) { int r_, c_; stage_rc<KS>(wid * 1024 + i * 8192 + lane * 16, r_, c_); sO[i] = r_ * K + c_; }
  f32x4 acc[8][4];
#pragma unroll
  for (int m = 0; m < 8; ++m)
#pragma unroll
    for (int n = 0; n < 4; ++n) acc[m][n] = f32x4{0.f, 0.f, 0.f, 0.f};
  const int nt = K / BK;
#define G_STAGE(buf, AB_, BB_, kt) do { _Pragma("unroll") for (int i = 0; i < GL; ++i) { \
    __builtin_amdgcn_global_load_lds((const unsigned*)((AB_) + (kt) * BK + sO[i]), (LDSU*)(shm + (buf) * STAGE_B + wid * 1024 + i * 8192), 16, 0, 0); \
    __builtin_amdgcn_global_load_lds((const unsigned*)((BB_) + (kt) * BK + sO[i]), (LDSU*)(shm + (buf) * STAGE_B + TILE_B + wid * 1024 + i * 8192), 16, 0, 0); } } while (0)
#define G_STAGE_H(hh, buf, AB_, BB_, kt) do { _Pragma("unroll") for (int i = (hh) * 2; i < (hh) * 2 + 2; ++i) { \
    __builtin_amdgcn_global_load_lds((const unsigned*)((AB_) + (kt) * BK + sO[i]), (LDSU*)(shm + (buf) * STAGE_B + wid * 1024 + i * 8192), 16, 0, 0); \
    __builtin_amdgcn_global_load_lds((const unsigned*)((BB_) + (kt) * BK + sO[i]), (LDSU*)(shm + (buf) * STAGE_B + TILE_B + wid * 1024 + i * 8192), 16, 0, 0); } } while (0)
  if (!prefetched) G_STAGE(0, Ab, Bb, 0);
  asm volatile("s_waitcnt vmcnt(0)" ::: "memory");
  __syncthreads();
  for (int t = 0; t < nt; ++t) {
    int cur = t & 1;
    if (t + 1 < nt) G_STAGE_H(0, cur ^ 1, Ab, Bb, t + 1);
    else if (has_next) G_STAGE_H(0, 0, Abn, Bbn, 0);
    const LDSC* SAp = shm + cur * STAGE_B;
    const LDSC* SBp = SAp + TILE_B;
#pragma unroll
    for (int ks = 0; ks < KS; ++ks) {
      if (ks == 1) {
        if (t + 1 < nt) G_STAGE_H(1, cur ^ 1, Ab, Bb, t + 1);
        else if (has_next) G_STAGE_H(1, 0, Abn, Bbn, 0);
      }
      bf16x8 At[8], Bf[4];
#pragma unroll
      for (int m = 0; m < 8; ++m) At[m] = *(const LDS_BF8*)(SAp + lds_byte<KS>(wr * 128 + m * 16 + fr, ks * 32 + fq * 8));
#pragma unroll
      for (int n = 0; n < 4; ++n) Bf[n] = *(const LDS_BF8*)(SBp + lds_byte<KS>(wc * 64 + n * 16 + fr, ks * 32 + fq * 8));
      __builtin_amdgcn_s_setprio(1);
#pragma unroll
      for (int m = 0; m < 8; ++m)
#pragma unroll
        for (int n = 0; n < 4; ++n) acc[m][n] = __builtin_amdgcn_mfma_f32_16x16x32_bf16(At[m], Bf[n], acc[m][n], 0, 0, 0);
      __builtin_amdgcn_s_setprio(0);
      __builtin_amdgcn_sched_barrier(0);
    }
    if (t + 1 < nt) asm volatile("s_waitcnt vmcnt(0)" ::: "memory");
    __syncthreads();
  }
#undef G_STAGE
#undef G_STAGE_H
  typedef __attribute__((address_space(3))) float LDSF;
  typedef __attribute__((address_space(3))) f32x4 LDSF4;
  LDSF* scr = (LDSF*)(shm + STAGE_B + wid * 4352);
  const int cb = bcol + wc * 64;
#define SLAB_WRITE(m) do { _Pragma("unroll") for (int n = 0; n < 4; ++n) _Pragma("unroll") for (int j = 0; j < 4; ++j) \
    scr[(fq * 4 + j) * 68 + n * 16 + fr] = acc[m][n][j]; asm volatile("s_waitcnt lgkmcnt(0)" ::: "memory"); } while (0)
#define SLAB_DONE() asm volatile("s_waitcnt lgkmcnt(0)" ::: "memory")
  if constexpr (EPI == E_SWIGLU) {
    const int l8 = lane & 7, r8 = lane >> 3;
#pragma unroll
    for (int m = 0; m < 8; ++m) {
      SLAB_WRITE(m);
#pragma unroll
      for (int k = 0; k < 2; ++k) {
        int rl = k * 8 + r8, row = brow + wr * 128 + m * 16 + rl;
        f32x4 gt = *(const LDSF4*)(scr + rl * 68 + l8 * 4), up = *(const LDSF4*)(scr + rl * 68 + 32 + l8 * 4);
        float rs = rstd_of(g.ss_in[g.rowoff + row]);
        float o[4];
#pragma unroll
        for (int e = 0; e < 4; ++e) { float a = gt[e] * rs; o[e] = a * sigm(a) * (up[e] * rs); }
        uint2 pk; pk.x = pack2(o[0], o[1]); pk.y = pack2(o[2], o[3]);
        *(uint2*)(g.o0 + (size_t)row * DFF + (cb >> 1) + l8 * 4) = pk;
      }
      SLAB_DONE();
    }
  } else if constexpr (EPI == E_QKV) {
    const int which = cb >> 10, c0 = cb & 1023;
    if (which == 2) {
#pragma unroll
      for (int m = 0; m < 8; ++m) {
        int row0 = brow + wr * 128 + m * 16 + fq * 4;
        float rs[4];
#pragma unroll
        for (int j = 0; j < 4; ++j) rs[j] = rstd_of(g.ss_in[row0 + j]);
#pragma unroll
        for (int n = 0; n < 4; ++n) {
          int col = c0 + n * 16 + fr;
          float b = g.bias[cb + n * 16 + fr];
          uint2 pk; pk.x = pack2(acc[m][n][0] * rs[0] + b, acc[m][n][1] * rs[1] + b); pk.y = pack2(acc[m][n][2] * rs[2] + b, acc[m][n][3] * rs[3] + b);
          *(uint2*)(g.o2 + (size_t)col * MT + row0) = pk;
        }
      }
    } else {
      u16* dst = which == 0 ? g.o0 : g.o1;
      const float sc = which == 0 ? 0.17677669529663687f : 1.f;
      f32x4 b4 = *(const f32x4*)(g.bias + cb + fr * 4);
#pragma unroll
      for (int m = 0; m < 8; ++m) {
        SLAB_WRITE(m);
#pragma unroll
        for (int k = 0; k < 4; ++k) {
          int rl = k * 4 + fq, row = brow + wr * 128 + m * 16 + rl;
          f32x4 v = *(const LDSF4*)(scr + rl * 68 + fr * 4);
          float rs = rstd_of(g.ss_in[row]);
          uint2 pk; pk.x = pack2((v[0] * rs + b4[0]) * sc, (v[1] * rs + b4[1]) * sc); pk.y = pack2((v[2] * rs + b4[2]) * sc, (v[3] * rs + b4[3]) * sc);
          *(uint2*)(dst + (size_t)row * D + c0 + fr * 4) = pk;
        }
        SLAB_DONE();
      }
    }
  } else {
    float lw[4] = {0.f, 0.f, 0.f, 0.f}, lb[4] = {0.f, 0.f, 0.f, 0.f}, bs[4] = {0.f, 0.f, 0.f, 0.f};
    if constexpr (EPI == E_RWFIN) {
#pragma unroll
      for (int e = 0; e < 4; ++e) { lw[e] = g.f1[cb + fr * 4 + e]; lb[e] = g.f2[cb + fr * 4 + e]; }
    }
    if constexpr (EPI == E_RESID) {
      if (g.bias) {
#pragma unroll
        for (int e = 0; e < 4; ++e) bs[e] = g.bias[cb + fr * 4 + e];
      }
    }
    f32x4 h_n[4]; uint2 a_n[4]; float f_n[4][2];
#define EPI_LOAD(m_) do { _Pragma("unroll") for (int k = 0; k < 4; ++k) { \
      const int row_ = brow + wr * 128 + (m_) * 16 + k * 4 + fq, col_ = cb + fr * 4; \
      if constexpr (EPI == E_RESID || EPI == E_PLEGATE) h_n[k] = *(const f32x4*)(g.h + (size_t)(g.rowoff + row_) * D + col_); \
      if constexpr (EPI == E_PLEGATE) { a_n[k] = *(const uint2*)(g.o0 + (size_t)(g.rowoff + row_) * D + col_); f_n[k][0] = g.ss_in[g.rowoff + row_]; } \
      } } while (0)
    f32x4 h_m[4]; uint2 a_m[4]; float f_m[4][2];
    EPI_LOAD(0);
#pragma unroll
    for (int k = 0; k < 4; ++k) { h_m[k] = h_n[k]; a_m[k] = a_n[k]; f_m[k][0] = f_n[k][0]; }
    EPI_LOAD(1);
#pragma unroll
    for (int m = 0; m < 8; ++m) {
      f32x4 h_c[4]; uint2 a_c[4]; float f_c[4][2];
#pragma unroll
      for (int k = 0; k < 4; ++k) { h_c[k] = h_m[k]; a_c[k] = a_m[k]; f_c[k][0] = f_m[k][0];
                                    h_m[k] = h_n[k]; a_m[k] = a_n[k]; f_m[k][0] = f_n[k][0]; }
      if (m + 2 < 8) EPI_LOAD(m + 2);
      SLAB_WRITE(m);
#pragma unroll
      for (int k = 0; k < 4; ++k) {
        const int rl = k * 4 + fq, row = brow + wr * 128 + m * 16 + rl;
        const int col = cb + fr * 4;
        f32x4 v = *(const LDSF4*)(scr + rl * 68 + fr * 4);
        if constexpr (EPI == E_RESID || EPI == E_PLEGATE) {
          size_t grow = (size_t)(g.rowoff + row);
          float* hp = g.h + grow * D + col;
          f32x4 hv = h_c[k];
          if constexpr (EPI == E_PLEGATE) {
            float rs = rstd_of(f_c[k][0]);
            uint2 pb = a_c[k];
            hv[0] += sigm(v[0] * rs) * bf2f((u16)(pb.x & 0xffff));
            hv[1] += sigm(v[1] * rs) * bf2f((u16)(pb.x >> 16));
            hv[2] += sigm(v[2] * rs) * bf2f((u16)(pb.y & 0xffff));
            hv[3] += sigm(v[3] * rs) * bf2f((u16)(pb.y >> 16));
          } else {
#pragma unroll
            for (int e = 0; e < 4; ++e) hv[e] += g.scale * v[e] + bs[e];
          }
          *(f32x4*)hp = hv;
          if (g.hb != nullptr) {
            uint2 pk; pk.x = pack2(hv[0], hv[1]); pk.y = pack2(hv[2], hv[3]);
            *(uint2*)(g.hb + grow * D + col) = pk;
          }
          float sq = rowsum16(hv[0] * hv[0] + hv[1] * hv[1] + hv[2] * hv[2] + hv[3] * hv[3]);
          if (fr == 0) atomicAdd(g.ss_out + grow, sq);
        } else if constexpr (EPI == E_PLEPROJ) {
          uint2 pk; pk.x = pack2(v[0], v[1]); pk.y = pack2(v[2], v[3]);
          *(uint2*)(g.o0 + (size_t)row * D + col) = pk;
        } else if constexpr (EPI == E_RKV) {
          if (cb < 3072) {
            u16* buf = g.o0 + (size_t)(cb >> 10) * ((size_t)MR * 1024);
            uint2 pk; pk.x = pack2(v[0], v[1]); pk.y = pack2(v[2], v[3]);
            *(uint2*)(buf + (size_t)row * D + (cb & 1023) + fr * 4) = pk;
          } else if (cb < 3456) {
            int which = (cb - 3072) >> 7, c0 = (cb - 3072) & 127;
            u16* buf = g.o1 + (size_t)which * ((size_t)MR * 128);
            if (which == 0) { v[0] = tanhf(v[0]); v[1] = tanhf(v[1]); v[2] = tanhf(v[2]); v[3] = tanhf(v[3]); }
            else if (which == 2) { v[0] = sigm(v[0]); v[1] = sigm(v[1]); v[2] = sigm(v[2]); v[3] = sigm(v[3]); }
            uint2 pk; pk.x = pack2(v[0], v[1]); pk.y = pack2(v[2], v[3]);
            *(uint2*)(buf + (size_t)row * 128 + c0 + fr * 4) = pk;
          }
        } else if constexpr (EPI == E_RWFIN) {
          const int head = cb >> 6;
          size_t idx = (size_t)row * D + col;
          uint2 a0 = *(const uint2*)(g.o0 + idx), a1 = *(const uint2*)(g.o1 + idx), vv = *(const uint2*)(g.o2 + idx);
          float y[4];
          y[0] = bf2f((u16)(a0.x & 0xffff)) + bf2f((u16)(a1.x & 0xffff));
          y[1] = bf2f((u16)(a0.x >> 16)) + bf2f((u16)(a1.x >> 16));
          y[2] = bf2f((u16)(a0.y & 0xffff)) + bf2f((u16)(a1.y & 0xffff));
          y[3] = bf2f((u16)(a0.y >> 16)) + bf2f((u16)(a1.y >> 16));
          float mean = rowsum16(y[0] + y[1] + y[2] + y[3]) * (1.f / 64.f);
#pragma unroll
          for (int e = 0; e < 4; ++e) y[e] -= mean;
          float inv = rsqrtf(rowsum16(y[0] * y[0] + y[1] * y[1] + y[2] * y[2] + y[3] * y[3]) * (1.f / 64.f) + 64e-5f);
          float bon = g.f0[(size_t)row * 16 + head] + g.f0[(size_t)MR * 16 + (size_t)row * 16 + head];
          float vf[4] = {bf2f((u16)(vv.x & 0xffff)), bf2f((u16)(vv.x >> 16)), bf2f((u16)(vv.y & 0xffff)), bf2f((u16)(vv.y >> 16))};
          float o[4];
#pragma unroll
          for (int e = 0; e < 4; ++e) o[e] = (y[e] * inv * lw[e] + lb[e] + bon * vf[e]) * v[e];
          uint2 pk; pk.x = pack2(o[0], o[1]); pk.y = pack2(o[2], o[3]);
          *(uint2*)(g.hb + idx) = pk;
        }
      }
      SLAB_DONE();
    }
  }
#undef SLAB_WRITE
#undef EPI_LOAD
#undef SLAB_DONE
}

template <int EPI> __device__ __forceinline__ void gemm_phase(const GA& g, const GA& g2, LDSC* shm) {
  const int nM = g.mtiles, nN = g.ntiles;
  const int G = gridDim.x;
  const int PN = (nN & 3) == 0 ? 4 : 2, PM = 32 / PN;
  const int sN = nN / PN, sM = nM / PM, nsup = sN * sM;
  const int per = G >> 8;
  const int b = blockIdx.x, x = b & 7, l = (b >> 3) & 31, rep = b >> 8;
  bool pref = false;
  for (int s = x + 8 * rep; s < nsup; s += 8 * per) {
    int sm = s / sN, sn = s % sN;
    int pm = sm * PM + (l % PM), pn = sn * PN + (l / PM);
    int s2 = s + 8 * per;
    bool hn = s2 < nsup;
    int pm2 = (s2 / sN) * PM + (l % PM), pn2 = (s2 % sN) * PN + (l / PM);
    if constexpr (EPI == E_PLEGATE) {
      gemm_tile<E_PLEPROJ>(g2, pm, pn, false, false, pm, pn, shm);
      gemm_tile<E_PLEGATE>(g, pm, pn, false, false, pm, pn, shm);
    } else {
      gemm_tile<EPI>(g, pm, pn, pref, hn, hn ? pm2 : pm, hn ? pn2 : pn, shm);
      pref = hn;
    }
  }
  __syncthreads();
}

__device__ __forceinline__ void phase_mix(const Params& p, int tok0, int ntok) {
  const float* ss1 = (const float*)(p.ws + OFF_SS) + (size_t)1 * MT;
  const float* gain = p.in[7];
  u16* A2 = (u16*)(p.ws + OFF_BIG + BIG_A2);
  int tid = otid(), half = tid >> 8, c4 = (tid & 255) * 4;
  float4 gn = *(const float4*)(gain + c4);
  for (int l0 = blockIdx.x * 2; l0 < ntok; l0 += gridDim.x * 2) {
    int l = l0 + half, tok = tok0 + l;
    int pos, T;
    if (tok < MPROMPT) { pos = tok & 2047; T = 2048; } else { pos = tok - MPROMPT; T = 16384; }
    float4 c = *(const float4*)(p.h + (size_t)tok * D + c4);
    float rc = rstd_of(ss1[tok]);
    float4 hn = {c.x * rc * gn.x, c.y * rc * gn.y, c.z * rc * gn.z, c.w * rc * gn.w};
    float4 av = {0.f, 0.f, 0.f, 0.f};
    if (pos > 0) {
      float4 q = *(const float4*)(p.h + (size_t)(tok - 1) * D + c4);
      float r = rstd_of(ss1[tok - 1]);
      av.x += q.x * r * gn.x; av.y += q.y * r * gn.y; av.z += q.z * r * gn.z; av.w += q.w * r * gn.w;
    }
    if (pos < T - 1) {
      float4 q = *(const float4*)(p.h + (size_t)(tok + 1) * D + c4);
      float r = rstd_of(ss1[tok + 1]);
      av.x += q.x * r * gn.x; av.y += q.y * r * gn.y; av.z += q.z * r * gn.z; av.w += q.w * r * gn.w;
    }
    uint2 a, b;
    a.x = pack2(hn.x, hn.y); a.y = pack2(hn.z, hn.w);
    b.x = pack2(0.5f * av.x, 0.5f * av.y); b.y = pack2(0.5f * av.z, 0.5f * av.w);
    *(uint2*)(A2 + (size_t)l * 2048 + c4) = a;
    *(uint2*)(A2 + (size_t)l * 2048 + 1024 + c4) = b;
  }
}

constexpr int SC_T = 32;
constexpr int SC_ARR = SC_T * 64 * 4;
constexpr int SC_BUF = 6 * SC_ARR;
template <int E> __device__ __forceinline__ float rowsumL(float v) {
  v += dppf<0xB1>(v); v += dppf<0x4E>(v); v += dppf<0x141>(v);
  if (E == 4) v += dppf<0x140>(v);
  return v;
}

template <int E>
__device__ __forceinline__ void scan_item(const Params& p, int seq_loc0, int T, int head, int z, int rowbase, int nw, char* shm) {
  char* big = p.ws + OFF_BIG;
  const u16* Rb = (const u16*)(big + BIG_RKV);
  const u16* Kb = (const u16*)(big + BIG_RKV + SZ_RKV1);
  const u16* Vb = (const u16*)(big + BIG_RKV + 2 * SZ_RKV1);
  const u16* TW = (const u16*)(big + BIG_T);
  const u16* TA = (const u16*)(big + BIG_T + SZ_T1);
  u16* Y = (u16*)(big + (z ? BIG_Y1 : BIG_Y0));
  float* bonus = (float*)(p.ws + OFF_BONUS) + (size_t)z * MR * 16;
  const u16* W2 = (const u16*)(p.ws + OFF_W2W) + (size_t)z * 1024 * 64;
  const u16* A2w = (const u16*)(p.ws + OFF_W2A) + (size_t)z * 1024 * 64;
  const float* w0 = p.in[14] + z * 1024 + head * 64;
  const float* a0 = p.in[17] + z * 1024 + head * 64;
  const int tid = otid(), wv = tid >> 6, lane = tid & 63, fr = lane & 15, fq = lane >> 4;
  float* Ybuf = (float*)(shm + 2 * SC_BUF);
  const int si = tid >> 4, ec4 = (tid & 15) * 4;
  float4 ckk = *(const float4*)(p.in[22] + head * 64 + ec4);
  float4 cka = *(const float4*)(p.in[23] + head * 64 + ec4);
  float4 crk = *(const float4*)(p.in[24] + head * 64 + ec4);
  const int mt = wv >> 2, ntl = wv & 3;
  bf16x8 Bw[2], Ba[2];
#pragma unroll
  for (int ks = 0; ks < 2; ++ks) {
    Bw[ks] = *(const bf16x8*)(W2 + (size_t)(head * 64 + ntl * 16 + fr) * 64 + ks * 32 + fq * 8);
    Ba[ks] = *(const bf16x8*)(A2w + (size_t)(head * 64 + ntl * 16 + fr) * 64 + ks * 32 + fq * 8);
  }
  const float w0c = w0[ntl * 16 + fr], a0c = a0[ntl * 16 + fr];
  constexpr int LPR = 64 / E, RPW = 64 / LPR, NP = E / 2, NQ = E / 4;
  const int le = lane % LPR, row0 = rowbase + wv * RPW + lane / LPR;
  f32x2 st[NP];
#pragma unroll
  for (int q = 0; q < NP; ++q) st[q] = f32x2{0.f, 0.f};
  const int nch = T / SC_T;
  uint2 pr, pk, pv; bf16x8 Aw[2], Aa[2];
  auto tok_of = [&](int t) { return seq_loc0 + (z ? (T - 1 - t) : t); };
#define SC_LOAD(c) do { \
    int tk_ = tok_of((c) * SC_T + si); \
    pr = *(const uint2*)(Rb + (size_t)tk_ * D + head * 64 + ec4); \
    pk = *(const uint2*)(Kb + (size_t)tk_ * D + head * 64 + ec4); \
    pv = *(const uint2*)(Vb + (size_t)tk_ * D + head * 64 + ec4); \
    int tm_ = tok_of((c) * SC_T + mt * 16 + fr); \
    _Pragma("unroll") for (int ks = 0; ks < 2; ++ks) { \
      Aw[ks] = *(const bf16x8*)(TW + (size_t)tm_ * 128 + z * 64 + ks * 32 + fq * 8); \
      Aa[ks] = *(const bf16x8*)(TA + (size_t)tm_ * 128 + z * 64 + ks * 32 + fq * 8); } } while (0)
#define SC_LORA(b) do { \
    f32x4 cw = {0.f, 0.f, 0.f, 0.f}, ca = {0.f, 0.f, 0.f, 0.f}; \
    _Pragma("unroll") for (int ks = 0; ks < 2; ++ks) { \
      cw = __builtin_amdgcn_mfma_f32_16x16x32_bf16(Aw[ks], Bw[ks], cw, 0, 0, 0); \
      ca = __builtin_amdgcn_mfma_f32_16x16x32_bf16(Aa[ks], Ba[ks], ca, 0, 0, 0); } \
    float* Wl_ = (float*)(shm + (b) * SC_BUF); float* Al_ = (float*)(shm + (b) * SC_BUF + 3 * SC_ARR); \
    _Pragma("unroll") for (int j = 0; j < 4; ++j) { \
      int st_ = mt * 16 + fq * 4 + j; \
      Wl_[st_ * 64 + ntl * 16 + fr] = __expf(-0.6065306597126334f * sigm(w0c + cw[j])); \
      Al_[st_ * 64 + ntl * 16 + fr] = sigm(a0c + ca[j]); } } while (0)
#define SC_ELEM(b, c) do { \
    char* bb_ = shm + (b) * SC_BUF; \
    float4 a4 = *(const float4*)(bb_ + 3 * SC_ARR + (si * 64 + ec4) * 4); \
    float r0 = bf2f((u16)(pr.x & 0xffff)), r1 = bf2f((u16)(pr.x >> 16)), r2 = bf2f((u16)(pr.y & 0xffff)), r3 = bf2f((u16)(pr.y >> 16)); \
    float k0 = bf2f((u16)(pk.x & 0xffff)), k1 = bf2f((u16)(pk.x >> 16)), k2 = bf2f((u16)(pk.y & 0xffff)), k3 = bf2f((u16)(pk.y >> 16)); \
    float v0 = bf2f((u16)(pv.x & 0xffff)), v1 = bf2f((u16)(pv.x >> 16)), v2 = bf2f((u16)(pv.y & 0xffff)), v3 = bf2f((u16)(pv.y >> 16)); \
    float q0 = k0 * ckk.x, q1 = k1 * ckk.y, q2 = k2 * ckk.z, q3 = k3 * ckk.w; \
    float n2 = rowsum16(q0 * q0 + q1 * q1 + q2 * q2 + q3 * q3); \
    float inv_ = rsqrtf(fmaxf(n2, 1e-24f)); \
    q0 *= inv_; q1 *= inv_; q2 *= inv_; q3 *= inv_; \
    float d0 = k0 * (1.f + (a4.x - 1.f) * cka.x), d1 = k1 * (1.f + (a4.y - 1.f) * cka.y), d2 = k2 * (1.f + (a4.z - 1.f) * cka.z), d3 = k3 * (1.f + (a4.w - 1.f) * cka.w); \
    float bn = rowsum16(r0 * d0 * crk.x + r1 * d1 * crk.y + r2 * d2 * crk.z + r3 * d3 * crk.w); \
    if (rowbase == 0 && (tid & 15) == 0) bonus[(size_t)tok_of((c) * SC_T + si) * 16 + head] = bn; \
    *(float4*)(bb_ + 1 * SC_ARR + (si * 64 + ec4) * 4) = float4{q0, q1, q2, q3}; \
    *(float4*)(bb_ + 2 * SC_ARR + (si * 64 + ec4) * 4) = float4{d0, d1, d2, d3}; \
    *(float4*)(bb_ + 3 * SC_ARR + (si * 64 + ec4) * 4) = float4{q0 * a4.x, q1 * a4.y, q2 * a4.z, q3 * a4.w}; \
    *(float4*)(bb_ + 4 * SC_ARR + (si * 64 + ec4) * 4) = float4{r0, r1, r2, r3}; \
    *(float4*)(bb_ + 5 * SC_ARR + (si * 64 + ec4) * 4) = float4{v0, v1, v2, v3}; } while (0)

  __syncthreads();
  SC_LOAD(0);
  SC_LORA(0);
  __syncthreads();
  SC_ELEM(0, 0);
  __syncthreads();
  for (int c = 0; c < nch; ++c) {
    const int b = c & 1;
    if (c + 1 < nch) SC_LOAD(c + 1);
    const char* bb = shm + b * SC_BUF;
    if (wv < nw) {
      f32x4 cw[NQ], ckq[NQ], ckd[NQ], cka4[NQ], cr[NQ]; float vv;
#define SC_LD(i_, W_, KK_, KD_, KA_, R_, V_) do { _Pragma("unroll") for (int q = 0; q < NQ; ++q) { \
        W_[q] = *(const f32x4*)(bb + 0 * SC_ARR + ((i_) * 64 + le * E + q * 4) * 4); \
        KK_[q] = *(const f32x4*)(bb + 1 * SC_ARR + ((i_) * 64 + le * E + q * 4) * 4); \
        KD_[q] = *(const f32x4*)(bb + 2 * SC_ARR + ((i_) * 64 + le * E + q * 4) * 4); \
        KA_[q] = *(const f32x4*)(bb + 3 * SC_ARR + ((i_) * 64 + le * E + q * 4) * 4); \
        R_[q] = *(const f32x4*)(bb + 4 * SC_ARR + ((i_) * 64 + le * E + q * 4) * 4); } \
        V_ = *(const float*)(bb + 5 * SC_ARR + ((i_) * 64 + row0) * 4); } while (0)
      SC_LD(0, cw, ckq, ckd, cka4, cr, vv);
      f32x4 mw_[NQ], mkq[NQ], mkd[NQ], mka[NQ], mr[NQ]; float mvv;
      if constexpr (E == 4) SC_LD(1, mw_, mkq, mkd, mka, mr, mvv);
#pragma unroll 8
      for (int i = 0; i < SC_T; ++i) {
        f32x4 nw_[NQ], nkq[NQ], nkd[NQ], nka[NQ], nr[NQ]; float nvv;
        const int in_ = (i + (E == 4 ? 2 : 1)) & (SC_T - 1);
        SC_LD(in_, nw_, nkq, nkd, nka, nr, nvv);
        f32x2 da = st[0] * ckq[0].lo;
#pragma unroll
        for (int q = 1; q < NP; ++q) da += st[q] * ((q & 1) ? ckq[q >> 1].hi : ckq[q >> 1].lo);
        f32x2 uq[NP];
#pragma unroll
        for (int q = 0; q < NP; ++q) {
          f32x2 kdq = (q & 1) ? ckd[q >> 1].hi : ckd[q >> 1].lo;
          f32x2 wq = (q & 1) ? cw[q >> 1].hi : cw[q >> 1].lo;
          uq[q] = st[q] * wq + kdq * vv;
        }
        const float sk = rowsumL<E>(da.x + da.y);
#pragma unroll
        for (int q = 0; q < NP; ++q) {
          f32x2 kaq = (q & 1) ? cka4[q >> 1].hi : cka4[q >> 1].lo;
          st[q] = uq[q] - kaq * sk;
        }
        f32x2 ya = st[0] * cr[0].lo;
#pragma unroll
        for (int q = 1; q < NP; ++q) ya += st[q] * ((q & 1) ? cr[q >> 1].hi : cr[q >> 1].lo);
        const float yy = rowsumL<E>(ya.x + ya.y);
        if (le == 0) Ybuf[i * 64 + row0] = yy;
        if constexpr (E == 4) {
#pragma unroll
          for (int q = 0; q < NQ; ++q) { cw[q] = mw_[q]; ckq[q] = mkq[q]; ckd[q] = mkd[q]; cka4[q] = mka[q]; cr[q] = mr[q];
                                         mw_[q] = nw_[q]; mkq[q] = nkq[q]; mkd[q] = nkd[q]; mka[q] = nka[q]; mr[q] = nr[q]; }
          vv = mvv; mvv = nvv;
        } else {
#pragma unroll
          for (int q = 0; q < NQ; ++q) { cw[q] = nw_[q]; ckq[q] = nkq[q]; ckd[q] = nkd[q]; cka4[q] = nka[q]; cr[q] = nr[q]; }
          vv = nvv;
        }
      }
#undef SC_LD
    }
    if (c + 1 < nch) SC_LORA(b ^ 1);
    __syncthreads();
    if (c + 1 < nch) SC_ELEM(b ^ 1, c + 1);
    {
      int tk = tok_of(c * SC_T + si);
      int rr = (tid & 15) * 4;
      if (rr >= rowbase && rr < rowbase + nw * RPW) {
        float4 yv = *(const float4*)(Ybuf + si * 64 + rr);
        uint2 pk2; pk2.x = pack2(yv.x, yv.y); pk2.y = pack2(yv.z, yv.w);
        *(uint2*)(Y + (size_t)tk * D + head * 64 + rr) = pk2;
      }
    }
    __syncthreads();
  }
#undef SC_LOAD
#undef SC_LORA
#undef SC_ELEM
}

__device__ __forceinline__ void phase_scan(const Params& p, char* shm) {
  const int G = gridDim.x, b = blockIdx.x;
  const int nS = 128, nP = 16 * 32;
  int j, step;
  if (G > nS) { if (b < nS) { j = b; step = 1 << 30; } else { j = nS + (b - nS); step = G - nS; } }
  else { j = b; step = G; }
  for (; j < nS + nP; j += step) {
    if (j < nS) scan_item<4>(p, MPROMPT, 16384, (j >> 3) & 15, (j >> 2) & 1, (j & 3) * 16, 4, shm);
    else { int q = j - nS; scan_item<8>(p, (q >> 5) * 2048, 2048, (q >> 1) & 15, q & 1, 0, 8, shm); }
  }
}

__device__ __forceinline__ void phase_natt(const Params& p, u16* Odst, char* shm) {
  char* big = p.ws + OFF_BIG;
  const u16* Q = (const u16*)(big + BIG_Q);
  const u16* Kb = (const u16*)(big + BIG_K);
  const u16* Vt = (const u16*)(big + BIG_VT);
  const int tid = otid(), wv = tid >> 6, lane = tid & 63, fr = lane & 15, fq = lane >> 4;
  const int hg = blockIdx.x & 3, h = hg * 8 + wv;
  float* tab = (float*)(shm + wv * 3840);
  {
    const float* rp = p.in[30] + (size_t)h * 15 * 31;
    for (int idx = lane; idx < 960; idx += 64) tab[idx] = 0.f;
    asm volatile("s_waitcnt lgkmcnt(0)" ::: "memory");
    for (int idx = lane; idx < 465; idx += 64) { int r = idx / 31, c = idx - r * 31; tab[r * 64 + 16 + c] = rp[idx]; }
    asm volatile("s_waitcnt lgkmcnt(0)" ::: "memory");
  }
  const int nqb = MT / 16, qstep = gridDim.x >> 2;
  for (int qb = blockIdx.x >> 2; qb < nqb; qb += qstep) {
    int tb = qb * 16;
    int seqbase, T, loc;
    if (tb < MPROMPT) { seqbase = tb & ~2047; T = 2048; loc = tb & 2047; } else { seqbase = MPROMPT; T = 16384; loc = tb - MPROMPT; }
    int rows = T >> 6, i = loc >> 6, cbq = (loc & 63) >> 4;
    int rs = min(max(i - 4, 0), rows - 8);
    int kvs = min(max(cbq * 16 - 8, 0), 32);
    int qc = cbq * 16 + fr;
    int ws_ = min(max(qc - 8, 0), 48);
    bf16x8 qf = *(const bf16x8*)(Q + (size_t)(tb + fr) * D + h * 32 + fq * 8);
    unsigned vm = 0;
#pragma unroll
    for (int e = 0; e < 8; ++e) { int kcol = kvs + fq * 8 + e; vm |= ((kcol >= ws_) && (kcol < ws_ + 16)) ? (1u << e) : 0u; }
    const float* trow = tab + (rs - i + 7) * 64 + 16 + (kvs + fq * 8 - qc + 15);
    bf16x8 kf[8][2];
#pragma unroll
    for (int r = 0; r < 8; ++r)
#pragma unroll
      for (int hb2 = 0; hb2 < 2; ++hb2) {
        int kcolA = kvs + (fr >> 2) * 8 + hb2 * 4 + (fr & 3);
        size_t ktok = (size_t)seqbase + (size_t)(rs + r) * 64 + kcolA;
        kf[r][hb2] = *(const bf16x8*)(Kb + ktok * D + h * 32 + fq * 8);
      }
    f32x4 sc[8][2];
    float mx = -1e30f;
#pragma unroll
    for (int r = 0; r < 8; ++r) {
#pragma unroll
      for (int hb2 = 0; hb2 < 2; ++hb2) {
        f32x4 a = __builtin_amdgcn_mfma_f32_16x16x32_bf16(kf[r][hb2], qf, f32x4{0.f, 0.f, 0.f, 0.f}, 0, 0, 0);
#pragma unroll
        for (int j = 0; j < 4; ++j) {
          float sv = ((vm >> (hb2 * 4 + j)) & 1u) ? a[j] + trow[r * 64 + hb2 * 4 + j] : -1e30f;
          a[j] = sv; mx = fmaxf(mx, sv);
        }
        sc[r][hb2] = a;
      }
    }
    mx = fmaxf(mx, __shfl_xor(mx, 16));
    mx = fmaxf(mx, __shfl_xor(mx, 32));
    float sum = 0.f;
    f32x4 o0 = {0.f, 0.f, 0.f, 0.f}, o1 = {0.f, 0.f, 0.f, 0.f};
#pragma unroll
    for (int r = 0; r < 8; ++r) {
      bf16x8 pf;
#pragma unroll
      for (int e = 0; e < 8; ++e) {
        float pe = __expf(sc[r][e >> 2][e & 3] - mx);
        sum += pe;
        pf[e] = (short)f2bf(pe);
      }
      size_t vbase = (size_t)seqbase + (size_t)(rs + r) * 64 + kvs + fq * 8;
      bf16x8 v0 = *(const bf16x8*)(Vt + (size_t)(h * 32 + fr) * MT + vbase);
      bf16x8 v1 = *(const bf16x8*)(Vt + (size_t)(h * 32 + 16 + fr) * MT + vbase);
      o0 = __builtin_amdgcn_mfma_f32_16x16x32_bf16(v0, pf, o0, 0, 0, 0);
      o1 = __builtin_amdgcn_mfma_f32_16x16x32_bf16(v1, pf, o1, 0, 0, 0);
    }
    sum += __shfl_xor(sum, 16);
    sum += __shfl_xor(sum, 32);
    float inv = 1.f / sum;
    uint2 w0, w1;
    w0.x = pack2(o0[0] * inv, o0[1] * inv); w0.y = pack2(o0[2] * inv, o0[3] * inv);
    w1.x = pack2(o1[0] * inv, o1[1] * inv); w1.y = pack2(o1[2] * inv, o1[3] * inv);
    *(uint2*)(Odst + (size_t)(tb + fr) * D + h * 32 + fq * 4) = w0;
    *(uint2*)(Odst + (size_t)(tb + fr) * D + h * 32 + 16 + fq * 4) = w1;
  }
}

__device__ __forceinline__ void phase_final(const Params& p) {
  const float* ss8 = (const float*)(p.ws + OFF_SS) + (size_t)8 * MT;
  const float* gain = p.in[11];
  int tid = otid(), half = tid >> 8, c4 = (tid & 255) * 4;
  float4 gn = *(const float4*)(gain + c4);
  for (int r0 = blockIdx.x * 2; r0 < MT; r0 += gridDim.x * 2) {
    int row = r0 + half;
    float rs = rstd_of(ss8[row]);
    float4 v = *(float4*)(p.h + (size_t)row * D + c4);
    v.x *= rs * gn.x; v.y *= rs * gn.y; v.z *= rs * gn.z; v.w *= rs * gn.w;
    *(float4*)(p.h + (size_t)row * D + c4) = v;
  }
}

constexpr int NPHASE = 20;
#ifndef PROBE_MASK
#define PROBE_MASK 0ull
#endif

enum { K_NONE = 0, K_PREP, K_FFN1, K_FFN2, K_MIX, K_RKV, K_SCAN, K_FIN, K_RWO, K_PPROJ, K_PGATE, K_CONVH, K_QKV, K_NATT, K_NAO, K_FINAL };

__device__ __forceinline__ void run_phase(const Params& p, int ph, LDSC* shml) {
  char* shm = (char*)shml;
  char* ws = p.ws;
  float* ss = (float*)(ws + OFF_SS);
  u16* hb = (u16*)(ws + OFF_HB);
  char* big = ws + OFF_BIG;
  int kind = K_NONE, a = 0, b = 0, c = 0, d = 0;
  switch (ph) {
    case 0: kind = K_PREP; break;
    case 1: kind = K_FFN1; a = 0; b = 0; c = 0; d = 0; break;
    case 2: kind = K_FFN2; a = 0; b = 0; c = 1; break;
    case 3: kind = K_MIX; break;
    case 4: kind = K_RKV; break;
    case 5: kind = K_SCAN; break;
    case 6: kind = K_FIN; break;
    case 7: kind = K_RWO; break;
    case 8: kind = K_FFN1; a = 0; b = 1; c = 2; d = 1; break;
    case 9: kind = K_FFN2; a = 0; b = 1; c = 3; break;
    case 10: kind = K_PGATE; a = 0; b = 3; c = 4; break;
    case 11: kind = K_FFN1; a = 1; b = 0; c = 4; d = 0; break;
    case 12: kind = K_FFN2; a = 1; b = 0; c = 5; break;
    case 13: kind = K_QKV; break;
    case 14: kind = K_NATT; break;
    case 15: kind = K_NAO; break;
    case 16: kind = K_FFN1; a = 1; b = 1; c = 6; d = 1; break;
    case 17: kind = K_FFN2; a = 1; b = 1; c = 7; break;
    case 18: kind = K_PGATE; a = 1; b = 7; c = 8; break;
    case 19: kind = K_FINAL; break;
    default: break;
  }
  GA g;
  g.A = nullptr; g.Bt = nullptr; g.K = 0; g.N = 0; g.mtiles = 0; g.ntiles = 0; g.rowoff = 0;
  g.ss_in = nullptr; g.ss_out = nullptr; g.bias = nullptr; g.scale = 1.f; g.h = p.h; g.hb = hb;
  g.o0 = nullptr; g.o1 = nullptr; g.o2 = nullptr; g.f0 = nullptr; g.f1 = nullptr; g.f2 = nullptr;
  GA g2 = g;
  int epi = -1;
  const int tok0 = 0, ntok = MT;
  switch (kind) {
    case K_PREP: phase_prep(p, shm); break;
    case K_FFN1:
      if (d) conv_p(p, a);
      g.A = (a == 1 && b == 0) ? (const u16*)(big + BIG_HBALT) : hb;
      g.Bt = (const u16*)(ws + OFF_WIN + (size_t)(a * 2 + b) * SZ_WIN); g.K = 1024; g.N = 5632;
      g.mtiles = MT / 256; g.ntiles = 22; g.ss_in = ss + (size_t)c * MT; g.o0 = (u16*)(big + BIG_ACTB);
      epi = E_SWIGLU; break;
    case K_FFN2:
      g.A = (const u16*)(big + BIG_ACTB); g.Bt = (const u16*)(ws + OFF_WOUT + (size_t)(a * 2 + b) * SZ_WOUT); g.K = DFF; g.N = 1024;
      g.mtiles = MT / 256; g.ntiles = 4; g.ss_out = ss + (size_t)c * MT; g.scale = 0.5f;
      if (a == 0 && b == 0) g.hb = nullptr;
      epi = E_RESID; break;
    case K_MIX: phase_mix(p, tok0, ntok); break;
    case K_RKV:
      g.A = (const u16*)(big + BIG_A2); g.Bt = (const u16*)(ws + OFF_WRKV); g.K = 2048; g.N = 3456;
      g.mtiles = ntok / 256; g.ntiles = 14; g.o0 = (u16*)(big + BIG_RKV); g.o1 = (u16*)(big + BIG_T);
      epi = E_RKV; break;
    case K_SCAN: phase_scan(p, shm); break;
    case K_FIN:
      g.A = (const u16*)(big + BIG_T + 2 * SZ_T1); g.Bt = (const u16*)(ws + OFF_WG2); g.K = 128; g.N = 1024;
      g.mtiles = ntok / 256; g.ntiles = 4;
      g.o0 = (u16*)(big + BIG_Y0); g.o1 = (u16*)(big + BIG_Y1); g.o2 = (u16*)(big + BIG_RKV + 2 * SZ_RKV1);
      g.hb = (u16*)(big + BIG_RKV + SZ_RKV1);
      g.f0 = (const float*)(ws + OFF_BONUS); g.f1 = p.in[25]; g.f2 = p.in[26];
      epi = E_RWFIN; break;
    case K_RWO:
      g.A = (const u16*)(big + BIG_RKV + SZ_RKV1); g.Bt = (const u16*)(ws + OFF_WRWO); g.K = 1024; g.N = 1024;
      g.mtiles = ntok / 256; g.ntiles = 4; g.rowoff = tok0; g.ss_out = ss + (size_t)2 * MT; g.scale = 1.f;
      epi = E_RESID; break;
    case K_PGATE:
      g2 = g;
      g2.A = (const u16*)(ws + OFF_PBI); g2.Bt = (const u16*)(ws + OFF_WPP) + (size_t)a * 1024 * 256; g2.K = 256; g2.N = 1024;
      g2.mtiles = MT / 256; g2.ntiles = 4; g2.o0 = (u16*)(big + BIG_PB);
      g.hb = a == 0 ? (u16*)(big + BIG_HBALT) : nullptr;
      g.A = hb; g.Bt = (const u16*)(ws + OFF_WPG) + (size_t)a * 1024 * 1024; g.K = 1024; g.N = 1024;
      g.mtiles = MT / 256; g.ntiles = 4; g.ss_in = ss + (size_t)b * MT; g.ss_out = ss + (size_t)c * MT; g.o0 = (u16*)(big + BIG_PB);
      epi = E_PLEGATE; break;
    case K_QKV:
      g.A = hb; g.Bt = (const u16*)(ws + OFF_WQKV); g.K = 1024; g.N = 3072; g.mtiles = MT / 256; g.ntiles = 12;
      g.ss_in = ss + (size_t)5 * MT; g.bias = p.in[29];
      g.o0 = (u16*)(big + BIG_Q); g.o1 = (u16*)(big + BIG_K); g.o2 = (u16*)(big + BIG_VT);
      epi = E_QKV; break;
    case K_NATT:
#ifdef PROBE_NATT
      phase_natt(p, hb, shm); __syncthreads();
#endif
      phase_natt(p, (u16*)(big + BIG_Q), shm); break;
    case K_NAO:
      g.A = (const u16*)(big + BIG_Q); g.Bt = (const u16*)(ws + OFF_WNAO); g.K = 1024; g.N = 1024; g.mtiles = MT / 256; g.ntiles = 4;
      g.ss_out = ss + (size_t)6 * MT; g.bias = p.in[32]; g.scale = 1.f;
      epi = E_RESID; break;
    case K_FINAL: phase_final(p); break;
    default: break;
  }
  switch (epi) {
    case E_SWIGLU: gemm_phase<E_SWIGLU>(g, g2, shml); break;
    case E_RESID: gemm_phase<E_RESID>(g, g2, shml); break;
    case E_PLEGATE: gemm_phase<E_PLEGATE>(g, g2, shml); break;
    case E_RKV: gemm_phase<E_RKV>(g, g2, shml); break;
    case E_RWFIN: gemm_phase<E_RWFIN>(g, g2, shml); break;
    case E_QKV: gemm_phase<E_QKV>(g, g2, shml); break;
    default: break;
  }
}

__device__ __forceinline__ void grid_barrier(unsigned* bar, unsigned& nbar) {
  asm volatile("s_waitcnt vmcnt(0)" ::: "memory");
  __syncthreads();
  nbar += 1;
  if (otid() == 0) {
    __builtin_amdgcn_s_waitcnt(0);
    __builtin_amdgcn_fence(__ATOMIC_RELEASE, "agent");
    asm volatile("s_waitcnt vmcnt(0)" ::: "memory");
    __hip_atomic_fetch_add(bar, 1u, __ATOMIC_RELAXED, __HIP_MEMORY_SCOPE_AGENT);
    const unsigned target = nbar * gridDim.x;
    while (__hip_atomic_load(bar, __ATOMIC_RELAXED, __HIP_MEMORY_SCOPE_AGENT) < target) __builtin_amdgcn_s_sleep(1);
    __builtin_amdgcn_fence(__ATOMIC_ACQUIRE, "agent");
    asm volatile("s_waitcnt vmcnt(0)" ::: "memory");
  }
  __syncthreads();
}

__global__ void __launch_bounds__(NTHR, 2) fwd_megakernel(Params p, int ph_lo, int ph_hi) {
  __shared__ __attribute__((aligned(1024))) char shm[131072];
  cg::grid_group grid = cg::this_grid();
  unsigned* bar = (unsigned*)(p.ws + OFF_BAR);
  if (blockIdx.x == 0 && otid() == 0) __hip_atomic_store(bar, 0u, __ATOMIC_RELAXED, __HIP_MEMORY_SCOPE_AGENT);
  unsigned nbar = 0;
  for (int ph = ph_lo; ph < ph_hi; ++ph) {
#if PROBE_MASK
    if ((PROBE_MASK >> ph) & 1ull) { run_phase(p, ph, (LDSC*)shm); if (ph == ph_lo) grid.sync(); else grid_barrier(bar, nbar); }
#endif
    run_phase(p, ph, (LDSC*)shm);
    if (ph + 1 < ph_hi) {
      if (ph == ph_lo) grid.sync(); else grid_barrier(bar, nbar);
    }
  }
}

extern "C" void kernel_launch(void* const* d_in, const int* in_sizes, int n_in, void* d_out, int out_size, void* d_ws, size_t ws_size,
                              hipStream_t stream) {
  static int grid_blocks = 0;
  if (!grid_blocks) {
    int dev = 0, cus = 0, per_cu = 0;
    hipGetDevice(&dev);
    hipDeviceGetAttribute(&cus, hipDeviceAttributeMultiprocessorCount, dev);
    hipOccupancyMaxActiveBlocksPerMultiprocessor(&per_cu, fwd_megakernel, NTHR, 0);
    (void)per_cu;
    grid_blocks = 256;
    if (cus < 256) { fprintf(stderr, "device has %d CUs, this kernel needs 256\n", cus); grid_blocks = -1; }
  }
  if (grid_blocks < 0) return;
  if (ws_size < OFF_BIG + BIG_T + 3 * SZ_T1) return;
  Params p{};
  for (int i = 0; i < 33; ++i) p.in[i] = (const float*)d_in[i];
  p.h = (float*)d_out;
  p.ws = (char*)d_ws;
  int lo = 0, hi = NPHASE;
  void* args[] = {&p, &lo, &hi};
  hipError_t e = hipLaunchCooperativeKernel((void*)fwd_megakernel, dim3(grid_blocks), dim3(NTHR), args, 0, stream);
  if (e != hipSuccess) fprintf(stderr, "cooperative launch failed: %s (grid %d)\n", hipGetErrorString(e), grid_blocks);
}
```

```cpp
#include <hip/hip_runtime.h>
#include <hip/hip_cooperative_groups.h>
#include <cstdio>
#include <cstdint>
namespace cg = cooperative_groups;

typedef unsigned short u16;
using bf16x8 = __attribute__((ext_vector_type(8))) short;
using f32x4 = __attribute__((ext_vector_type(4))) float;
using f32x2 = __attribute__((ext_vector_type(2))) float;
using i32x4 = __attribute__((ext_vector_type(4))) int;
typedef __attribute__((address_space(3))) char LDSC;
typedef __attribute__((address_space(3))) unsigned LDSU;
typedef __attribute__((address_space(3))) bf16x8 LDS_BF8;

constexpr int MT = 49152;
constexpr int MPROMPT = 32768;
constexpr int MR = MT;
constexpr int D = 1024;
constexpr int DFF = 2816;
constexpr int NTHR = 512;

constexpr size_t SZ_WIN = (size_t)5632 * 1024 * 2;
constexpr size_t SZ_WOUT = (size_t)1024 * 2816 * 2;
constexpr size_t OFF_WIN = 0;
constexpr size_t OFF_WOUT = OFF_WIN + 4 * SZ_WIN;
constexpr size_t OFF_WPG = OFF_WOUT + 4 * SZ_WOUT;
constexpr size_t OFF_WPP = OFF_WPG + 2 * (size_t)1024 * 1024 * 2;
constexpr size_t OFF_WRKV = OFF_WPP + 2 * (size_t)1024 * 256 * 2;
constexpr size_t OFF_W2W = OFF_WRKV + (size_t)3584 * 2048 * 2;
constexpr size_t OFF_W2A = OFF_W2W + 2 * (size_t)1024 * 64 * 2;
constexpr size_t OFF_WG2 = OFF_W2A + 2 * (size_t)1024 * 64 * 2;
constexpr size_t OFF_WRWO = OFF_WG2 + (size_t)1024 * 128 * 2;
constexpr size_t OFF_WQKV = OFF_WRWO + (size_t)1024 * 1024 * 2;
constexpr size_t OFF_WNAO = OFF_WQKV + (size_t)3072 * 1024 * 2;
constexpr size_t OFF_SS = OFF_WNAO + (size_t)1024 * 1024 * 2;
constexpr size_t OFF_BONUS = OFF_SS + 9 * (size_t)MT * 4;
constexpr size_t OFF_BAR = OFF_BONUS + 2 * (size_t)MR * 16 * 4;
constexpr size_t OFF_HB = OFF_BAR + 256;
constexpr size_t OFF_PBI = OFF_HB + (size_t)MT * 1024 * 2;
constexpr size_t OFF_BIG = OFF_PBI + (size_t)MT * 256 * 2;
constexpr size_t BIG_ACTB = 0;
constexpr size_t BIG_PB = 0;
constexpr size_t BIG_HBALT = (size_t)MT * 2816 * 2;
constexpr size_t BIG_A2 = 0;
constexpr size_t BIG_Y0 = 0;
constexpr size_t BIG_Y1 = (size_t)MR * 1024 * 2;
constexpr size_t BIG_RKV = (size_t)MR * 2048 * 2;
constexpr size_t SZ_RKV1 = (size_t)MR * 1024 * 2;
constexpr size_t BIG_T = BIG_RKV + 3 * SZ_RKV1;
constexpr size_t SZ_T1 = (size_t)MR * 128 * 2;
constexpr size_t BIG_Q = 0;
constexpr size_t BIG_K = (size_t)MT * 1024 * 2;
constexpr size_t BIG_VT = 2 * (size_t)MT * 1024 * 2;

struct Params {
  const float* in[33];
  float* h;
  char* ws;
};

__device__ __forceinline__ u16 f2bf(float f) {
  unsigned u = __float_as_uint(f);
  u += 0x7fffu + ((u >> 16) & 1u);
  return (u16)(u >> 16);
}
__device__ __forceinline__ float bf2f(u16 h) { return __uint_as_float(((unsigned)h) << 16); }
__device__ __forceinline__ unsigned pack2(float a, float b) { return (unsigned)f2bf(a) | ((unsigned)f2bf(b) << 16); }
__device__ __forceinline__ float sigm(float x) { return __builtin_amdgcn_rcpf(1.f + __expf(-x)); }
template <int CTRL> __device__ __forceinline__ float dppf(float v) {
  return __int_as_float(__builtin_amdgcn_update_dpp(0, __float_as_int(v), CTRL, 0xf, 0xf, true));
}
__device__ __forceinline__ float rowsum16(float v) {
  v += dppf<0xB1>(v);
  v += dppf<0x4E>(v);
  v += dppf<0x141>(v);
  v += dppf<0x140>(v);
  return v;
}
__device__ __forceinline__ int otid() { int t = __builtin_amdgcn_workitem_id_x(); asm volatile("" : "+v"(t)); return t; }
__device__ __forceinline__ float rstd_of(float ss) { return rsqrtf(ss * (1.f / 1024.f) + 1e-6f); }

struct PrepJob {
  const float* src; int K, N, ldsrc;
  u16* dst; int dld, koff, noff;
  const float* sc; int mode;
  int perm;
};

__device__ __forceinline__ void prep_tiles(const PrepJob& j, char* shm) {
  u16* tl = (u16*)shm;
  int kt = j.K >> 6, nt = j.N >> 6, tiles = kt * nt;
  int tid = otid();
  for (int t = blockIdx.x; t < tiles; t += gridDim.x) {
    int k0 = (t / nt) << 6, n0 = (t % nt) << 6;
#pragma unroll
    for (int it = 0; it < 2; ++it) {
      int kk = (tid >> 4) + 32 * it, nn4 = (tid & 15) * 4;
      float4 v = *(const float4*)(j.src + (size_t)(k0 + kk) * j.ldsrc + n0 + nn4);
      float s = 1.f;
      if (j.mode == 1 || j.mode == 3) s = j.sc[k0 + kk];
      else if (j.mode == 2) s = 1.f - j.sc[k0 + kk];
      tl[(nn4 + 0) * 72 + kk] = f2bf(v.x * s);
      tl[(nn4 + 1) * 72 + kk] = f2bf(v.y * s);
      tl[(nn4 + 2) * 72 + kk] = f2bf(v.z * s);
      tl[(nn4 + 3) * 72 + kk] = f2bf(v.w * s);
    }
    __syncthreads();
    {
      int nn = tid >> 3, kk8 = (tid & 7) * 8;
      int c = n0 + nn, drow;
      if (j.perm) { int half = c / DFF, cp = c % DFF; drow = (cp >> 5) * 64 + half * 32 + (cp & 31); }
      else drow = c;
      i32x4 v = *(const i32x4*)(tl + nn * 72 + kk8);
      *(i32x4*)(j.dst + (size_t)(j.noff + drow) * j.dld + j.koff + k0 + kk8) = v;
    }
    __syncthreads();
  }
}

__device__ __forceinline__ void phase_prep(const Params& p, char* shm) {
  char* ws = p.ws;
  for (int jj = 0; jj < 38; ++jj) {
    PrepJob j; j.mode = 0; j.sc = nullptr; j.perm = 0; j.koff = 0; j.noff = 0;
    if (jj < 4) {
      j.src = p.in[5] + (size_t)jj * 1024 * 5632; j.K = 1024; j.N = 5632; j.ldsrc = 5632;
      j.dst = (u16*)(ws + OFF_WIN + jj * SZ_WIN); j.dld = 1024; j.sc = p.in[4] + jj * 1024; j.mode = 1; j.perm = 1;
    } else if (jj < 8) {
      int q = jj - 4;
      j.src = p.in[6] + (size_t)q * 2816 * 1024; j.K = 2816; j.N = 1024; j.ldsrc = 1024;
      j.dst = (u16*)(ws + OFF_WOUT + q * SZ_WOUT); j.dld = 2816;
    } else if (jj < 10) {
      int q = jj - 8;
      j.src = p.in[9] + (size_t)q * 1024 * 1024; j.K = 1024; j.N = 1024; j.ldsrc = 1024;
      j.dst = (u16*)(ws + OFF_WPG) + (size_t)q * 1024 * 1024; j.dld = 1024; j.sc = p.in[8] + q * 1024; j.mode = 1;
    } else if (jj < 12) {
      int q = jj - 10;
      j.src = p.in[10] + (size_t)q * 256 * 1024; j.K = 256; j.N = 1024; j.ldsrc = 1024;
      j.dst = (u16*)(ws + OFF_WPP) + (size_t)q * 1024 * 256; j.dld = 256;
    } else if (jj < 28) {
      int q = (jj - 12) >> 1, hf = (jj - 12) & 1;
      j.K = 1024; j.dst = (u16*)(ws + OFF_WRKV); j.dld = 2048; j.koff = hf * 1024; j.mode = hf ? 3 : 2;
      if (q < 3) { j.src = p.in[13] + (size_t)q * 1024 * 1024; j.N = 1024; j.ldsrc = 1024; j.noff = q * 1024; j.sc = p.in[12] + q * 1024; }
      else if (q < 5) { int z = q - 3; j.src = p.in[15] + (size_t)z * 1024 * 64; j.N = 64; j.ldsrc = 64; j.noff = 3072 + z * 64; j.sc = p.in[12] + 3 * 1024; }
      else if (q < 7) { int z = q - 5; j.src = p.in[18] + (size_t)z * 1024 * 64; j.N = 64; j.ldsrc = 64; j.noff = 3200 + z * 64; j.sc = p.in[12] + 4 * 1024; }
      else { j.src = p.in[20]; j.N = 128; j.ldsrc = 128; j.noff = 3328; j.sc = p.in[12] + 5 * 1024; }
    } else if (jj < 30) {
      int z = jj - 28;
      j.src = p.in[16] + (size_t)z * 64 * 1024; j.K = 64; j.N = 1024; j.ldsrc = 1024;
      j.dst = (u16*)(ws + OFF_W2W) + (size_t)z * 1024 * 64; j.dld = 64;
    } else if (jj < 32) {
      int z = jj - 30;
      j.src = p.in[19] + (size_t)z * 64 * 1024; j.K = 64; j.N = 1024; j.ldsrc = 1024;
      j.dst = (u16*)(ws + OFF_W2A) + (size_t)z * 1024 * 64; j.dld = 64;
    } else if (jj == 32) {
      j.src = p.in[21]; j.K = 128; j.N = 1024; j.ldsrc = 1024; j.dst = (u16*)(ws + OFF_WG2); j.dld = 128;
    } else if (jj == 33) {
      j.src = p.in[27]; j.K = 1024; j.N = 1024; j.ldsrc = 1024; j.dst = (u16*)(ws + OFF_WRWO); j.dld = 1024;
    } else if (jj == 34) {
      j.src = p.in[28]; j.K = 1024; j.N = 3072; j.ldsrc = 3072; j.dst = (u16*)(ws + OFF_WQKV); j.dld = 1024; j.sc = p.in[7] + 1024; j.mode = 1;
    } else if (jj == 35) {
      j.src = p.in[31]; j.K = 1024; j.N = 1024; j.ldsrc = 1024; j.dst = (u16*)(ws + OFF_WNAO); j.dld = 1024;
    } else continue;
    prep_tiles(j, shm);
  }
  float* ss = (float*)(ws + OFF_SS);
  u16* hb = (u16*)(ws + OFF_HB);
  int tid = otid(), half = tid >> 8, t4 = (tid & 255) * 4;
  float* red = (float*)shm;
  for (int r0 = blockIdx.x * 2; r0 < MT; r0 += gridDim.x * 2) {
    int row = r0 + half;
    const float* src = row < MPROMPT ? p.in[0] + (size_t)row * D : p.in[1] + (size_t)(row - MPROMPT) * D;
    float4 v = *(const float4*)(src + t4);
    *(float4*)(p.h + (size_t)row * D + t4) = v;
    uint2 pk; pk.x = pack2(v.x, v.y); pk.y = pack2(v.z, v.w);
    *(uint2*)(hb + (size_t)row * D + t4) = pk;
    float s = v.x * v.x + v.y * v.y + v.z * v.z + v.w * v.w;
#pragma unroll
    for (int o = 32; o > 0; o >>= 1) s += __shfl_xor(s, o);
    __syncthreads();
    if ((tid & 63) == 0) red[tid >> 6] = s;
    __syncthreads();
    if ((tid & 255) == 0) {
      float tot = red[half * 4] + red[half * 4 + 1] + red[half * 4 + 2] + red[half * 4 + 3];
      ss[row] = tot;
#pragma unroll
      for (int q = 1; q < 9; ++q) ss[(size_t)q * MT + row] = 0.f;
    }
  }
}

__device__ __forceinline__ void conv_p(const Params& p, int layer) {
  u16* pbi = (u16*)(p.ws + OFF_PBI);
  const float* pp = p.in[2] + (size_t)layer * MPROMPT * 256;
  const float* ps = p.in[3] + (size_t)layer * (MT - MPROMPT) * 256;
  size_t n4 = (size_t)MT * 256 / 4;
  for (size_t i = (size_t)blockIdx.x * NTHR + otid(); i < n4; i += (size_t)gridDim.x * NTHR) {
    size_t e = i * 4;
    const float* s = e < (size_t)MPROMPT * 256 ? pp + e : ps + (e - (size_t)MPROMPT * 256);
    float4 v = *(const float4*)s;
    uint2 pk; pk.x = pack2(v.x, v.y); pk.y = pack2(v.z, v.w);
    *(uint2*)(pbi + e) = pk;
  }
}

__device__ __forceinline__ void conv_h(const Params& p) {
  u16* hb = (u16*)(p.ws + OFF_HB);
  size_t n4 = (size_t)MT * D / 4;
  for (size_t i = (size_t)blockIdx.x * NTHR + otid(); i < n4; i += (size_t)gridDim.x * NTHR) {
    float4 v = *(const float4*)(p.h + i * 4);
    uint2 pk; pk.x = pack2(v.x, v.y); pk.y = pack2(v.z, v.w);
    *(uint2*)(hb + i * 4) = pk;
  }
}

enum { E_SWIGLU = 0, E_RESID = 1, E_PLEPROJ = 2, E_PLEGATE = 3, E_RKV = 4, E_RWFIN = 5, E_QKV = 6 };

struct GA {
  const u16* A; const u16* Bt; int K; int N;
  int mtiles, ntiles;
  int rowoff;
  const float* ss_in; float* ss_out;
  const float* bias; float scale;
  float* h; u16* hb;
  u16* o0; u16* o1; u16* o2;
  const float* f0; const float* f1; const float* f2;
};

template <int KS> __device__ __forceinline__ int lds_byte(int r, int c) {
  int st = (r >> 4) * KS + (c >> 5), ob = (r & 15) * 64 + (c & 31) * 2;
  return st * 1024 + (ob ^ (((ob >> 9) & 1) << 5));
}
template <int KS> __device__ __forceinline__ void stage_rc(int b, int& R, int& C) {
  int st = b >> 10, sb = b & 1023, swz = sb ^ (((sb >> 9) & 1) << 5);
  R = (st / KS) * 16 + swz / 64;
  C = (st % KS) * 32 + (swz % 64) / 2;
}

template <int EPI>
__device__ __forceinline__ void gemm_tile(const GA& g, int pm, int pn, bool prefetched, bool has_next, int pm_next, int pn_next, LDSC* shm) {
  constexpr int BK = 64, KS = 2, TILE_B = 256 * BK * 2, GL = 4, STAGE_B = 2 * TILE_B;
  const int K = g.K;
  const int tid = otid(), wid = tid >> 6, lane = tid & 63, wr = wid >> 2, wc = wid & 3, fr = lane & 15, fq = lane >> 4;
  const int brow = pm * 256, bcol = pn * 256;
  const u16* Ab = g.A + (size_t)brow * K;
  const u16* Bb = g.Bt + (size_t)bcol * K;
  const u16* Abn = g.A + (size_t)(pm_next * 256) * K;
  const u16* Bbn = g.Bt + (size_t)(pn_next * 256) * K;
  int sO[GL];
#pragma unroll
  for (int i = 0; i < GL; ++i) { int r_, c_; stage_rc<KS>(wid * 1024 + i * 8192 + lane * 16, r_, c_); sO[i] = r_ * K + c_; }
  f32x4 acc[8][4];
#pragma unroll
  for (int m = 0; m < 8; ++m)
#pragma unroll
    for (int n = 0; n < 4; ++n) acc[m][n] = f32x4{0.f, 0.f, 0.f, 0.f};
  const int nt = K / BK;
#define G_STAGE(buf, AB_, BB_, kt) do { _Pragma("unroll") for (int i = 0; i < GL; ++i) { \
    __builtin_amdgcn_global_load_lds((const unsigned*)((AB_) + (kt) * BK + sO[i]), (LDSU*)(shm + (buf) * STAGE_B + wid * 1024 + i * 8192), 16, 0, 0); \
    __builtin_amdgcn_global_load_lds((const unsigned*)((BB_) + (kt) * BK + sO[i]), (LDSU*)(shm + (buf) * STAGE_B + TILE_B + wid * 1024 + i * 8192), 16, 0, 0); } } while (0)
#define G_STAGE_H(hh, buf, AB_, BB_, kt) do { _Pragma("unroll") for (int i = (hh) * 2; i < (hh) * 2 + 2; ++i) { \
    __builtin_amdgcn_global_load_lds((const unsigned*)((AB_) + (kt) * BK + sO[i]), (LDSU*)(shm + (buf) * STAGE_B + wid * 1024 + i * 8192), 16, 0, 0); \
    __builtin_amdgcn_global_load_lds((const unsigned*)((BB_) + (kt) * BK + sO[i]), (LDSU*)(shm + (buf) * STAGE_B + TILE_B + wid * 1024 + i * 8192), 16, 0, 0); } } while (0)
  if (!prefetched) G_STAGE(0, Ab, Bb, 0);
  asm volatile("s_waitcnt vmcnt(0)" ::: "memory");
  __syncthreads();
  for (int t = 0; t < nt; ++t) {
    int cur = t & 1;
    if (t + 1 < nt) G_STAGE_H(0, cur ^ 1, Ab, Bb, t + 1);
    else if (has_next) G_STAGE_H(0, 0, Abn, Bbn, 0);
    const LDSC* SAp = shm + cur * STAGE_B;
    const LDSC* SBp = SAp + TILE_B;
#pragma unroll
    for (int ks = 0; ks < KS; ++ks) {
      if (ks == 1) {
        if (t + 1 < nt) G_STAGE_H(1, cur ^ 1, Ab, Bb, t + 1);
        else if (has_next) G_STAGE_H(1, 0, Abn, Bbn, 0);
      }
      bf16x8 At[8], Bf[4];
#pragma unroll
      for (int m = 0; m < 8; ++m) At[m] = *(const LDS_BF8*)(SAp + lds_byte<KS>(wr * 128 + m * 16 + fr, ks * 32 + fq * 8));
#pragma unroll
      for (int n = 0; n < 4; ++n) Bf[n] = *(const LDS_BF8*)(SBp + lds_byte<KS>(wc * 64 + n * 16 + fr, ks * 32 + fq * 8));
      __builtin_amdgcn_s_setprio(1);
#pragma unroll
      for (int m = 0; m < 8; ++m)
#pragma unroll
        for (int n = 0; n < 4; ++n) acc[m][n] = __builtin_amdgcn_mfma_f32_16x16x32_bf16(At[m], Bf[n], acc[m][n], 0, 0, 0);
      __builtin_amdgcn_s_setprio(0);
      __builtin_amdgcn_sched_barrier(0);
    }
    if (t + 1 < nt) asm volatile("s_waitcnt vmcnt(0)" ::: "memory");
    __syncthreads();
  }
#undef G_STAGE
#undef G_STAGE_H
  typedef __attribute__((address_space(3))) float LDSF;
  typedef __attribute__((address_space(3))) f32x4 LDSF4;
  LDSF* scr = (LDSF*)(shm + STAGE_B + wid * 4352);
  const int cb = bcol + wc * 64;
#define SLAB_WRITE(m) do { _Pragma("unroll") for (int n = 0; n < 4; ++n) _Pragma("unroll") for (int j = 0; j < 4; ++j) \
    scr[(fq * 4 + j) * 68 + n * 16 + fr] = acc[m][n][j]; asm volatile("s_waitcnt lgkmcnt(0)" ::: "memory"); } while (0)
#define SLAB_DONE() asm volatile("s_waitcnt lgkmcnt(0)" ::: "memory")
  if constexpr (EPI == E_SWIGLU) {
    const int l8 = lane & 7, r8 = lane >> 3;
#pragma unroll
    for (int m = 0; m < 8; ++m) {
      SLAB_WRITE(m);
#pragma unroll
      for (int k = 0; k < 2; ++k) {
        int rl = k * 8 + r8, row = brow + wr * 128 + m * 16 + rl;
        f32x4 gt = *(const LDSF4*)(scr + rl * 68 + l8 * 4), up = *(const LDSF4*)(scr + rl * 68 + 32 + l8 * 4);
        float rs = rstd_of(g.ss_in[g.rowoff + row]);
        float o[4];
#pragma unroll
        for (int e = 0; e < 4; ++e) { float a = gt[e] * rs; o[e] = a * sigm(a) * (up[e] * rs); }
        uint2 pk; pk.x = pack2(o[0], o[1]); pk.y = pack2(o[2], o[3]);
        *(uint2*)(g.o0 + (size_t)row * DFF + (cb >> 1) + l8 * 4) = pk;
      }
      SLAB_DONE();
    }
  } else if constexpr (EPI == E_QKV) {
    const int which = cb >> 10, c0 = cb & 1023;
    if (which == 2) {
#pragma unroll
      for (int m = 0; m < 8; ++m) {
        int row0 = brow + wr * 128 + m * 16 + fq * 4;
        float rs[4];
#pragma unroll
        for (int j = 0; j < 4; ++j) rs[j] = rstd_of(g.ss_in[row0 + j]);
#pragma unroll
        for (int n = 0; n < 4; ++n) {
          int col = c0 + n * 16 + fr;
          float b = g.bias[cb + n * 16 + fr];
          uint2 pk; pk.x = pack2(acc[m][n][0] * rs[0] + b, acc[m][n][1] * rs[1] + b); pk.y = pack2(acc[m][n][2] * rs[2] + b, acc[m][n][3] * rs[3] + b);
          *(uint2*)(g.o2 + (size_t)col * MT + row0) = pk;
        }
      }
    } else {
      u16* dst = which == 0 ? g.o0 : g.o1;
      const float sc = which == 0 ? 0.17677669529663687f : 1.f;
      f32x4 b4 = *(const f32x4*)(g.bias + cb + fr * 4);
#pragma unroll
      for (int m = 0; m < 8; ++m) {
        SLAB_WRITE(m);
#pragma unroll
        for (int k = 0; k < 4; ++k) {
          int rl = k * 4 + fq, row = brow + wr * 128 + m * 16 + rl;
          f32x4 v = *(const LDSF4*)(scr + rl * 68 + fr * 4);
          float rs = rstd_of(g.ss_in[row]);
          uint2 pk; pk.x = pack2((v[0] * rs + b4[0]) * sc, (v[1] * rs + b4[1]) * sc); pk.y = pack2((v[2] * rs + b4[2]) * sc, (v[3] * rs + b4[3]) * sc);
          *(uint2*)(dst + (size_t)row * D + c0 + fr * 4) = pk;
        }
        SLAB_DONE();
      }
    }
  } else {
    float lw[4] = {0.f, 0.f, 0.f, 0.f}, lb[4] = {0.f, 0.f, 0.f, 0.f}, bs[4] = {0.f, 0.f, 0.f, 0.f};
    if constexpr (EPI == E_RWFIN) {
#pragma unroll
      for (int e = 0; e < 4; ++e) { lw[e] = g.f1[cb + fr * 4 + e]; lb[e] = g.f2[cb + fr * 4 + e]; }
    }
    if constexpr (EPI == E_RESID) {
      if (g.bias) {
#pragma unroll
        for (int e = 0; e < 4; ++e) bs[e] = g.bias[cb + fr * 4 + e];
      }
    }
    f32x4 h_n[4]; uint2 a_n[4]; float f_n[4][2];
#define EPI_LOAD(m_) do { _Pragma("unroll") for (int k = 0; k < 4; ++k) { \
      const int row_ = brow + wr * 128 + (m_) * 16 + k * 4 + fq, col_ = cb + fr * 4; \
      if constexpr (EPI == E_RESID || EPI == E_PLEGATE) h_n[k] = *(const f32x4*)(g.h + (size_t)(g.rowoff + row_) * D + col_); \
      if constexpr (EPI == E_PLEGATE) { a_n[k] = *(const uint2*)(g.o0 + (size_t)(g.rowoff + row_) * D + col_); f_n[k][0] = g.ss_in[g.rowoff + row_]; } \
      } } while (0)
    f32x4 h_m[4]; uint2 a_m[4]; float f_m[4][2];
    EPI_LOAD(0);
#pragma unroll
    for (int k = 0; k < 4; ++k) { h_m[k] = h_n[k]; a_m[k] = a_n[k]; f_m[k][0] = f_n[k][0]; }
    EPI_LOAD(1);
#pragma unroll
    for (int m = 0; m < 8; ++m) {
      f32x4 h_c[4]; uint2 a_c[4]; float f_c[4][2];
#pragma unroll
      for (int k = 0; k < 4; ++k) { h_c[k] = h_m[k]; a_c[k] = a_m[k]; f_c[k][0] = f_m[k][0];
                                    h_m[k] = h_n[k]; a_m[k] = a_n[k]; f_m[k][0] = f_n[k][0]; }
      if (m + 2 < 8) EPI_LOAD(m + 2);
      SLAB_WRITE(m);
#pragma unroll
      for (int k = 0; k < 4; ++k) {
        const int rl = k * 4 + fq, row = brow + wr * 128 + m * 16 + rl;
        const int col = cb + fr * 4;
        f32x4 v = *(const LDSF4*)(scr + rl * 68 + fr * 4);
        if constexpr (EPI == E_RESID || EPI == E_PLEGATE) {
          size_t grow = (size_t)(g.rowoff + row);
          float* hp = g.h + grow * D + col;
          f32x4 hv = h_c[k];
          if constexpr (EPI == E_PLEGATE) {
            float rs = rstd_of(f_c[k][0]);
            uint2 pb = a_c[k];
            hv[0] += sigm(v[0] * rs) * bf2f((u16)(pb.x & 0xffff));
            hv[1] += sigm(v[1] * rs) * bf2f((u16)(pb.x >> 16));
            hv[2] += sigm(v[2] * rs) * bf2f((u16)(pb.y & 0xffff));
            hv[3] += sigm(v[3] * rs) * bf2f((u16)(pb.y >> 16));
          } else {
#pragma unroll
            for (int e = 0; e < 4; ++e) hv[e] += g.scale * v[e] + bs[e];
          }
          *(f32x4*)hp = hv;
          if (g.hb != nullptr) {
            uint2 pk; pk.x = pack2(hv[0], hv[1]); pk.y = pack2(hv[2], hv[3]);
            *(uint2*)(g.hb + grow * D + col) = pk;
          }
          float sq = rowsum16(hv[0] * hv[0] + hv[1] * hv[1] + hv[2] * hv[2] + hv[3] * hv[3]);
          if (fr == 0) atomicAdd(g.ss_out + grow, sq);
        } else if constexpr (EPI == E_PLEPROJ) {
          uint2 pk; pk.x = pack2(v[0], v[1]); pk.y = pack2(v[2], v[3]);
          *(uint2*)(g.o0 + (size_t)row * D + col) = pk;
        } else if constexpr (EPI == E_RKV) {
          if (cb < 3072) {
            u16* buf = g.o0 + (size_t)(cb >> 10) * ((size_t)MR * 1024);
            uint2 pk; pk.x = pack2(v[0], v[1]); pk.y = pack2(v[2], v[3]);
            *(uint2*)(buf + (size_t)row * D + (cb & 1023) + fr * 4) = pk;
          } else if (cb < 3456) {
            int which = (cb - 3072) >> 7, c0 = (cb - 3072) & 127;
            u16* buf = g.o1 + (size_t)which * ((size_t)MR * 128);
            if (which == 0) { v[0] = tanhf(v[0]); v[1] = tanhf(v[1]); v[2] = tanhf(v[2]); v[3] = tanhf(v[3]); }
            else if (which == 2) { v[0] = sigm(v[0]); v[1] = sigm(v[1]); v[2] = sigm(v[2]); v[3] = sigm(v[3]); }
            uint2 pk; pk.x = pack2(v[0], v[1]); pk.y = pack2(v[2], v[3]);
            *(uint2*)(buf + (size_t)row * 128 + c0 + fr * 4) = pk;
          }
        } else if constexpr (EPI == E_RWFIN) {
          const int head = cb >> 6;
          size_t idx = (size_t)row * D + col;
          uint2 a0 = *(const uint2*)(g.o0 + idx), a1 = *(const uint2*)(g.o1 + idx), vv = *(const uint2*)(g.o2 + idx);
          float y[4];
          y[0] = bf2f((u16)(a0.x & 0xffff)) + bf2f((u16)(a1.x & 0xffff));
          y[1] = bf2f((u16)(a0.x >> 16)) + bf2f((u16)(a1.x >> 16));
          y[2] = bf2f((u16)(a0.y & 0xffff)) + bf2f((u16)(a1.y & 0xffff));
          y[3] = bf2f((u16)(a0.y >> 16)) + bf2f((u16)(a1.y >> 16));
          float mean = rowsum16(y[0] + y[1] + y[2] + y[3]) * (1.f / 64.f);
#pragma unroll
          for (int e = 0; e < 4; ++e) y[e] -= mean;
          float inv = rsqrtf(rowsum16(y[0] * y[0] + y[1] * y[1] + y[2] * y[2] + y[3] * y[3]) * (1.f / 64.f) + 64e-5f);
          float bon = g.f0[(size_t)row * 16 + head] + g.f0[(size_t)MR * 16 + (size_t)row * 16 + head];
          float vf[4] = {bf2f((u16)(vv.x & 0xffff)), bf2f((u16)(vv.x >> 16)), bf2f((u16)(vv.y & 0xffff)), bf2f((u16)(vv.y >> 16))};
          float o[4];
#pragma unroll
          for (int e = 0; e < 4; ++e) o[e] = (y[e] * inv * lw[e] + lb[e] + bon * vf[e]) * v[e];
          uint2 pk; pk.x = pack2(o[0], o[1]); pk.y = pack2(o[2], o[3]);
          *(uint2*)(g.hb + idx) = pk;
        }
      }
      SLAB_DONE();
    }
  }
#undef SLAB_WRITE
#undef EPI_LOAD
#undef SLAB_DONE
}

template <int EPI> __device__ __forceinline__ void gemm_phase(const GA& g, const GA& g2, LDSC* shm) {
  const int nM = g.mtiles, nN = g.ntiles;
  const int G = gridDim.x;
  const int PN = (nN & 3) == 0 ? 4 : 2, PM = 32 / PN;
  const int sN = nN / PN, sM = nM / PM, nsup = sN * sM;
  const int per = G >> 8;
  const int b = blockIdx.x, x = b & 7, l = (b >> 3) & 31, rep = b >> 8;
  bool pref = false;
  for (int s = x + 8 * rep; s < nsup; s += 8 * per) {
    int sm = s / sN, sn = s % sN;
    int pm = sm * PM + (l % PM), pn = sn * PN + (l / PM);
    int s2 = s + 8 * per;
    bool hn = s2 < nsup;
    int pm2 = (s2 / sN) * PM + (l % PM), pn2 = (s2 % sN) * PN + (l / PM);
    if constexpr (EPI == E_PLEGATE) {
      gemm_tile<E_PLEPROJ>(g2, pm, pn, false, false, pm, pn, shm);
      gemm_tile<E_PLEGATE>(g, pm, pn, false, false, pm, pn, shm);
    } else {
      gemm_tile<EPI>(g, pm, pn, pref, hn, hn ? pm2 : pm, hn ? pn2 : pn, shm);
      pref = hn;
    }
  }
  __syncthreads();
}

__device__ __forceinline__ void phase_mix(const Params& p, int tok0, int ntok) {
  const float* ss1 = (const float*)(p.ws + OFF_SS) + (size_t)1 * MT;
  const float* gain = p.in[7];
  u16* A2 = (u16*)(p.ws + OFF_BIG + BIG_A2);
  int tid = otid(), half = tid >> 8, c4 = (tid & 255) * 4;
  float4 gn = *(const float4*)(gain + c4);
  for (int l0 = blockIdx.x * 2; l0 < ntok; l0 += gridDim.x * 2) {
    int l = l0 + half, tok = tok0 + l;
    int pos, T;
    if (tok < MPROMPT) { pos = tok & 2047; T = 2048; } else { pos = tok - MPROMPT; T = 16384; }
    float4 c = *(const float4*)(p.h + (size_t)tok * D + c4);
    float rc = rstd_of(ss1[tok]);
    float4 hn = {c.x * rc * gn.x, c.y * rc * gn.y, c.z * rc * gn.z, c.w * rc * gn.w};
    float4 av = {0.f, 0.f, 0.f, 0.f};
    if (pos > 0) {
      float4 q = *(const float4*)(p.h + (size_t)(tok - 1) * D + c4);
      float r = rstd_of(ss1[tok - 1]);
      av.x += q.x * r * gn.x; av.y += q.y * r * gn.y; av.z += q.z * r * gn.z; av.w += q.w * r * gn.w;
    }
    if (pos < T - 1) {
      float4 q = *(const float4*)(p.h + (size_t)(tok + 1) * D + c4);
      float r = rstd_of(ss1[tok + 1]);
      av.x += q.x * r * gn.x; av.y += q.y * r * gn.y; av.z += q.z * r * gn.z; av.w += q.w * r * gn.w;
    }
    uint2 a, b;
    a.x = pack2(hn.x, hn.y); a.y = pack2(hn.z, hn.w);
    b.x = pack2(0.5f * av.x, 0.5f * av.y); b.y = pack2(0.5f * av.z, 0.5f * av.w);
    *(uint2*)(A2 + (size_t)l * 2048 + c4) = a;
    *(uint2*)(A2 + (size_t)l * 2048 + 1024 + c4) = b;
  }
}

constexpr int SC_T = 32;
constexpr int SC_ARR = SC_T * 64 * 4;
constexpr int SC_BUF = 6 * SC_ARR;
template <int E> __device__ __forceinline__ float rowsumL(float v) {
  v += dppf<0xB1>(v); v += dppf<0x4E>(v); v += dppf<0x141>(v);
  if (E == 4) v += dppf<0x140>(v);
  return v;
}

template <int E, int R = 1>
__device__ __forceinline__ void scan_item(const Params& p, int seq_loc0, int T, int head, int z, int rowbase, int nw, char* shm) {
  char* big = p.ws + OFF_BIG;
  const u16* Rb = (const u16*)(big + BIG_RKV);
  const u16* Kb = (const u16*)(big + BIG_RKV + SZ_RKV1);
  const u16* Vb = (const u16*)(big + BIG_RKV + 2 * SZ_RKV1);
  const u16* TW = (const u16*)(big + BIG_T);
  const u16* TA = (const u16*)(big + BIG_T + SZ_T1);
  u16* Y = (u16*)(big + (z ? BIG_Y1 : BIG_Y0));
  float* bonus = (float*)(p.ws + OFF_BONUS) + (size_t)z * MR * 16;
  const u16* W2 = (const u16*)(p.ws + OFF_W2W) + (size_t)z * 1024 * 64;
  const u16* A2w = (const u16*)(p.ws + OFF_W2A) + (size_t)z * 1024 * 64;
  const float* w0 = p.in[14] + z * 1024 + head * 64;
  const float* a0 = p.in[17] + z * 1024 + head * 64;
  const int tid = otid(), wv = tid >> 6, lane = tid & 63, fr = lane & 15, fq = lane >> 4;
  float* Ybuf = (float*)(shm + 2 * SC_BUF);
  const int si = tid >> 4, ec4 = (tid & 15) * 4;
  float4 ckk = *(const float4*)(p.in[22] + head * 64 + ec4);
  float4 cka = *(const float4*)(p.in[23] + head * 64 + ec4);
  float4 crk = *(const float4*)(p.in[24] + head * 64 + ec4);
  const int mt = wv >> 2, ntl = wv & 3;
  bf16x8 Bw[2], Ba[2];
#pragma unroll
  for (int ks = 0; ks < 2; ++ks) {
    Bw[ks] = *(const bf16x8*)(W2 + (size_t)(head * 64 + ntl * 16 + fr) * 64 + ks * 32 + fq * 8);
    Ba[ks] = *(const bf16x8*)(A2w + (size_t)(head * 64 + ntl * 16 + fr) * 64 + ks * 32 + fq * 8);
  }
  const float w0c = w0[ntl * 16 + fr], a0c = a0[ntl * 16 + fr];
  constexpr int LPR = 64 / E, RPW = R * (64 / LPR), NP = E / 2, NQ = E / 4;
  const int le = lane % LPR, row0 = rowbase + wv * RPW + (lane / LPR) * R;
  f32x2 st[R][NP];
#pragma unroll
  for (int r = 0; r < R; ++r)
#pragma unroll
    for (int q = 0; q < NP; ++q) st[r][q] = f32x2{0.f, 0.f};
  float skc = 0.f, sklast = 0.f;
  f32x2 ulast0 = {0.f, 0.f}, ulast1 = {0.f, 0.f};
  f32x4 kalast = {0.f, 0.f, 0.f, 0.f};
  const int nch = T / SC_T;
  uint2 pr, pk, pv; bf16x8 Aw[2], Aa[2];
  auto tok_of = [&](int t) { return seq_loc0 + (z ? (T - 1 - t) : t); };
#define SC_LOAD(c) do { \
    int tk_ = tok_of((c) * SC_T + si); \
    pr = *(const uint2*)(Rb + (size_t)tk_ * D + head * 64 + ec4); \
    pk = *(const uint2*)(Kb + (size_t)tk_ * D + head * 64 + ec4); \
    pv = *(const uint2*)(Vb + (size_t)tk_ * D + head * 64 + ec4); \
    int tm_ = tok_of((c) * SC_T + mt * 16 + fr); \
    _Pragma("unroll") for (int ks = 0; ks < 2; ++ks) { \
      Aw[ks] = *(const bf16x8*)(TW + (size_t)tm_ * 128 + z * 64 + ks * 32 + fq * 8); \
      Aa[ks] = *(const bf16x8*)(TA + (size_t)tm_ * 128 + z * 64 + ks * 32 + fq * 8); } } while (0)
#define SC_LORA(b) do { \
    f32x4 cw = {0.f, 0.f, 0.f, 0.f}, ca = {0.f, 0.f, 0.f, 0.f}; \
    _Pragma("unroll") for (int ks = 0; ks < 2; ++ks) { \
      cw = __builtin_amdgcn_mfma_f32_16x16x32_bf16(Aw[ks], Bw[ks], cw, 0, 0, 0); \
      ca = __builtin_amdgcn_mfma_f32_16x16x32_bf16(Aa[ks], Ba[ks], ca, 0, 0, 0); } \
    float* Wl_ = (float*)(shm + (b) * SC_BUF); float* Al_ = (float*)(shm + (b) * SC_BUF + 3 * SC_ARR); \
    _Pragma("unroll") for (int j = 0; j < 4; ++j) { \
      int st_ = mt * 16 + fq * 4 + j; \
      Wl_[st_ * 64 + ntl * 16 + fr] = __expf(-0.6065306597126334f * sigm(w0c + cw[j])); \
      Al_[st_ * 64 + ntl * 16 + fr] = sigm(a0c + ca[j]); } } while (0)
#define SC_ELEM(b, c) do { \
    char* bb_ = shm + (b) * SC_BUF; \
    float4 a4 = *(const float4*)(bb_ + 3 * SC_ARR + (si * 64 + ec4) * 4); \
    float r0 = bf2f((u16)(pr.x & 0xffff)), r1 = bf2f((u16)(pr.x >> 16)), r2 = bf2f((u16)(pr.y & 0xffff)), r3 = bf2f((u16)(pr.y >> 16)); \
    float k0 = bf2f((u16)(pk.x & 0xffff)), k1 = bf2f((u16)(pk.x >> 16)), k2 = bf2f((u16)(pk.y & 0xffff)), k3 = bf2f((u16)(pk.y >> 16)); \
    float v0 = bf2f((u16)(pv.x & 0xffff)), v1 = bf2f((u16)(pv.x >> 16)), v2 = bf2f((u16)(pv.y & 0xffff)), v3 = bf2f((u16)(pv.y >> 16)); \
    float q0 = k0 * ckk.x, q1 = k1 * ckk.y, q2 = k2 * ckk.z, q3 = k3 * ckk.w; \
    float n2 = rowsum16(q0 * q0 + q1 * q1 + q2 * q2 + q3 * q3); \
    float inv_ = rsqrtf(fmaxf(n2, 1e-24f)); \
    q0 *= inv_; q1 *= inv_; q2 *= inv_; q3 *= inv_; \
    float d0 = k0 * (1.f + (a4.x - 1.f) * cka.x), d1 = k1 * (1.f + (a4.y - 1.f) * cka.y), d2 = k2 * (1.f + (a4.z - 1.f) * cka.z), d3 = k3 * (1.f + (a4.w - 1.f) * cka.w); \
    float bn = rowsum16(r0 * d0 * crk.x + r1 * d1 * crk.y + r2 * d2 * crk.z + r3 * d3 * crk.w); \
    if (rowbase == 0 && (tid & 15) == 0) bonus[(size_t)tok_of((c) * SC_T + si) * 16 + head] = bn; \
    *(float4*)(bb_ + 1 * SC_ARR + (si * 64 + ec4) * 4) = float4{q0, q1, q2, q3}; \
    *(float4*)(bb_ + 2 * SC_ARR + (si * 64 + ec4) * 4) = float4{d0, d1, d2, d3}; \
    *(float4*)(bb_ + 3 * SC_ARR + (si * 64 + ec4) * 4) = float4{q0 * a4.x, q1 * a4.y, q2 * a4.z, q3 * a4.w}; \
    *(float4*)(bb_ + 4 * SC_ARR + (si * 64 + ec4) * 4) = float4{r0, r1, r2, r3}; \
    *(float4*)(bb_ + 5 * SC_ARR + (si * 64 + ec4) * 4) = float4{v0, v1, v2, v3}; } while (0)

  __syncthreads();
  SC_LOAD(0);
  SC_LORA(0);
  __syncthreads();
  SC_ELEM(0, 0);
  __syncthreads();
  for (int c = 0; c < nch; ++c) {
    const int b = c & 1;
    if (c + 1 < nch) SC_LOAD(c + 1);
    const char* bb = shm + b * SC_BUF;
    if (wv < nw) {
      f32x4 cw[NQ], ckq[NQ], ckd[NQ], cka4[NQ], cr[NQ]; float vv[R];
#define SC_LD(i_, W_, KK_, KD_, KA_, R_, V_) do { _Pragma("unroll") for (int q = 0; q < NQ; ++q) { \
        W_[q] = *(const f32x4*)(bb + 0 * SC_ARR + ((i_) * 64 + le * E + q * 4) * 4); \
        KK_[q] = *(const f32x4*)(bb + 1 * SC_ARR + ((i_) * 64 + le * E + q * 4) * 4); \
        KD_[q] = *(const f32x4*)(bb + 2 * SC_ARR + ((i_) * 64 + le * E + q * 4) * 4); \
        KA_[q] = *(const f32x4*)(bb + 3 * SC_ARR + ((i_) * 64 + le * E + q * 4) * 4); \
        R_[q] = *(const f32x4*)(bb + 4 * SC_ARR + ((i_) * 64 + le * E + q * 4) * 4); } \
        _Pragma("unroll") for (int r = 0; r < R; ++r) V_[r] = *(const float*)(bb + 5 * SC_ARR + ((i_) * 64 + row0 + r) * 4); } while (0)
      SC_LD(0, cw, ckq, ckd, cka4, cr, vv);
      f32x4 mw_[NQ], mkq[NQ], mkd[NQ], mka[NQ], mr[NQ]; float mvv[R];
      if constexpr (E == 4) {
        SC_LD(1, mw_, mkq, mkd, mka, mr, mvv);
        f32x2 pu = ulast0 * ckq[0].lo + ulast1 * ckq[0].hi;
        f32x2 pc = kalast.lo * ckq[0].lo + kalast.hi * ckq[0].hi;
        skc = rowsumL<E>(pu.x + pu.y) - sklast * rowsumL<E>(pc.x + pc.y);
      }
#pragma unroll 8
      for (int i = 0; i < SC_T; ++i) {
        f32x4 nw_[NQ], nkq[NQ], nkd[NQ], nka[NQ], nr[NQ]; float nvv[R];
        const int in_ = (i + (E == 4 ? 2 : 1)) & (SC_T - 1);
        SC_LD(in_, nw_, nkq, nkd, nka, nr, nvv);
        float sk[R], yy[R];
        f32x2 uq[R][NP];
        if constexpr (E == 4) {
          f32x2 u0 = st[0][0] * cw[0].lo + ckd[0].lo * vv[0];
          f32x2 u1 = st[0][1] * cw[0].hi + ckd[0].hi * vv[0];
          st[0][0] = u0 - cka4[0].lo * skc;
          st[0][1] = u1 - cka4[0].hi * skc;
          f32x2 pu = u0 * mkq[0].lo + u1 * mkq[0].hi;
          f32x2 pc = cka4[0].lo * mkq[0].lo + cka4[0].hi * mkq[0].hi;
          const float rr_ = rowsumL<E>(pu.x + pu.y), cc_ = rowsumL<E>(pc.x + pc.y);
          ulast0 = u0; ulast1 = u1; kalast = cka4[0]; sklast = skc;
          skc = rr_ - skc * cc_;
          f32x2 ya = st[0][0] * cr[0].lo + st[0][1] * cr[0].hi;
          yy[0] = ya.x + ya.y;
        } else {
#pragma unroll
        for (int r = 0; r < R; ++r) {
          f32x2 da = st[r][0] * ckq[0].lo;
#pragma unroll
          for (int q = 1; q < NP; ++q) da += st[r][q] * ((q & 1) ? ckq[q >> 1].hi : ckq[q >> 1].lo);
#pragma unroll
          for (int q = 0; q < NP; ++q) {
            f32x2 kdq = (q & 1) ? ckd[q >> 1].hi : ckd[q >> 1].lo;
            f32x2 wq = (q & 1) ? cw[q >> 1].hi : cw[q >> 1].lo;
            uq[r][q] = st[r][q] * wq + kdq * vv[r];
          }
          sk[r] = da.x + da.y;
        }
#pragma unroll
        for (int r = 0; r < R; ++r) sk[r] = rowsumL<E>(sk[r]);
#pragma unroll
        for (int r = 0; r < R; ++r) {
#pragma unroll
          for (int q = 0; q < NP; ++q) {
            f32x2 kaq = (q & 1) ? cka4[q >> 1].hi : cka4[q >> 1].lo;
            st[r][q] = uq[r][q] - kaq * sk[r];
          }
          f32x2 ya = st[r][0] * cr[0].lo;
#pragma unroll
          for (int q = 1; q < NP; ++q) ya += st[r][q] * ((q & 1) ? cr[q >> 1].hi : cr[q >> 1].lo);
          yy[r] = ya.x + ya.y;
        }
        }
#pragma unroll
        for (int r = 0; r < R; ++r) yy[r] = rowsumL<E>(yy[r]);
        if (le == 0) {
#pragma unroll
          for (int r = 0; r < R; ++r) Ybuf[i * 64 + row0 + r] = yy[r];
        }
        if constexpr (E == 4) {
#pragma unroll
          for (int q = 0; q < NQ; ++q) { cw[q] = mw_[q]; ckq[q] = mkq[q]; ckd[q] = mkd[q]; cka4[q] = mka[q]; cr[q] = mr[q];
                                         mw_[q] = nw_[q]; mkq[q] = nkq[q]; mkd[q] = nkd[q]; mka[q] = nka[q]; mr[q] = nr[q]; }
#pragma unroll
          for (int r = 0; r < R; ++r) { vv[r] = mvv[r]; mvv[r] = nvv[r]; }
        } else {
#pragma unroll
          for (int q = 0; q < NQ; ++q) { cw[q] = nw_[q]; ckq[q] = nkq[q]; ckd[q] = nkd[q]; cka4[q] = nka[q]; cr[q] = nr[q]; }
#pragma unroll
          for (int r = 0; r < R; ++r) vv[r] = nvv[r];
        }
      }
#undef SC_LD
    }
    if (c + 1 < nch) SC_LORA(b ^ 1);
    __syncthreads();
    if (c + 1 < nch) SC_ELEM(b ^ 1, c + 1);
    {
      int tk = tok_of(c * SC_T + si);
      int rr = (tid & 15) * 4;
      if (rr >= rowbase && rr < rowbase + nw * RPW) {
        float4 yv = *(const float4*)(Ybuf + si * 64 + rr);
        uint2 pk2; pk2.x = pack2(yv.x, yv.y); pk2.y = pack2(yv.z, yv.w);
        *(uint2*)(Y + (size_t)tk * D + head * 64 + rr) = pk2;
      }
    }
    __syncthreads();
  }
#undef SC_LOAD
#undef SC_LORA
#undef SC_ELEM
}

__device__ __forceinline__ void phase_scan(const Params& p, char* shm) {
  const int G = gridDim.x, b = blockIdx.x;
  const int nS = 128, nP = 16 * 32;
  int j, step;
  if (G > nS) { if (b < nS) { j = b; step = 1 << 30; } else { j = nS + (b - nS); step = G - nS; } }
  else { j = b; step = G; }
  for (; j < nS + nP; j += step) {
    if (j < nS) scan_item<4>(p, MPROMPT, 16384, (j >> 3) & 15, (j >> 2) & 1, (j & 3) * 16, 4, shm);
    else { int q = j - nS; scan_item<8, 2>(p, (q >> 5) * 2048, 2048, (q >> 1) & 15, q & 1, 0, 4, shm); }
  }
}

__device__ __forceinline__ void phase_natt(const Params& p, u16* Odst, char* shm) {
  char* big = p.ws + OFF_BIG;
  const u16* Q = (const u16*)(big + BIG_Q);
  const u16* Kb = (const u16*)(big + BIG_K);
  const u16* Vt = (const u16*)(big + BIG_VT);
  const int tid = otid(), wv = tid >> 6, lane = tid & 63, fr = lane & 15, fq = lane >> 4;
  const int hg = blockIdx.x & 3, h = hg * 8 + wv;
  float* tab = (float*)(shm + wv * 3840);
  {
    const float* rp = p.in[30] + (size_t)h * 15 * 31;
    for (int idx = lane; idx < 960; idx += 64) tab[idx] = 0.f;
    asm volatile("s_waitcnt lgkmcnt(0)" ::: "memory");
    for (int idx = lane; idx < 465; idx += 64) { int r = idx / 31, c = idx - r * 31; tab[r * 64 + 16 + c] = rp[idx]; }
    asm volatile("s_waitcnt lgkmcnt(0)" ::: "memory");
  }
  const int nqb = MT / 16, qstep = gridDim.x >> 2;
  for (int qb = blockIdx.x >> 2; qb < nqb; qb += qstep) {
    int tb = qb * 16;
    int seqbase, T, loc;
    if (tb < MPROMPT) { seqbase = tb & ~2047; T = 2048; loc = tb & 2047; } else { seqbase = MPROMPT; T = 16384; loc = tb - MPROMPT; }
    int rows = T >> 6, i = loc >> 6, cbq = (loc & 63) >> 4;
    int rs = min(max(i - 4, 0), rows - 8);
    int kvs = min(max(cbq * 16 - 8, 0), 32);
    int qc = cbq * 16 + fr;
    int ws_ = min(max(qc - 8, 0), 48);
    bf16x8 qf = *(const bf16x8*)(Q + (size_t)(tb + fr) * D + h * 32 + fq * 8);
    unsigned vm = 0;
#pragma unroll
    for (int e = 0; e < 8; ++e) { int kcol = kvs + fq * 8 + e; vm |= ((kcol >= ws_) && (kcol < ws_ + 16)) ? (1u << e) : 0u; }
    const float* trow = tab + (rs - i + 7) * 64 + 16 + (kvs + fq * 8 - qc + 15);
    bf16x8 kf[8][2];
#pragma unroll
    for (int r = 0; r < 8; ++r)
#pragma unroll
      for (int hb2 = 0; hb2 < 2; ++hb2) {
        int kcolA = kvs + (fr >> 2) * 8 + hb2 * 4 + (fr & 3);
        size_t ktok = (size_t)seqbase + (size_t)(rs + r) * 64 + kcolA;
        kf[r][hb2] = *(const bf16x8*)(Kb + ktok * D + h * 32 + fq * 8);
      }
    f32x4 sc[8][2];
    float mx = -1e30f;
#pragma unroll
    for (int r = 0; r < 8; ++r) {
#pragma unroll
      for (int hb2 = 0; hb2 < 2; ++hb2) {
        f32x4 a = __builtin_amdgcn_mfma_f32_16x16x32_bf16(kf[r][hb2], qf, f32x4{0.f, 0.f, 0.f, 0.f}, 0, 0, 0);
#pragma unroll
        for (int j = 0; j < 4; ++j) {
          float sv = ((vm >> (hb2 * 4 + j)) & 1u) ? a[j] + trow[r * 64 + hb2 * 4 + j] : -1e30f;
          a[j] = sv; mx = fmaxf(mx, sv);
        }
        sc[r][hb2] = a;
      }
    }
    mx = fmaxf(mx, __shfl_xor(mx, 16));
    mx = fmaxf(mx, __shfl_xor(mx, 32));
    float sum = 0.f;
    f32x4 o0 = {0.f, 0.f, 0.f, 0.f}, o1 = {0.f, 0.f, 0.f, 0.f};
#pragma unroll
    for (int r = 0; r < 8; ++r) {
      bf16x8 pf;
#pragma unroll
      for (int e = 0; e < 8; ++e) {
        float pe = __expf(sc[r][e >> 2][e & 3] - mx);
        sum += pe;
        pf[e] = (short)f2bf(pe);
      }
      size_t vbase = (size_t)seqbase + (size_t)(rs + r) * 64 + kvs + fq * 8;
      bf16x8 v0 = *(const bf16x8*)(Vt + (size_t)(h * 32 + fr) * MT + vbase);
      bf16x8 v1 = *(const bf16x8*)(Vt + (size_t)(h * 32 + 16 + fr) * MT + vbase);
      o0 = __builtin_amdgcn_mfma_f32_16x16x32_bf16(v0, pf, o0, 0, 0, 0);
      o1 = __builtin_amdgcn_mfma_f32_16x16x32_bf16(v1, pf, o1, 0, 0, 0);
    }
    sum += __shfl_xor(sum, 16);
    sum += __shfl_xor(sum, 32);
    float inv = 1.f / sum;
    uint2 w0, w1;
    w0.x = pack2(o0[0] * inv, o0[1] * inv); w0.y = pack2(o0[2] * inv, o0[3] * inv);
    w1.x = pack2(o1[0] * inv, o1[1] * inv); w1.y = pack2(o1[2] * inv, o1[3] * inv);
    *(uint2*)(Odst + (size_t)(tb + fr) * D + h * 32 + fq * 4) = w0;
    *(uint2*)(Odst + (size_t)(tb + fr) * D + h * 32 + 16 + fq * 4) = w1;
  }
}

__device__ __forceinline__ void phase_final(const Params& p) {
  const float* ss8 = (const float*)(p.ws + OFF_SS) + (size_t)8 * MT;
  const float* gain = p.in[11];
  int tid = otid(), half = tid >> 8, c4 = (tid & 255) * 4;
  float4 gn = *(const float4*)(gain + c4);
  for (int r0 = blockIdx.x * 2; r0 < MT; r0 += gridDim.x * 2) {
    int row = r0 + half;
    float rs = rstd_of(ss8[row]);
    float4 v = *(float4*)(p.h + (size_t)row * D + c4);
    v.x *= rs * gn.x; v.y *= rs * gn.y; v.z *= rs * gn.z; v.w *= rs * gn.w;
    *(float4*)(p.h + (size_t)row * D + c4) = v;
  }
}

constexpr int NPHASE = 20;
#ifndef PROBE_MASK
#define PROBE_MASK 0ull
#endif

enum { K_NONE = 0, K_PREP, K_FFN1, K_FFN2, K_MIX, K_RKV, K_SCAN, K_FIN, K_RWO, K_PPROJ, K_PGATE, K_CONVH, K_QKV, K_NATT, K_NAO, K_FINAL };

__device__ __forceinline__ void run_phase(const Params& p, int ph, LDSC* shml) {
  char* shm = (char*)shml;
  char* ws = p.ws;
  float* ss = (float*)(ws + OFF_SS);
  u16* hb = (u16*)(ws + OFF_HB);
  char* big = ws + OFF_BIG;
  int kind = K_NONE, a = 0, b = 0, c = 0, d = 0;
  switch (ph) {
    case 0: kind = K_PREP; break;
    case 1: kind = K_FFN1; a = 0; b = 0; c = 0; d = 0; break;
    case 2: kind = K_FFN2; a = 0; b = 0; c = 1; break;
    case 3: kind = K_MIX; break;
    case 4: kind = K_RKV; break;
    case 5: kind = K_SCAN; break;
    case 6: kind = K_FIN; break;
    case 7: kind = K_RWO; break;
    case 8: kind = K_FFN1; a = 0; b = 1; c = 2; d = 1; break;
    case 9: kind = K_FFN2; a = 0; b = 1; c = 3; break;
    case 10: kind = K_PGATE; a = 0; b = 3; c = 4; break;
    case 11: kind = K_FFN1; a = 1; b = 0; c = 4; d = 0; break;
    case 12: kind = K_FFN2; a = 1; b = 0; c = 5; break;
    case 13: kind = K_QKV; break;
    case 14: kind = K_NATT; break;
    case 15: kind = K_NAO; break;
    case 16: kind = K_FFN1; a = 1; b = 1; c = 6; d = 1; break;
    case 17: kind = K_FFN2; a = 1; b = 1; c = 7; break;
    case 18: kind = K_PGATE; a = 1; b = 7; c = 8; break;
    case 19: kind = K_FINAL; break;
    default: break;
  }
  GA g;
  g.A = nullptr; g.Bt = nullptr; g.K = 0; g.N = 0; g.mtiles = 0; g.ntiles = 0; g.rowoff = 0;
  g.ss_in = nullptr; g.ss_out = nullptr; g.bias = nullptr; g.scale = 1.f; g.h = p.h; g.hb = hb;
  g.o0 = nullptr; g.o1 = nullptr; g.o2 = nullptr; g.f0 = nullptr; g.f1 = nullptr; g.f2 = nullptr;
  GA g2 = g;
  int epi = -1;
  const int tok0 = 0, ntok = MT;
  switch (kind) {
    case K_PREP: phase_prep(p, shm); break;
    case K_FFN1:
      if (d) conv_p(p, a);
      g.A = (a == 1 && b == 0) ? (const u16*)(big + BIG_HBALT) : hb;
      g.Bt = (const u16*)(ws + OFF_WIN + (size_t)(a * 2 + b) * SZ_WIN); g.K = 1024; g.N = 5632;
      g.mtiles = MT / 256; g.ntiles = 22; g.ss_in = ss + (size_t)c * MT; g.o0 = (u16*)(big + BIG_ACTB);
      epi = E_SWIGLU; break;
    case K_FFN2:
      g.A = (const u16*)(big + BIG_ACTB); g.Bt = (const u16*)(ws + OFF_WOUT + (size_t)(a * 2 + b) * SZ_WOUT); g.K = DFF; g.N = 1024;
      g.mtiles = MT / 256; g.ntiles = 4; g.ss_out = ss + (size_t)c * MT; g.scale = 0.5f;
      if (a == 0 && b == 0) g.hb = nullptr;
      epi = E_RESID; break;
    case K_MIX: phase_mix(p, tok0, ntok); break;
    case K_RKV:
      g.A = (const u16*)(big + BIG_A2); g.Bt = (const u16*)(ws + OFF_WRKV); g.K = 2048; g.N = 3456;
      g.mtiles = ntok / 256; g.ntiles = 14; g.o0 = (u16*)(big + BIG_RKV); g.o1 = (u16*)(big + BIG_T);
      epi = E_RKV; break;
    case K_SCAN: phase_scan(p, shm); break;
    case K_FIN:
      g.A = (const u16*)(big + BIG_T + 2 * SZ_T1); g.Bt = (const u16*)(ws + OFF_WG2); g.K = 128; g.N = 1024;
      g.mtiles = ntok / 256; g.ntiles = 4;
      g.o0 = (u16*)(big + BIG_Y0); g.o1 = (u16*)(big + BIG_Y1); g.o2 = (u16*)(big + BIG_RKV + 2 * SZ_RKV1);
      g.hb = (u16*)(big + BIG_RKV + SZ_RKV1);
      g.f0 = (const float*)(ws + OFF_BONUS); g.f1 = p.in[25]; g.f2 = p.in[26];
      epi = E_RWFIN; break;
    case K_RWO:
      g.A = (const u16*)(big + BIG_RKV + SZ_RKV1); g.Bt = (const u16*)(ws + OFF_WRWO); g.K = 1024; g.N = 1024;
      g.mtiles = ntok / 256; g.ntiles = 4; g.rowoff = tok0; g.ss_out = ss + (size_t)2 * MT; g.scale = 1.f;
      epi = E_RESID; break;
    case K_PGATE:
      g2 = g;
      g2.A = (const u16*)(ws + OFF_PBI); g2.Bt = (const u16*)(ws + OFF_WPP) + (size_t)a * 1024 * 256; g2.K = 256; g2.N = 1024;
      g2.mtiles = MT / 256; g2.ntiles = 4; g2.o0 = (u16*)(big + BIG_PB);
      g.hb = a == 0 ? (u16*)(big + BIG_HBALT) : nullptr;
      g.A = hb; g.Bt = (const u16*)(ws + OFF_WPG) + (size_t)a * 1024 * 1024; g.K = 1024; g.N = 1024;
      g.mtiles = MT / 256; g.ntiles = 4; g.ss_in = ss + (size_t)b * MT; g.ss_out = ss + (size_t)c * MT; g.o0 = (u16*)(big + BIG_PB);
      epi = E_PLEGATE; break;
    case K_QKV:
      g.A = hb; g.Bt = (const u16*)(ws + OFF_WQKV); g.K = 1024; g.N = 3072; g.mtiles = MT / 256; g.ntiles = 12;
      g.ss_in = ss + (size_t)5 * MT; g.bias = p.in[29];
      g.o0 = (u16*)(big + BIG_Q); g.o1 = (u16*)(big + BIG_K); g.o2 = (u16*)(big + BIG_VT);
      epi = E_QKV; break;
    case K_NATT:
#ifdef PROBE_NATT
      phase_natt(p, hb, shm); __syncthreads();
#endif
      phase_natt(p, (u16*)(big + BIG_Q), shm); break;
    case K_NAO:
      g.A = (const u16*)(big + BIG_Q); g.Bt = (const u16*)(ws + OFF_WNAO); g.K = 1024; g.N = 1024; g.mtiles = MT / 256; g.ntiles = 4;
      g.ss_out = ss + (size_t)6 * MT; g.bias = p.in[32]; g.scale = 1.f;
      epi = E_RESID; break;
    case K_FINAL: phase_final(p); break;
    default: break;
  }
  switch (epi) {
    case E_SWIGLU: gemm_phase<E_SWIGLU>(g, g2, shml); break;
    case E_RESID: gemm_phase<E_RESID>(g, g2, shml); break;
    case E_PLEGATE: gemm_phase<E_PLEGATE>(g, g2, shml); break;
    case E_RKV: gemm_phase<E_RKV>(g, g2, shml); break;
    case E_RWFIN: gemm_phase<E_RWFIN>(g, g2, shml); break;
    case E_QKV: gemm_phase<E_QKV>(g, g2, shml); break;
    default: break;
  }
}

__device__ __forceinline__ void grid_barrier(unsigned* bar, unsigned& nbar) {
  asm volatile("s_waitcnt vmcnt(0)" ::: "memory");
  __syncthreads();
  nbar += 1;
  if (otid() == 0) {
    __builtin_amdgcn_s_waitcnt(0);
    __builtin_amdgcn_fence(__ATOMIC_RELEASE, "agent");
    asm volatile("s_waitcnt vmcnt(0)" ::: "memory");
    __hip_atomic_fetch_add(bar, 1u, __ATOMIC_RELAXED, __HIP_MEMORY_SCOPE_AGENT);
    const unsigned target = nbar * gridDim.x;
    while (__hip_atomic_load(bar, __ATOMIC_RELAXED, __HIP_MEMORY_SCOPE_AGENT) < target) __builtin_amdgcn_s_sleep(1);
    __builtin_amdgcn_fence(__ATOMIC_ACQUIRE, "agent");
    asm volatile("s_waitcnt vmcnt(0)" ::: "memory");
  }
  __syncthreads();
}

__global__ void __launch_bounds__(NTHR, 2) fwd_megakernel(Params p, int ph_lo, int ph_hi) {
  __shared__ __attribute__((aligned(1024))) char shm[131072];
  cg::grid_group grid = cg::this_grid();
  unsigned* bar = (unsigned*)(p.ws + OFF_BAR);
  if (blockIdx.x == 0 && otid() == 0) __hip_atomic_store(bar, 0u, __ATOMIC_RELAXED, __HIP_MEMORY_SCOPE_AGENT);
  unsigned nbar = 0;
  for (int ph = ph_lo; ph < ph_hi; ++ph) {
#if PROBE_MASK
    if ((PROBE_MASK >> ph) & 1ull) { run_phase(p, ph, (LDSC*)shm); if (ph == ph_lo) grid.sync(); else grid_barrier(bar, nbar); }
#endif
    run_phase(p, ph, (LDSC*)shm);
    if (ph + 1 < ph_hi) {
      if (ph == ph_lo) grid.sync(); else grid_barrier(bar, nbar);
    }
  }
}

extern "C" void kernel_launch(void* const* d_in, const int* in_sizes, int n_in, void* d_out, int out_size, void* d_ws, size_t ws_size,
                              hipStream_t stream) {
  static int grid_blocks = 0;
  if (!grid_blocks) {
    int dev = 0, cus = 0, per_cu = 0;
    hipGetDevice(&dev);
    hipDeviceGetAttribute(&cus, hipDeviceAttributeMultiprocessorCount, dev);
    hipOccupancyMaxActiveBlocksPerMultiprocessor(&per_cu, fwd_megakernel, NTHR, 0);
    (void)per_cu;
    grid_blocks = 256;
    if (cus < 256) { fprintf(stderr, "device has %d CUs, this kernel needs 256\n", cus); grid_blocks = -1; }
  }
  if (grid_blocks < 0) return;
  if (ws_size < OFF_BIG + BIG_T + 3 * SZ_T1) return;
  Params p{};
  for (int i = 0; i < 33; ++i) p.in[i] = (const float*)d_in[i];
  p.h = (float*)d_out;
  p.ws = (char*)d_ws;
  int lo = 0, hi = NPHASE;
  void* args[] = {&p, &lo, &hi};
  hipError_t e = hipLaunchCooperativeKernel((void*)fwd_megakernel, dim3(grid_blocks), dim3(NTHR), args, 0, stream);
  if (e != hipSuccess) fprintf(stderr, "cooperative launch failed: %s (grid %d)\n", hipGetErrorString(e), grid_blocks);
}
```

```cpp
#include <hip/hip_runtime.h>
#include <hip/hip_cooperative_groups.h>
#include <cstdio>
#include <cstdint>
namespace cg = cooperative_groups;

typedef unsigned short u16;
using bf16x8 = __attribute__((ext_vector_type(8))) short;
using f32x4 = __attribute__((ext_vector_type(4))) float;
using f32x2 = __attribute__((ext_vector_type(2))) float;
using i32x4 = __attribute__((ext_vector_type(4))) int;
typedef __attribute__((address_space(3))) char LDSC;
typedef __attribute__((address_space(3))) unsigned LDSU;
typedef __attribute__((address_space(3))) bf16x8 LDS_BF8;

constexpr int MT = 49152;
constexpr int MPROMPT = 32768;
constexpr int MR = MT;
constexpr int D = 1024;
constexpr int DFF = 2816;
constexpr int NTHR = 512;

constexpr size_t SZ_WIN = (size_t)5632 * 1024 * 2;
constexpr size_t SZ_WOUT = (size_t)1024 * 2816 * 2;
constexpr size_t OFF_WIN = 0;
constexpr size_t OFF_WOUT = OFF_WIN + 4 * SZ_WIN;
constexpr size_t OFF_WPG = OFF_WOUT + 4 * SZ_WOUT;
constexpr size_t OFF_WPP = OFF_WPG + 2 * (size_t)1024 * 1024 * 2;
constexpr size_t OFF_WRKV = OFF_WPP + 2 * (size_t)1024 * 256 * 2;
constexpr size_t OFF_W2W = OFF_WRKV + (size_t)3584 * 2048 * 2;
constexpr size_t OFF_W2A = OFF_W2W + 2 * (size_t)1024 * 64 * 2;
constexpr size_t OFF_WG2 = OFF_W2A + 2 * (size_t)1024 * 64 * 2;
constexpr size_t OFF_WRWO = OFF_WG2 + (size_t)1024 * 128 * 2;
constexpr size_t OFF_WQKV = OFF_WRWO + (size_t)1024 * 1024 * 2;
constexpr size_t OFF_WNAO = OFF_WQKV + (size_t)3072 * 1024 * 2;
constexpr size_t OFF_SS = OFF_WNAO + (size_t)1024 * 1024 * 2;
constexpr size_t OFF_BONUS = OFF_SS + 9 * (size_t)MT * 4;
constexpr size_t OFF_BAR = OFF_BONUS + 2 * (size_t)MR * 16 * 4;
constexpr size_t OFF_HB = OFF_BAR + 256;
constexpr size_t OFF_PBI = OFF_HB + (size_t)MT * 1024 * 2;
constexpr size_t OFF_BIG = OFF_PBI + (size_t)MT * 256 * 2;
constexpr size_t BIG_ACTB = 0;
constexpr size_t BIG_PB = 0;
constexpr size_t BIG_HBALT = (size_t)MT * 2816 * 2;
constexpr size_t BIG_A2 = 0;
constexpr size_t BIG_Y0 = 0;
constexpr size_t BIG_Y1 = (size_t)MR * 1024 * 2;
constexpr size_t BIG_RKV = (size_t)MR * 2048 * 2;
constexpr size_t SZ_RKV1 = (size_t)MR * 1024 * 2;
constexpr size_t BIG_T = BIG_RKV + 3 * SZ_RKV1;
constexpr size_t SZ_T1 = (size_t)MR * 128 * 2;
constexpr size_t BIG_Q = 0;
constexpr size_t BIG_K = (size_t)MT * 1024 * 2;
constexpr size_t BIG_VT = 2 * (size_t)MT * 1024 * 2;

struct Params {
  const float* in[33];
  float* h;
  char* ws;
};

__device__ __forceinline__ u16 f2bf(float f) {
  unsigned u = __float_as_uint(f);
  u += 0x7fffu + ((u >> 16) & 1u);
  return (u16)(u >> 16);
}
__device__ __forceinline__ float bf2f(u16 h) { return __uint_as_float(((unsigned)h) << 16); }
__device__ __forceinline__ unsigned pack2(float a, float b) { return (unsigned)f2bf(a) | ((unsigned)f2bf(b) << 16); }
__device__ __forceinline__ float sigm(float x) { return __builtin_amdgcn_rcpf(1.f + __expf(-x)); }
template <int CTRL> __device__ __forceinline__ float dppf(float v) {
  return __int_as_float(__builtin_amdgcn_update_dpp(0, __float_as_int(v), CTRL, 0xf, 0xf, true));
}
__device__ __forceinline__ float rowsum16(float v) {
  v += dppf<0xB1>(v);
  v += dppf<0x4E>(v);
  v += dppf<0x141>(v);
  v += dppf<0x140>(v);
  return v;
}
__device__ __forceinline__ int otid() { int t = __builtin_amdgcn_workitem_id_x(); asm volatile("" : "+v"(t)); return t; }
__device__ __forceinline__ float rstd_of(float ss) { return rsqrtf(ss * (1.f / 1024.f) + 1e-6f); }

struct PrepJob {
  const float* src; int K, N, ldsrc;
  u16* dst; int dld, koff, noff;
  const float* sc; int mode;
  int perm;
};

__device__ __forceinline__ void prep_tiles(const PrepJob& j, char* shm, int nblk, int bid) {
  u16* tl = (u16*)shm;
  int kt = j.K >> 6, nt = j.N >> 6, tiles = kt * nt;
  int tid = otid();
  for (int t = bid; t < tiles; t += nblk) {
    int k0 = (t / nt) << 6, n0 = (t % nt) << 6;
#pragma unroll
    for (int it = 0; it < 2; ++it) {
      int kk = (tid >> 4) + 32 * it, nn4 = (tid & 15) * 4;
      float4 v = *(const float4*)(j.src + (size_t)(k0 + kk) * j.ldsrc + n0 + nn4);
      float s = 1.f;
      if (j.mode == 1 || j.mode == 3) s = j.sc[k0 + kk];
      else if (j.mode == 2) s = 1.f - j.sc[k0 + kk];
      tl[(nn4 + 0) * 72 + kk] = f2bf(v.x * s);
      tl[(nn4 + 1) * 72 + kk] = f2bf(v.y * s);
      tl[(nn4 + 2) * 72 + kk] = f2bf(v.z * s);
      tl[(nn4 + 3) * 72 + kk] = f2bf(v.w * s);
    }
    __syncthreads();
    {
      int nn = tid >> 3, kk8 = (tid & 7) * 8;
      int c = n0 + nn, drow;
      if (j.perm) { int half = c / DFF, cp = c % DFF; drow = (cp >> 5) * 64 + half * 32 + (cp & 31); }
      else drow = c;
      i32x4 v = *(const i32x4*)(tl + nn * 72 + kk8);
      *(i32x4*)(j.dst + (size_t)(j.noff + drow) * j.dld + j.koff + k0 + kk8) = v;
    }
    __syncthreads();
  }
}

__device__ __forceinline__ bool prep_is_early(int jj) { return jj == 0 || jj == 4 || (jj >= 12 && jj < 32); }
__device__ __forceinline__ void prep_weights(const Params& p, char* shm, bool early, int nblk, int bid) {
  char* ws = p.ws;
  for (int jj = 0; jj < 36; ++jj) {
    if (prep_is_early(jj) != early) continue;
    PrepJob j; j.mode = 0; j.sc = nullptr; j.perm = 0; j.koff = 0; j.noff = 0;
    if (jj < 4) {
      j.src = p.in[5] + (size_t)jj * 1024 * 5632; j.K = 1024; j.N = 5632; j.ldsrc = 5632;
      j.dst = (u16*)(ws + OFF_WIN + jj * SZ_WIN); j.dld = 1024; j.sc = p.in[4] + jj * 1024; j.mode = 1; j.perm = 1;
    } else if (jj < 8) {
      int q = jj - 4;
      j.src = p.in[6] + (size_t)q * 2816 * 1024; j.K = 2816; j.N = 1024; j.ldsrc = 1024;
      j.dst = (u16*)(ws + OFF_WOUT + q * SZ_WOUT); j.dld = 2816;
    } else if (jj < 10) {
      int q = jj - 8;
      j.src = p.in[9] + (size_t)q * 1024 * 1024; j.K = 1024; j.N = 1024; j.ldsrc = 1024;
      j.dst = (u16*)(ws + OFF_WPG) + (size_t)q * 1024 * 1024; j.dld = 1024; j.sc = p.in[8] + q * 1024; j.mode = 1;
    } else if (jj < 12) {
      int q = jj - 10;
      j.src = p.in[10] + (size_t)q * 256 * 1024; j.K = 256; j.N = 1024; j.ldsrc = 1024;
      j.dst = (u16*)(ws + OFF_WPP) + (size_t)q * 1024 * 256; j.dld = 256;
    } else if (jj < 28) {
      int q = (jj - 12) >> 1, hf = (jj - 12) & 1;
      j.K = 1024; j.dst = (u16*)(ws + OFF_WRKV); j.dld = 2048; j.koff = hf * 1024; j.mode = hf ? 3 : 2;
      if (q < 3) { j.src = p.in[13] + (size_t)q * 1024 * 1024; j.N = 1024; j.ldsrc = 1024; j.noff = q * 1024; j.sc = p.in[12] + q * 1024; }
      else if (q < 5) { int z = q - 3; j.src = p.in[15] + (size_t)z * 1024 * 64; j.N = 64; j.ldsrc = 64; j.noff = 3072 + z * 64; j.sc = p.in[12] + 3 * 1024; }
      else if (q < 7) { int z = q - 5; j.src = p.in[18] + (size_t)z * 1024 * 64; j.N = 64; j.ldsrc = 64; j.noff = 3200 + z * 64; j.sc = p.in[12] + 4 * 1024; }
      else { j.src = p.in[20]; j.N = 128; j.ldsrc = 128; j.noff = 3328; j.sc = p.in[12] + 5 * 1024; }
    } else if (jj < 30) {
      int z = jj - 28;
      j.src = p.in[16] + (size_t)z * 64 * 1024; j.K = 64; j.N = 1024; j.ldsrc = 1024;
      j.dst = (u16*)(ws + OFF_W2W) + (size_t)z * 1024 * 64; j.dld = 64;
    } else if (jj < 32) {
      int z = jj - 30;
      j.src = p.in[19] + (size_t)z * 64 * 1024; j.K = 64; j.N = 1024; j.ldsrc = 1024;
      j.dst = (u16*)(ws + OFF_W2A) + (size_t)z * 1024 * 64; j.dld = 64;
    } else if (jj == 32) {
      j.src = p.in[21]; j.K = 128; j.N = 1024; j.ldsrc = 1024; j.dst = (u16*)(ws + OFF_WG2); j.dld = 128;
    } else if (jj == 33) {
      j.src = p.in[27]; j.K = 1024; j.N = 1024; j.ldsrc = 1024; j.dst = (u16*)(ws + OFF_WRWO); j.dld = 1024;
    } else if (jj == 34) {
      j.src = p.in[28]; j.K = 1024; j.N = 3072; j.ldsrc = 3072; j.dst = (u16*)(ws + OFF_WQKV); j.dld = 1024; j.sc = p.in[7] + 1024; j.mode = 1;
    } else if (jj == 35) {
      j.src = p.in[31]; j.K = 1024; j.N = 1024; j.ldsrc = 1024; j.dst = (u16*)(ws + OFF_WNAO); j.dld = 1024;
    } else continue;
    prep_tiles(j, shm, nblk, bid);
  }
}

__device__ __forceinline__ void phase_prep(const Params& p, char* shm) {
  char* ws = p.ws;
  prep_weights(p, shm, true, gridDim.x, blockIdx.x);
  float* ss = (float*)(ws + OFF_SS);
  u16* hb = (u16*)(ws + OFF_HB);
  int tid = otid(), half = tid >> 8, t4 = (tid & 255) * 4;
  float* red = (float*)shm;
  for (int r0 = blockIdx.x * 2; r0 < MT; r0 += gridDim.x * 2) {
    int row = r0 + half;
    const float* src = row < MPROMPT ? p.in[0] + (size_t)row * D : p.in[1] + (size_t)(row - MPROMPT) * D;
    float4 v = *(const float4*)(src + t4);
    *(float4*)(p.h + (size_t)row * D + t4) = v;
    uint2 pk; pk.x = pack2(v.x, v.y); pk.y = pack2(v.z, v.w);
    *(uint2*)(hb + (size_t)row * D + t4) = pk;
    float s = v.x * v.x + v.y * v.y + v.z * v.z + v.w * v.w;
#pragma unroll
    for (int o = 32; o > 0; o >>= 1) s += __shfl_xor(s, o);
    __syncthreads();
    if ((tid & 63) == 0) red[tid >> 6] = s;
    __syncthreads();
    if ((tid & 255) == 0) {
      float tot = red[half * 4] + red[half * 4 + 1] + red[half * 4 + 2] + red[half * 4 + 3];
      ss[row] = tot;
#pragma unroll
      for (int q = 1; q < 9; ++q) ss[(size_t)q * MT + row] = 0.f;
    }
  }
}

__device__ __forceinline__ void conv_p(const Params& p, int layer) {
  u16* pbi = (u16*)(p.ws + OFF_PBI);
  const float* pp = p.in[2] + (size_t)layer * MPROMPT * 256;
  const float* ps = p.in[3] + (size_t)layer * (MT - MPROMPT) * 256;
  size_t n4 = (size_t)MT * 256 / 4;
  for (size_t i = (size_t)blockIdx.x * NTHR + otid(); i < n4; i += (size_t)gridDim.x * NTHR) {
    size_t e = i * 4;
    const float* s = e < (size_t)MPROMPT * 256 ? pp + e : ps + (e - (size_t)MPROMPT * 256);
    float4 v = *(const float4*)s;
    uint2 pk; pk.x = pack2(v.x, v.y); pk.y = pack2(v.z, v.w);
    *(uint2*)(pbi + e) = pk;
  }
}

__device__ __forceinline__ void conv_h(const Params& p) {
  u16* hb = (u16*)(p.ws + OFF_HB);
  size_t n4 = (size_t)MT * D / 4;
  for (size_t i = (size_t)blockIdx.x * NTHR + otid(); i < n4; i += (size_t)gridDim.x * NTHR) {
    float4 v = *(const float4*)(p.h + i * 4);
    uint2 pk; pk.x = pack2(v.x, v.y); pk.y = pack2(v.z, v.w);
    *(uint2*)(hb + i * 4) = pk;
  }
}

enum { E_SWIGLU = 0, E_RESID = 1, E_PLEPROJ = 2, E_PLEGATE = 3, E_RKV = 4, E_RWFIN = 5, E_QKV = 6 };

struct GA {
  const u16* A; const u16* Bt; int K; int N;
  int mtiles, ntiles;
  int rowoff;
  const float* ss_in; float* ss_out;
  const float* bias; float scale;
  float* h; u16* hb;
  u16* o0; u16* o1; u16* o2;
  const float* f0; const float* f1; const float* f2;
};

template <int KS> __device__ __forceinline__ int lds_byte(int r, int c) {
  int st = (r >> 4) * KS + (c >> 5), ob = (r & 15) * 64 + (c & 31) * 2;
  return st * 1024 + (ob ^ (((ob >> 9) & 1) << 5));
}
template <int KS> __device__ __forceinline__ void stage_rc(int b, int& R, int& C) {
  int st = b >> 10, sb = b & 1023, swz = sb ^ (((sb >> 9) & 1) << 5);
  R = (st / KS) * 16 + swz / 64;
  C = (st % KS) * 32 + (swz % 64) / 2;
}

template <int EPI>
__device__ __forceinline__ void gemm_tile(const GA& g, int pm, int pn, bool prefetched, bool has_next, int pm_next, int pn_next, LDSC* shm) {
  constexpr int BK = 64, KS = 2, TILE_B = 256 * BK * 2, GL = 4, STAGE_B = 2 * TILE_B;
  const int K = g.K;
  const int tid = otid(), wid = tid >> 6, lane = tid & 63, wr = wid >> 2, wc = wid & 3, fr = lane & 15, fq = lane >> 4;
  const int brow = pm * 256, bcol = pn * 256;
  const u16* Ab = g.A + (size_t)brow * K;
  const u16* Bb = g.Bt + (size_t)bcol * K;
  const u16* Abn = g.A + (size_t)(pm_next * 256) * K;
  const u16* Bbn = g.Bt + (size_t)(pn_next * 256) * K;
  int sO[GL];
#pragma unroll
  for (int i = 0; i < GL; ++i) { int r_, c_; stage_rc<KS>(wid * 1024 + i * 8192 + lane * 16, r_, c_); sO[i] = r_ * K + c_; }
  f32x4 acc[8][4];
#pragma unroll
  for (int m = 0; m < 8; ++m)
#pragma unroll
    for (int n = 0; n < 4; ++n) acc[m][n] = f32x4{0.f, 0.f, 0.f, 0.f};
  const int nt = K / BK;
#define G_STAGE(buf, AB_, BB_, kt) do { _Pragma("unroll") for (int i = 0; i < GL; ++i) { \
    __builtin_amdgcn_global_load_lds((const unsigned*)((AB_) + (kt) * BK + sO[i]), (LDSU*)(shm + (buf) * STAGE_B + wid * 1024 + i * 8192), 16, 0, 0); \
    __builtin_amdgcn_global_load_lds((const unsigned*)((BB_) + (kt) * BK + sO[i]), (LDSU*)(shm + (buf) * STAGE_B + TILE_B + wid * 1024 + i * 8192), 16, 0, 0); } } while (0)
#define G_STAGE_H(hh, buf, AB_, BB_, kt) do { _Pragma("unroll") for (int i = (hh) * 2; i < (hh) * 2 + 2; ++i) { \
    __builtin_amdgcn_global_load_lds((const unsigned*)((AB_) + (kt) * BK + sO[i]), (LDSU*)(shm + (buf) * STAGE_B + wid * 1024 + i * 8192), 16, 0, 0); \
    __builtin_amdgcn_global_load_lds((const unsigned*)((BB_) + (kt) * BK + sO[i]), (LDSU*)(shm + (buf) * STAGE_B + TILE_B + wid * 1024 + i * 8192), 16, 0, 0); } } while (0)
  if (!prefetched) G_STAGE(0, Ab, Bb, 0);
  asm volatile("s_waitcnt vmcnt(0)" ::: "memory");
  __syncthreads();
  for (int t = 0; t < nt; ++t) {
    int cur = t & 1;
    if (t + 1 < nt) G_STAGE_H(0, cur ^ 1, Ab, Bb, t + 1);
    else if (has_next) G_STAGE_H(0, 0, Abn, Bbn, 0);
    const LDSC* SAp = shm + cur * STAGE_B;
    const LDSC* SBp = SAp + TILE_B;
#pragma unroll
    for (int ks = 0; ks < KS; ++ks) {
      if (ks == 1) {
        if (t + 1 < nt) G_STAGE_H(1, cur ^ 1, Ab, Bb, t + 1);
        else if (has_next) G_STAGE_H(1, 0, Abn, Bbn, 0);
      }
      bf16x8 At[8], Bf[4];
#pragma unroll
      for (int m = 0; m < 8; ++m) At[m] = *(const LDS_BF8*)(SAp + lds_byte<KS>(wr * 128 + m * 16 + fr, ks * 32 + fq * 8));
#pragma unroll
      for (int n = 0; n < 4; ++n) Bf[n] = *(const LDS_BF8*)(SBp + lds_byte<KS>(wc * 64 + n * 16 + fr, ks * 32 + fq * 8));
      __builtin_amdgcn_s_setprio(1);
#pragma unroll
      for (int m = 0; m < 8; ++m)
#pragma unroll
        for (int n = 0; n < 4; ++n) acc[m][n] = __builtin_amdgcn_mfma_f32_16x16x32_bf16(At[m], Bf[n], acc[m][n], 0, 0, 0);
      __builtin_amdgcn_s_setprio(0);
      __builtin_amdgcn_sched_barrier(0);
    }
    if (t + 1 < nt) asm volatile("s_waitcnt vmcnt(0)" ::: "memory");
    __syncthreads();
  }
#undef G_STAGE
#undef G_STAGE_H
  typedef __attribute__((address_space(3))) float LDSF;
  typedef __attribute__((address_space(3))) f32x4 LDSF4;
  LDSF* scr = (LDSF*)(shm + STAGE_B + wid * 4352);
  const int cb = bcol + wc * 64;
#define SLAB_WRITE(m) do { _Pragma("unroll") for (int n = 0; n < 4; ++n) _Pragma("unroll") for (int j = 0; j < 4; ++j) \
    scr[(fq * 4 + j) * 68 + n * 16 + fr] = acc[m][n][j]; asm volatile("s_waitcnt lgkmcnt(0)" ::: "memory"); } while (0)
#define SLAB_DONE() asm volatile("s_waitcnt lgkmcnt(0)" ::: "memory")
  if constexpr (EPI == E_SWIGLU) {
    const int l8 = lane & 7, r8 = lane >> 3;
#pragma unroll
    for (int m = 0; m < 8; ++m) {
      SLAB_WRITE(m);
#pragma unroll
      for (int k = 0; k < 2; ++k) {
        int rl = k * 8 + r8, row = brow + wr * 128 + m * 16 + rl;
        f32x4 gt = *(const LDSF4*)(scr + rl * 68 + l8 * 4), up = *(const LDSF4*)(scr + rl * 68 + 32 + l8 * 4);
        float rs = rstd_of(g.ss_in[g.rowoff + row]);
        float o[4];
#pragma unroll
        for (int e = 0; e < 4; ++e) { float a = gt[e] * rs; o[e] = a * sigm(a) * (up[e] * rs); }
        uint2 pk; pk.x = pack2(o[0], o[1]); pk.y = pack2(o[2], o[3]);
        *(uint2*)(g.o0 + (size_t)row * DFF + (cb >> 1) + l8 * 4) = pk;
      }
      SLAB_DONE();
    }
  } else if constexpr (EPI == E_QKV) {
    const int which = cb >> 10, c0 = cb & 1023;
    if (which == 2) {
#pragma unroll
      for (int m = 0; m < 8; ++m) {
        int row0 = brow + wr * 128 + m * 16 + fq * 4;
        float rs[4];
#pragma unroll
        for (int j = 0; j < 4; ++j) rs[j] = rstd_of(g.ss_in[row0 + j]);
#pragma unroll
        for (int n = 0; n < 4; ++n) {
          int col = c0 + n * 16 + fr;
          float b = g.bias[cb + n * 16 + fr];
          uint2 pk; pk.x = pack2(acc[m][n][0] * rs[0] + b, acc[m][n][1] * rs[1] + b); pk.y = pack2(acc[m][n][2] * rs[2] + b, acc[m][n][3] * rs[3] + b);
          *(uint2*)(g.o2 + (size_t)col * MT + row0) = pk;
        }
      }
    } else {
      u16* dst = which == 0 ? g.o0 : g.o1;
      const float sc = which == 0 ? 0.17677669529663687f : 1.f;
      f32x4 b4 = *(const f32x4*)(g.bias + cb + fr * 4);
#pragma unroll
      for (int m = 0; m < 8; ++m) {
        SLAB_WRITE(m);
#pragma unroll
        for (int k = 0; k < 4; ++k) {
          int rl = k * 4 + fq, row = brow + wr * 128 + m * 16 + rl;
          f32x4 v = *(const LDSF4*)(scr + rl * 68 + fr * 4);
          float rs = rstd_of(g.ss_in[row]);
          uint2 pk; pk.x = pack2((v[0] * rs + b4[0]) * sc, (v[1] * rs + b4[1]) * sc); pk.y = pack2((v[2] * rs + b4[2]) * sc, (v[3] * rs + b4[3]) * sc);
          *(uint2*)(dst + (size_t)row * D + c0 + fr * 4) = pk;
        }
        SLAB_DONE();
      }
    }
  } else {
    float lw[4] = {0.f, 0.f, 0.f, 0.f}, lb[4] = {0.f, 0.f, 0.f, 0.f}, bs[4] = {0.f, 0.f, 0.f, 0.f};
    if constexpr (EPI == E_RWFIN) {
#pragma unroll
      for (int e = 0; e < 4; ++e) { lw[e] = g.f1[cb + fr * 4 + e]; lb[e] = g.f2[cb + fr * 4 + e]; }
    }
    if constexpr (EPI == E_RESID) {
      if (g.bias) {
#pragma unroll
        for (int e = 0; e < 4; ++e) bs[e] = g.bias[cb + fr * 4 + e];
      }
    }
    f32x4 h_n[4]; uint2 a_n[4]; float f_n[4][2];
#define EPI_LOAD(m_) do { _Pragma("unroll") for (int k = 0; k < 4; ++k) { \
      const int row_ = brow + wr * 128 + (m_) * 16 + k * 4 + fq, col_ = cb + fr * 4; \
      if constexpr (EPI == E_RESID || EPI == E_PLEGATE) h_n[k] = *(const f32x4*)(g.h + (size_t)(g.rowoff + row_) * D + col_); \
      if constexpr (EPI == E_PLEGATE) { a_n[k] = *(const uint2*)(g.o0 + (size_t)(g.rowoff + row_) * D + col_); f_n[k][0] = g.ss_in[g.rowoff + row_]; } \
      } } while (0)
    f32x4 h_m[4]; uint2 a_m[4]; float f_m[4][2];
    EPI_LOAD(0);
#pragma unroll
    for (int k = 0; k < 4; ++k) { h_m[k] = h_n[k]; a_m[k] = a_n[k]; f_m[k][0] = f_n[k][0]; }
    EPI_LOAD(1);
#pragma unroll
    for (int m = 0; m < 8; ++m) {
      f32x4 h_c[4]; uint2 a_c[4]; float f_c[4][2];
#pragma unroll
      for (int k = 0; k < 4; ++k) { h_c[k] = h_m[k]; a_c[k] = a_m[k]; f_c[k][0] = f_m[k][0];
                                    h_m[k] = h_n[k]; a_m[k] = a_n[k]; f_m[k][0] = f_n[k][0]; }
      if (m + 2 < 8) EPI_LOAD(m + 2);
      SLAB_WRITE(m);
#pragma unroll
      for (int k = 0; k < 4; ++k) {
        const int rl = k * 4 + fq, row = brow + wr * 128 + m * 16 + rl;
        const int col = cb + fr * 4;
        f32x4 v = *(const LDSF4*)(scr + rl * 68 + fr * 4);
        if constexpr (EPI == E_RESID || EPI == E_PLEGATE) {
          size_t grow = (size_t)(g.rowoff + row);
          float* hp = g.h + grow * D + col;
          f32x4 hv = h_c[k];
          if constexpr (EPI == E_PLEGATE) {
            float rs = rstd_of(f_c[k][0]);
            uint2 pb = a_c[k];
            hv[0] += sigm(v[0] * rs) * bf2f((u16)(pb.x & 0xffff));
            hv[1] += sigm(v[1] * rs) * bf2f((u16)(pb.x >> 16));
            hv[2] += sigm(v[2] * rs) * bf2f((u16)(pb.y & 0xffff));
            hv[3] += sigm(v[3] * rs) * bf2f((u16)(pb.y >> 16));
          } else {
#pragma unroll
            for (int e = 0; e < 4; ++e) hv[e] += g.scale * v[e] + bs[e];
          }
          *(f32x4*)hp = hv;
          if (g.hb != nullptr) {
            uint2 pk; pk.x = pack2(hv[0], hv[1]); pk.y = pack2(hv[2], hv[3]);
            *(uint2*)(g.hb + grow * D + col) = pk;
          }
          float sq = rowsum16(hv[0] * hv[0] + hv[1] * hv[1] + hv[2] * hv[2] + hv[3] * hv[3]);
          if (fr == 0) atomicAdd(g.ss_out + grow, sq);
        } else if constexpr (EPI == E_PLEPROJ) {
          uint2 pk; pk.x = pack2(v[0], v[1]); pk.y = pack2(v[2], v[3]);
          *(uint2*)(g.o0 + (size_t)row * D + col) = pk;
        } else if constexpr (EPI == E_RKV) {
          if (cb < 3072) {
            u16* buf = g.o0 + (size_t)(cb >> 10) * ((size_t)MR * 1024);
            uint2 pk; pk.x = pack2(v[0], v[1]); pk.y = pack2(v[2], v[3]);
            *(uint2*)(buf + (size_t)row * D + (cb & 1023) + fr * 4) = pk;
          } else if (cb < 3456) {
            int which = (cb - 3072) >> 7, c0 = (cb - 3072) & 127;
            u16* buf = g.o1 + (size_t)which * ((size_t)MR * 128);
            if (which == 0) { v[0] = tanhf(v[0]); v[1] = tanhf(v[1]); v[2] = tanhf(v[2]); v[3] = tanhf(v[3]); }
            else if (which == 2) { v[0] = sigm(v[0]); v[1] = sigm(v[1]); v[2] = sigm(v[2]); v[3] = sigm(v[3]); }
            uint2 pk; pk.x = pack2(v[0], v[1]); pk.y = pack2(v[2], v[3]);
            *(uint2*)(buf + (size_t)row * 128 + c0 + fr * 4) = pk;
          }
        } else if constexpr (EPI == E_RWFIN) {
          const int head = cb >> 6;
          size_t idx = (size_t)row * D + col;
          uint2 a0 = *(const uint2*)(g.o0 + idx), a1 = *(const uint2*)(g.o1 + idx), vv = *(const uint2*)(g.o2 + idx);
          float y[4];
          y[0] = bf2f((u16)(a0.x & 0xffff)) + bf2f((u16)(a1.x & 0xffff));
          y[1] = bf2f((u16)(a0.x >> 16)) + bf2f((u16)(a1.x >> 16));
          y[2] = bf2f((u16)(a0.y & 0xffff)) + bf2f((u16)(a1.y & 0xffff));
          y[3] = bf2f((u16)(a0.y >> 16)) + bf2f((u16)(a1.y >> 16));
          float mean = rowsum16(y[0] + y[1] + y[2] + y[3]) * (1.f / 64.f);
#pragma unroll
          for (int e = 0; e < 4; ++e) y[e] -= mean;
          float inv = rsqrtf(rowsum16(y[0] * y[0] + y[1] * y[1] + y[2] * y[2] + y[3] * y[3]) * (1.f / 64.f) + 64e-5f);
          float bon = g.f0[(size_t)row * 16 + head] + g.f0[(size_t)MR * 16 + (size_t)row * 16 + head];
          float vf[4] = {bf2f((u16)(vv.x & 0xffff)), bf2f((u16)(vv.x >> 16)), bf2f((u16)(vv.y & 0xffff)), bf2f((u16)(vv.y >> 16))};
          float o[4];
#pragma unroll
          for (int e = 0; e < 4; ++e) o[e] = (y[e] * inv * lw[e] + lb[e] + bon * vf[e]) * v[e];
          uint2 pk; pk.x = pack2(o[0], o[1]); pk.y = pack2(o[2], o[3]);
          *(uint2*)(g.hb + idx) = pk;
        }
      }
      SLAB_DONE();
    }
  }
#undef SLAB_WRITE
#undef EPI_LOAD
#undef SLAB_DONE
}

template <int EPI> __device__ __forceinline__ void gemm_phase(const GA& g, const GA& g2, LDSC* shm) {
  const int nM = g.mtiles, nN = g.ntiles;
  const int G = gridDim.x;
  const int PN = (nN & 3) == 0 ? 4 : 2, PM = 32 / PN;
  const int sN = nN / PN, sM = nM / PM, nsup = sN * sM;
  const int per = G >> 8;
  const int b = blockIdx.x, x = b & 7, l = (b >> 3) & 31, rep = b >> 8;
  bool pref = false;
  for (int s = x + 8 * rep; s < nsup; s += 8 * per) {
    int sm = s / sN, sn = s % sN;
    int pm = sm * PM + (l % PM), pn = sn * PN + (l / PM);
    int s2 = s + 8 * per;
    bool hn = s2 < nsup;
    int pm2 = (s2 / sN) * PM + (l % PM), pn2 = (s2 % sN) * PN + (l / PM);
    if constexpr (EPI == E_PLEGATE) {
      gemm_tile<E_PLEPROJ>(g2, pm, pn, false, false, pm, pn, shm);
      gemm_tile<E_PLEGATE>(g, pm, pn, false, false, pm, pn, shm);
    } else {
      gemm_tile<EPI>(g, pm, pn, pref, hn, hn ? pm2 : pm, hn ? pn2 : pn, shm);
      pref = hn;
    }
  }
  __syncthreads();
}

__device__ __forceinline__ void phase_mix(const Params& p, int tok0, int ntok) {
  const float* ss1 = (const float*)(p.ws + OFF_SS) + (size_t)1 * MT;
  const float* gain = p.in[7];
  u16* A2 = (u16*)(p.ws + OFF_BIG + BIG_A2);
  int tid = otid(), half = tid >> 8, c4 = (tid & 255) * 4;
  float4 gn = *(const float4*)(gain + c4);
  for (int l0 = blockIdx.x * 2; l0 < ntok; l0 += gridDim.x * 2) {
    int l = l0 + half, tok = tok0 + l;
    int pos, T;
    if (tok < MPROMPT) { pos = tok & 2047; T = 2048; } else { pos = tok - MPROMPT; T = 16384; }
    float4 c = *(const float4*)(p.h + (size_t)tok * D + c4);
    float rc = rstd_of(ss1[tok]);
    float4 hn = {c.x * rc * gn.x, c.y * rc * gn.y, c.z * rc * gn.z, c.w * rc * gn.w};
    float4 av = {0.f, 0.f, 0.f, 0.f};
    if (pos > 0) {
      float4 q = *(const float4*)(p.h + (size_t)(tok - 1) * D + c4);
      float r = rstd_of(ss1[tok - 1]);
      av.x += q.x * r * gn.x; av.y += q.y * r * gn.y; av.z += q.z * r * gn.z; av.w += q.w * r * gn.w;
    }
    if (pos < T - 1) {
      float4 q = *(const float4*)(p.h + (size_t)(tok + 1) * D + c4);
      float r = rstd_of(ss1[tok + 1]);
      av.x += q.x * r * gn.x; av.y += q.y * r * gn.y; av.z += q.z * r * gn.z; av.w += q.w * r * gn.w;
    }
    uint2 a, b;
    a.x = pack2(hn.x, hn.y); a.y = pack2(hn.z, hn.w);
    b.x = pack2(0.5f * av.x, 0.5f * av.y); b.y = pack2(0.5f * av.z, 0.5f * av.w);
    *(uint2*)(A2 + (size_t)l * 2048 + c4) = a;
    *(uint2*)(A2 + (size_t)l * 2048 + 1024 + c4) = b;
  }
}

constexpr int SC_T = 32;
constexpr int SC_ARR = SC_T * 64 * 4;
constexpr int SC_BUF = 6 * SC_ARR;
template <int E> __device__ __forceinline__ float rowsumL(float v) {
  v += dppf<0xB1>(v); v += dppf<0x4E>(v); v += dppf<0x141>(v);
  if (E == 4) v += dppf<0x140>(v);
  return v;
}

template <int E, int R = 1>
__device__ __forceinline__ void scan_item(const Params& p, int seq_loc0, int T, int head, int z, int rowbase, int nw, char* shm) {
  char* big = p.ws + OFF_BIG;
  const u16* Rb = (const u16*)(big + BIG_RKV);
  const u16* Kb = (const u16*)(big + BIG_RKV + SZ_RKV1);
  const u16* Vb = (const u16*)(big + BIG_RKV + 2 * SZ_RKV1);
  const u16* TW = (const u16*)(big + BIG_T);
  const u16* TA = (const u16*)(big + BIG_T + SZ_T1);
  u16* Y = (u16*)(big + (z ? BIG_Y1 : BIG_Y0));
  float* bonus = (float*)(p.ws + OFF_BONUS) + (size_t)z * MR * 16;
  const u16* W2 = (const u16*)(p.ws + OFF_W2W) + (size_t)z * 1024 * 64;
  const u16* A2w = (const u16*)(p.ws + OFF_W2A) + (size_t)z * 1024 * 64;
  const float* w0 = p.in[14] + z * 1024 + head * 64;
  const float* a0 = p.in[17] + z * 1024 + head * 64;
  const int tid = otid(), wv = tid >> 6, lane = tid & 63, fr = lane & 15, fq = lane >> 4;
  float* Ybuf = (float*)(shm + 2 * SC_BUF);
  const int si = tid >> 4, ec4 = (tid & 15) * 4;
  float4 ckk = *(const float4*)(p.in[22] + head * 64 + ec4);
  float4 cka = *(const float4*)(p.in[23] + head * 64 + ec4);
  float4 crk = *(const float4*)(p.in[24] + head * 64 + ec4);
  const int mt = wv >> 2, ntl = wv & 3;
  bf16x8 Bw[2], Ba[2];
#pragma unroll
  for (int ks = 0; ks < 2; ++ks) {
    Bw[ks] = *(const bf16x8*)(W2 + (size_t)(head * 64 + ntl * 16 + fr) * 64 + ks * 32 + fq * 8);
    Ba[ks] = *(const bf16x8*)(A2w + (size_t)(head * 64 + ntl * 16 + fr) * 64 + ks * 32 + fq * 8);
  }
  const float w0c = w0[ntl * 16 + fr], a0c = a0[ntl * 16 + fr];
  constexpr int LPR = 64 / E, RPW = R * (64 / LPR), NP = E / 2, NQ = E / 4;
  const int le = lane % LPR, row0 = rowbase + wv * RPW + (lane / LPR) * R;
  f32x2 st[R][NP];
#pragma unroll
  for (int r = 0; r < R; ++r)
#pragma unroll
    for (int q = 0; q < NP; ++q) st[r][q] = f32x2{0.f, 0.f};
  float skc = 0.f, sklast = 0.f;
  f32x2 ulast0 = {0.f, 0.f}, ulast1 = {0.f, 0.f};
  f32x4 kalast = {0.f, 0.f, 0.f, 0.f};
  const int nch = T / SC_T;
  uint2 pr, pk, pv; bf16x8 Aw[2], Aa[2];
  auto tok_of = [&](int t) { return seq_loc0 + (z ? (T - 1 - t) : t); };
#define SC_LOAD(c) do { \
    int tk_ = tok_of((c) * SC_T + si); \
    pr = *(const uint2*)(Rb + (size_t)tk_ * D + head * 64 + ec4); \
    pk = *(const uint2*)(Kb + (size_t)tk_ * D + head * 64 + ec4); \
    pv = *(const uint2*)(Vb + (size_t)tk_ * D + head * 64 + ec4); \
    int tm_ = tok_of((c) * SC_T + mt * 16 + fr); \
    _Pragma("unroll") for (int ks = 0; ks < 2; ++ks) { \
      Aw[ks] = *(const bf16x8*)(TW + (size_t)tm_ * 128 + z * 64 + ks * 32 + fq * 8); \
      Aa[ks] = *(const bf16x8*)(TA + (size_t)tm_ * 128 + z * 64 + ks * 32 + fq * 8); } } while (0)
#define SC_LORA(b) do { \
    f32x4 cw = {0.f, 0.f, 0.f, 0.f}, ca = {0.f, 0.f, 0.f, 0.f}; \
    _Pragma("unroll") for (int ks = 0; ks < 2; ++ks) { \
      cw = __builtin_amdgcn_mfma_f32_16x16x32_bf16(Aw[ks], Bw[ks], cw, 0, 0, 0); \
      ca = __builtin_amdgcn_mfma_f32_16x16x32_bf16(Aa[ks], Ba[ks], ca, 0, 0, 0); } \
    float* Wl_ = (float*)(shm + (b) * SC_BUF); float* Al_ = (float*)(shm + (b) * SC_BUF + 3 * SC_ARR); \
    _Pragma("unroll") for (int j = 0; j < 4; ++j) { \
      int st_ = mt * 16 + fq * 4 + j; \
      Wl_[st_ * 64 + ntl * 16 + fr] = __expf(-0.6065306597126334f * sigm(w0c + cw[j])); \
      Al_[st_ * 64 + ntl * 16 + fr] = sigm(a0c + ca[j]); } } while (0)
#define SC_ELEM(b, c) do { \
    char* bb_ = shm + (b) * SC_BUF; \
    float4 a4 = *(const float4*)(bb_ + 3 * SC_ARR + (si * 64 + ec4) * 4); \
    float r0 = bf2f((u16)(pr.x & 0xffff)), r1 = bf2f((u16)(pr.x >> 16)), r2 = bf2f((u16)(pr.y & 0xffff)), r3 = bf2f((u16)(pr.y >> 16)); \
    float k0 = bf2f((u16)(pk.x & 0xffff)), k1 = bf2f((u16)(pk.x >> 16)), k2 = bf2f((u16)(pk.y & 0xffff)), k3 = bf2f((u16)(pk.y >> 16)); \
    float v0 = bf2f((u16)(pv.x & 0xffff)), v1 = bf2f((u16)(pv.x >> 16)), v2 = bf2f((u16)(pv.y & 0xffff)), v3 = bf2f((u16)(pv.y >> 16)); \
    float q0 = k0 * ckk.x, q1 = k1 * ckk.y, q2 = k2 * ckk.z, q3 = k3 * ckk.w; \
    float n2 = rowsum16(q0 * q0 + q1 * q1 + q2 * q2 + q3 * q3); \
    float inv_ = rsqrtf(fmaxf(n2, 1e-24f)); \
    q0 *= inv_; q1 *= inv_; q2 *= inv_; q3 *= inv_; \
    float d0 = k0 * (1.f + (a4.x - 1.f) * cka.x), d1 = k1 * (1.f + (a4.y - 1.f) * cka.y), d2 = k2 * (1.f + (a4.z - 1.f) * cka.z), d3 = k3 * (1.f + (a4.w - 1.f) * cka.w); \
    float bn = rowsum16(r0 * d0 * crk.x + r1 * d1 * crk.y + r2 * d2 * crk.z + r3 * d3 * crk.w); \
    if (rowbase == 0 && (tid & 15) == 0) bonus[(size_t)tok_of((c) * SC_T + si) * 16 + head] = bn; \
    *(float4*)(bb_ + 1 * SC_ARR + (si * 64 + ec4) * 4) = float4{q0, q1, q2, q3}; \
    *(float4*)(bb_ + 2 * SC_ARR + (si * 64 + ec4) * 4) = float4{d0, d1, d2, d3}; \
    *(float4*)(bb_ + 3 * SC_ARR + (si * 64 + ec4) * 4) = float4{q0 * a4.x, q1 * a4.y, q2 * a4.z, q3 * a4.w}; \
    *(float4*)(bb_ + 4 * SC_ARR + (si * 64 + ec4) * 4) = float4{r0, r1, r2, r3}; \
    *(float4*)(bb_ + 5 * SC_ARR + (si * 64 + ec4) * 4) = float4{v0, v1, v2, v3}; } while (0)

  __syncthreads();
  SC_LOAD(0);
  SC_LORA(0);
  __syncthreads();
  SC_ELEM(0, 0);
  __syncthreads();
  for (int c = 0; c < nch; ++c) {
    const int b = c & 1;
    if (c + 1 < nch) SC_LOAD(c + 1);
    const char* bb = shm + b * SC_BUF;
    if (wv < nw) {
      f32x4 cw[NQ], ckq[NQ], ckd[NQ], cka4[NQ], cr[NQ]; float vv[R];
#define SC_LD(i_, W_, KK_, KD_, KA_, R_, V_) do { _Pragma("unroll") for (int q = 0; q < NQ; ++q) { \
        W_[q] = *(const f32x4*)(bb + 0 * SC_ARR + ((i_) * 64 + le * E + q * 4) * 4); \
        KK_[q] = *(const f32x4*)(bb + 1 * SC_ARR + ((i_) * 64 + le * E + q * 4) * 4); \
        KD_[q] = *(const f32x4*)(bb + 2 * SC_ARR + ((i_) * 64 + le * E + q * 4) * 4); \
        KA_[q] = *(const f32x4*)(bb + 3 * SC_ARR + ((i_) * 64 + le * E + q * 4) * 4); \
        R_[q] = *(const f32x4*)(bb + 4 * SC_ARR + ((i_) * 64 + le * E + q * 4) * 4); } \
        _Pragma("unroll") for (int r = 0; r < R; ++r) V_[r] = *(const float*)(bb + 5 * SC_ARR + ((i_) * 64 + row0 + r) * 4); } while (0)
      SC_LD(0, cw, ckq, ckd, cka4, cr, vv);
      f32x4 mw_[NQ], mkq[NQ], mkd[NQ], mka[NQ], mr[NQ]; float mvv[R];
      if constexpr (E == 4) {
        SC_LD(1, mw_, mkq, mkd, mka, mr, mvv);
        f32x2 pu = ulast0 * ckq[0].lo + ulast1 * ckq[0].hi;
        f32x2 pc = kalast.lo * ckq[0].lo + kalast.hi * ckq[0].hi;
        skc = rowsumL<E>(pu.x + pu.y) - sklast * rowsumL<E>(pc.x + pc.y);
      }
#pragma unroll 8
      for (int i = 0; i < SC_T; ++i) {
        f32x4 nw_[NQ], nkq[NQ], nkd[NQ], nka[NQ], nr[NQ]; float nvv[R];
        const int in_ = (i + (E == 4 ? 2 : 1)) & (SC_T - 1);
        SC_LD(in_, nw_, nkq, nkd, nka, nr, nvv);
        float sk[R], yy[R];
        f32x2 uq[R][NP];
        if constexpr (E == 4) {
          f32x2 u0 = st[0][0] * cw[0].lo + ckd[0].lo * vv[0];
          f32x2 u1 = st[0][1] * cw[0].hi + ckd[0].hi * vv[0];
          st[0][0] = u0 - cka4[0].lo * skc;
          st[0][1] = u1 - cka4[0].hi * skc;
          f32x2 pu = u0 * mkq[0].lo + u1 * mkq[0].hi;
          f32x2 pc = cka4[0].lo * mkq[0].lo + cka4[0].hi * mkq[0].hi;
          const float rr_ = rowsumL<E>(pu.x + pu.y), cc_ = rowsumL<E>(pc.x + pc.y);
          ulast0 = u0; ulast1 = u1; kalast = cka4[0]; sklast = skc;
          skc = rr_ - skc * cc_;
          f32x2 ya = st[0][0] * cr[0].lo + st[0][1] * cr[0].hi;
          yy[0] = ya.x + ya.y;
        } else {
#pragma unroll
        for (int r = 0; r < R; ++r) {
          f32x2 da = st[r][0] * ckq[0].lo;
#pragma unroll
          for (int q = 1; q < NP; ++q) da += st[r][q] * ((q & 1) ? ckq[q >> 1].hi : ckq[q >> 1].lo);
#pragma unroll
          for (int q = 0; q < NP; ++q) {
            f32x2 kdq = (q & 1) ? ckd[q >> 1].hi : ckd[q >> 1].lo;
            f32x2 wq = (q & 1) ? cw[q >> 1].hi : cw[q >> 1].lo;
            uq[r][q] = st[r][q] * wq + kdq * vv[r];
          }
          sk[r] = da.x + da.y;
        }
#pragma unroll
        for (int r = 0; r < R; ++r) sk[r] = rowsumL<E>(sk[r]);
#pragma unroll
        for (int r = 0; r < R; ++r) {
#pragma unroll
          for (int q = 0; q < NP; ++q) {
            f32x2 kaq = (q & 1) ? cka4[q >> 1].hi : cka4[q >> 1].lo;
            st[r][q] = uq[r][q] - kaq * sk[r];
          }
          f32x2 ya = st[r][0] * cr[0].lo;
#pragma unroll
          for (int q = 1; q < NP; ++q) ya += st[r][q] * ((q & 1) ? cr[q >> 1].hi : cr[q >> 1].lo);
          yy[r] = ya.x + ya.y;
        }
        }
#pragma unroll
        for (int r = 0; r < R; ++r) yy[r] = rowsumL<E>(yy[r]);
        if (le == 0) {
#pragma unroll
          for (int r = 0; r < R; ++r) Ybuf[i * 64 + row0 + r] = yy[r];
        }
        if constexpr (E == 4) {
#pragma unroll
          for (int q = 0; q < NQ; ++q) { cw[q] = mw_[q]; ckq[q] = mkq[q]; ckd[q] = mkd[q]; cka4[q] = mka[q]; cr[q] = mr[q];
                                         mw_[q] = nw_[q]; mkq[q] = nkq[q]; mkd[q] = nkd[q]; mka[q] = nka[q]; mr[q] = nr[q]; }
#pragma unroll
          for (int r = 0; r < R; ++r) { vv[r] = mvv[r]; mvv[r] = nvv[r]; }
        } else {
#pragma unroll
          for (int q = 0; q < NQ; ++q) { cw[q] = nw_[q]; ckq[q] = nkq[q]; ckd[q] = nkd[q]; cka4[q] = nka[q]; cr[q] = nr[q]; }
#pragma unroll
          for (int r = 0; r < R; ++r) vv[r] = nvv[r];
        }
      }
#undef SC_LD
    }
    if (c + 1 < nch) SC_LORA(b ^ 1);
    __syncthreads();
    if (c + 1 < nch) SC_ELEM(b ^ 1, c + 1);
    {
      int tk = tok_of(c * SC_T + si);
      int rr = (tid & 15) * 4;
      if (rr >= rowbase && rr < rowbase + nw * RPW) {
        float4 yv = *(const float4*)(Ybuf + si * 64 + rr);
        uint2 pk2; pk2.x = pack2(yv.x, yv.y); pk2.y = pack2(yv.z, yv.w);
        *(uint2*)(Y + (size_t)tk * D + head * 64 + rr) = pk2;
      }
    }
    __syncthreads();
  }
#undef SC_LOAD
#undef SC_LORA
#undef SC_ELEM
}

__device__ __forceinline__ void phase_scan(const Params& p, char* shm) {
  const int G = gridDim.x, b = blockIdx.x;
  const int nS = 128, nP = 16 * 32;
  int j, step;
  if (G > nS) { if (b < nS) { j = b; step = 1 << 30; } else { j = nS + (b - nS); step = G - nS; } }
  else { j = b; step = G; }
  for (; j < nS + nP; j += step) {
    if (j < nS) scan_item<4>(p, MPROMPT, 16384, (j >> 3) & 15, (j >> 2) & 1, (j & 3) * 16, 4, shm);
    else { int q = j - nS; scan_item<8, 2>(p, (q >> 5) * 2048, 2048, (q >> 1) & 15, q & 1, 0, 4, shm); }
  }
  __syncthreads();
  if (G > nS) { if (b >= nS) prep_weights(p, shm, false, G - nS, b - nS); }
  else prep_weights(p, shm, false, G, b);
}

__device__ __forceinline__ void phase_natt(const Params& p, u16* Odst, char* shm) {
  char* big = p.ws + OFF_BIG;
  const u16* Q = (const u16*)(big + BIG_Q);
  const u16* Kb = (const u16*)(big + BIG_K);
  const u16* Vt = (const u16*)(big + BIG_VT);
  const int tid = otid(), wv = tid >> 6, lane = tid & 63, fr = lane & 15, fq = lane >> 4;
  const int hg = blockIdx.x & 3, h = hg * 8 + wv;
  float* tab = (float*)(shm + wv * 3840);
  {
    const float* rp = p.in[30] + (size_t)h * 15 * 31;
    for (int idx = lane; idx < 960; idx += 64) tab[idx] = 0.f;
    asm volatile("s_waitcnt lgkmcnt(0)" ::: "memory");
    for (int idx = lane; idx < 465; idx += 64) { int r = idx / 31, c = idx - r * 31; tab[r * 64 + 16 + c] = rp[idx]; }
    asm volatile("s_waitcnt lgkmcnt(0)" ::: "memory");
  }
  const int nqb = MT / 16, qstep = gridDim.x >> 2;
  for (int qb = blockIdx.x >> 2; qb < nqb; qb += qstep) {
    int tb = qb * 16;
    int seqbase, T, loc;
    if (tb < MPROMPT) { seqbase = tb & ~2047; T = 2048; loc = tb & 2047; } else { seqbase = MPROMPT; T = 16384; loc = tb - MPROMPT; }
    int rows = T >> 6, i = loc >> 6, cbq = (loc & 63) >> 4;
    int rs = min(max(i - 4, 0), rows - 8);
    int kvs = min(max(cbq * 16 - 8, 0), 32);
    int qc = cbq * 16 + fr;
    int ws_ = min(max(qc - 8, 0), 48);
    bf16x8 qf = *(const bf16x8*)(Q + (size_t)(tb + fr) * D + h * 32 + fq * 8);
    unsigned vm = 0;
#pragma unroll
    for (int e = 0; e < 8; ++e) { int kcol = kvs + fq * 8 + e; vm |= ((kcol >= ws_) && (kcol < ws_ + 16)) ? (1u << e) : 0u; }
    const float* trow = tab + (rs - i + 7) * 64 + 16 + (kvs + fq * 8 - qc + 15);
    bf16x8 kf[8][2];
#pragma unroll
    for (int r = 0; r < 8; ++r)
#pragma unroll
      for (int hb2 = 0; hb2 < 2; ++hb2) {
        int kcolA = kvs + (fr >> 2) * 8 + hb2 * 4 + (fr & 3);
        size_t ktok = (size_t)seqbase + (size_t)(rs + r) * 64 + kcolA;
        kf[r][hb2] = *(const bf16x8*)(Kb + ktok * D + h * 32 + fq * 8);
      }
    f32x4 sc[8][2];
    float mx = -1e30f;
#pragma unroll
    for (int r = 0; r < 8; ++r) {
#pragma unroll
      for (int hb2 = 0; hb2 < 2; ++hb2) {
        f32x4 a = __builtin_amdgcn_mfma_f32_16x16x32_bf16(kf[r][hb2], qf, f32x4{0.f, 0.f, 0.f, 0.f}, 0, 0, 0);
#pragma unroll
        for (int j = 0; j < 4; ++j) {
          float sv = ((vm >> (hb2 * 4 + j)) & 1u) ? a[j] + trow[r * 64 + hb2 * 4 + j] : -1e30f;
          a[j] = sv; mx = fmaxf(mx, sv);
        }
        sc[r][hb2] = a;
      }
    }
    mx = fmaxf(mx, __shfl_xor(mx, 16));
    mx = fmaxf(mx, __shfl_xor(mx, 32));
    float sum = 0.f;
    f32x4 o0 = {0.f, 0.f, 0.f, 0.f}, o1 = {0.f, 0.f, 0.f, 0.f};
#pragma unroll
    for (int r = 0; r < 8; ++r) {
      bf16x8 pf;
#pragma unroll
      for (int e = 0; e < 8; ++e) {
        float pe = __expf(sc[r][e >> 2][e & 3] - mx);
        sum += pe;
        pf[e] = (short)f2bf(pe);
      }
      size_t vbase = (size_t)seqbase + (size_t)(rs + r) * 64 + kvs + fq * 8;
      bf16x8 v0 = *(const bf16x8*)(Vt + (size_t)(h * 32 + fr) * MT + vbase);
      bf16x8 v1 = *(const bf16x8*)(Vt + (size_t)(h * 32 + 16 + fr) * MT + vbase);
      o0 = __builtin_amdgcn_mfma_f32_16x16x32_bf16(v0, pf, o0, 0, 0, 0);
      o1 = __builtin_amdgcn_mfma_f32_16x16x32_bf16(v1, pf, o1, 0, 0, 0);
    }
    sum += __shfl_xor(sum, 16);
    sum += __shfl_xor(sum, 32);
    float inv = 1.f / sum;
    uint2 w0, w1;
    w0.x = pack2(o0[0] * inv, o0[1] * inv); w0.y = pack2(o0[2] * inv, o0[3] * inv);
    w1.x = pack2(o1[0] * inv, o1[1] * inv); w1.y = pack2(o1[2] * inv, o1[3] * inv);
    *(uint2*)(Odst + (size_t)(tb + fr) * D + h * 32 + fq * 4) = w0;
    *(uint2*)(Odst + (size_t)(tb + fr) * D + h * 32 + 16 + fq * 4) = w1;
  }
}

__device__ __forceinline__ void phase_final(const Params& p) {
  const float* ss8 = (const float*)(p.ws + OFF_SS) + (size_t)8 * MT;
  const float* gain = p.in[11];
  int tid = otid(), half = tid >> 8, c4 = (tid & 255) * 4;
  float4 gn = *(const float4*)(gain + c4);
  for (int r0 = blockIdx.x * 2; r0 < MT; r0 += gridDim.x * 2) {
    int row = r0 + half;
    float rs = rstd_of(ss8[row]);
    float4 v = *(float4*)(p.h + (size_t)row * D + c4);
    v.x *= rs * gn.x; v.y *= rs * gn.y; v.z *= rs * gn.z; v.w *= rs * gn.w;
    *(float4*)(p.h + (size_t)row * D + c4) = v;
  }
}

constexpr int NPHASE = 20;
#ifndef PROBE_MASK
#define PROBE_MASK 0ull
#endif

enum { K_NONE = 0, K_PREP, K_FFN1, K_FFN2, K_MIX, K_RKV, K_SCAN, K_FIN, K_RWO, K_PPROJ, K_PGATE, K_CONVH, K_QKV, K_NATT, K_NAO, K_FINAL };

__device__ __forceinline__ void run_phase(const Params& p, int ph, LDSC* shml) {
  char* shm = (char*)shml;
  char* ws = p.ws;
  float* ss = (float*)(ws + OFF_SS);
  u16* hb = (u16*)(ws + OFF_HB);
  char* big = ws + OFF_BIG;
  int kind = K_NONE, a = 0, b = 0, c = 0, d = 0;
  switch (ph) {
    case 0: kind = K_PREP; break;
    case 1: kind = K_FFN1; a = 0; b = 0; c = 0; d = 0; break;
    case 2: kind = K_FFN2; a = 0; b = 0; c = 1; break;
    case 3: kind = K_MIX; break;
    case 4: kind = K_RKV; break;
    case 5: kind = K_SCAN; break;
    case 6: kind = K_FIN; break;
    case 7: kind = K_RWO; break;
    case 8: kind = K_FFN1; a = 0; b = 1; c = 2; d = 1; break;
    case 9: kind = K_FFN2; a = 0; b = 1; c = 3; break;
    case 10: kind = K_PGATE; a = 0; b = 3; c = 4; break;
    case 11: kind = K_FFN1; a = 1; b = 0; c = 4; d = 0; break;
    case 12: kind = K_FFN2; a = 1; b = 0; c = 5; break;
    case 13: kind = K_QKV; break;
    case 14: kind = K_NATT; break;
    case 15: kind = K_NAO; break;
    case 16: kind = K_FFN1; a = 1; b = 1; c = 6; d = 1; break;
    case 17: kind = K_FFN2; a = 1; b = 1; c = 7; break;
    case 18: kind = K_PGATE; a = 1; b = 7; c = 8; break;
    case 19: kind = K_FINAL; break;
    default: break;
  }
  GA g;
  g.A = nullptr; g.Bt = nullptr; g.K = 0; g.N = 0; g.mtiles = 0; g.ntiles = 0; g.rowoff = 0;
  g.ss_in = nullptr; g.ss_out = nullptr; g.bias = nullptr; g.scale = 1.f; g.h = p.h; g.hb = hb;
  g.o0 = nullptr; g.o1 = nullptr; g.o2 = nullptr; g.f0 = nullptr; g.f1 = nullptr; g.f2 = nullptr;
  GA g2 = g;
  int epi = -1;
  const int tok0 = 0, ntok = MT;
  switch (kind) {
    case K_PREP: phase_prep(p, shm); break;
    case K_FFN1:
      if (d) conv_p(p, a);
      g.A = (a == 1 && b == 0) ? (const u16*)(big + BIG_HBALT) : hb;
      g.Bt = (const u16*)(ws + OFF_WIN + (size_t)(a * 2 + b) * SZ_WIN); g.K = 1024; g.N = 5632;
      g.mtiles = MT / 256; g.ntiles = 22; g.ss_in = ss + (size_t)c * MT; g.o0 = (u16*)(big + BIG_ACTB);
      epi = E_SWIGLU; break;
    case K_FFN2:
      g.A = (const u16*)(big + BIG_ACTB); g.Bt = (const u16*)(ws + OFF_WOUT + (size_t)(a * 2 + b) * SZ_WOUT); g.K = DFF; g.N = 1024;
      g.mtiles = MT / 256; g.ntiles = 4; g.ss_out = ss + (size_t)c * MT; g.scale = 0.5f;
      if (a == 0 && b == 0) g.hb = nullptr;
      epi = E_RESID; break;
    case K_MIX: phase_mix(p, tok0, ntok); break;
    case K_RKV:
      g.A = (const u16*)(big + BIG_A2); g.Bt = (const u16*)(ws + OFF_WRKV); g.K = 2048; g.N = 3456;
      g.mtiles = ntok / 256; g.ntiles = 14; g.o0 = (u16*)(big + BIG_RKV); g.o1 = (u16*)(big + BIG_T);
      epi = E_RKV; break;
    case K_SCAN: phase_scan(p, shm); break;
    case K_FIN:
      g.A = (const u16*)(big + BIG_T + 2 * SZ_T1); g.Bt = (const u16*)(ws + OFF_WG2); g.K = 128; g.N = 1024;
      g.mtiles = ntok / 256; g.ntiles = 4;
      g.o0 = (u16*)(big + BIG_Y0); g.o1 = (u16*)(big + BIG_Y1); g.o2 = (u16*)(big + BIG_RKV + 2 * SZ_RKV1);
      g.hb = (u16*)(big + BIG_RKV + SZ_RKV1);
      g.f0 = (const float*)(ws + OFF_BONUS); g.f1 = p.in[25]; g.f2 = p.in[26];
      epi = E_RWFIN; break;
    case K_RWO:
      g.A = (const u16*)(big + BIG_RKV + SZ_RKV1); g.Bt = (const u16*)(ws + OFF_WRWO); g.K = 1024; g.N = 1024;
      g.mtiles = ntok / 256; g.ntiles = 4; g.rowoff = tok0; g.ss_out = ss + (size_t)2 * MT; g.scale = 1.f;
      epi = E_RESID; break;
    case K_PGATE:
      g2 = g;
      g2.A = (const u16*)(ws + OFF_PBI); g2.Bt = (const u16*)(ws + OFF_WPP) + (size_t)a * 1024 * 256; g2.K = 256; g2.N = 1024;
      g2.mtiles = MT / 256; g2.ntiles = 4; g2.o0 = (u16*)(big + BIG_PB);
      g.hb = a == 0 ? (u16*)(big + BIG_HBALT) : nullptr;
      g.A = hb; g.Bt = (const u16*)(ws + OFF_WPG) + (size_t)a * 1024 * 1024; g.K = 1024; g.N = 1024;
      g.mtiles = MT / 256; g.ntiles = 4; g.ss_in = ss + (size_t)b * MT; g.ss_out = ss + (size_t)c * MT; g.o0 = (u16*)(big + BIG_PB);
      epi = E_PLEGATE; break;
    case K_QKV:
      g.A = hb; g.Bt = (const u16*)(ws + OFF_WQKV); g.K = 1024; g.N = 3072; g.mtiles = MT / 256; g.ntiles = 12;
      g.ss_in = ss + (size_t)5 * MT; g.bias = p.in[29];
      g.o0 = (u16*)(big + BIG_Q); g.o1 = (u16*)(big + BIG_K); g.o2 = (u16*)(big + BIG_VT);
      epi = E_QKV; break;
    case K_NATT:
#ifdef PROBE_NATT
      phase_natt(p, hb, shm); __syncthreads();
#endif
      phase_natt(p, (u16*)(big + BIG_Q), shm); break;
    case K_NAO:
      g.A = (const u16*)(big + BIG_Q); g.Bt = (const u16*)(ws + OFF_WNAO); g.K = 1024; g.N = 1024; g.mtiles = MT / 256; g.ntiles = 4;
      g.ss_out = ss + (size_t)6 * MT; g.bias = p.in[32]; g.scale = 1.f;
      epi = E_RESID; break;
    case K_FINAL: phase_final(p); break;
    default: break;
  }
  switch (epi) {
    case E_SWIGLU: gemm_phase<E_SWIGLU>(g, g2, shml); break;
    case E_RESID: gemm_phase<E_RESID>(g, g2, shml); break;
    case E_PLEGATE: gemm_phase<E_PLEGATE>(g, g2, shml); break;
    case E_RKV: gemm_phase<E_RKV>(g, g2, shml); break;
    case E_RWFIN: gemm_phase<E_RWFIN>(g, g2, shml); break;
    case E_QKV: gemm_phase<E_QKV>(g, g2, shml); break;
    default: break;
  }
}

__device__ __forceinline__ void grid_barrier(unsigned* bar, unsigned& nbar) {
  asm volatile("s_waitcnt vmcnt(0)" ::: "memory");
  __syncthreads();
  nbar += 1;
  if (otid() == 0) {
    __builtin_amdgcn_s_waitcnt(0);
    __builtin_amdgcn_fence(__ATOMIC_RELEASE, "agent");
    asm volatile("s_waitcnt vmcnt(0)" ::: "memory");
    __hip_atomic_fetch_add(bar, 1u, __ATOMIC_RELAXED, __HIP_MEMORY_SCOPE_AGENT);
    const unsigned target = nbar * gridDim.x;
    while (__hip_atomic_load(bar, __ATOMIC_RELAXED, __HIP_MEMORY_SCOPE_AGENT) < target) __builtin_amdgcn_s_sleep(1);
    __builtin_amdgcn_fence(__ATOMIC_ACQUIRE, "agent");
    asm volatile("s_waitcnt vmcnt(0)" ::: "memory");
  }
  __syncthreads();
}

__global__ void __launch_bounds__(NTHR, 2) fwd_megakernel(Params p, int ph_lo, int ph_hi) {
  __shared__ __attribute__((aligned(1024))) char shm[131072];
  cg::grid_group grid = cg::this_grid();
  unsigned* bar = (unsigned*)(p.ws + OFF_BAR);
  if (blockIdx.x == 0 && otid() == 0) __hip_atomic_store(bar, 0u, __ATOMIC_RELAXED, __HIP_MEMORY_SCOPE_AGENT);
  unsigned nbar = 0;
  for (int ph = ph_lo; ph < ph_hi; ++ph) {
#if PROBE_MASK
    if ((PROBE_MASK >> ph) & 1ull) { run_phase(p, ph, (LDSC*)shm); if (ph == ph_lo) grid.sync(); else grid_barrier(bar, nbar); }
#endif
    run_phase(p, ph, (LDSC*)shm);
    if (ph + 1 < ph_hi) {
      if (ph == ph_lo) grid.sync(); else grid_barrier(bar, nbar);
    }
  }
}

extern "C" void kernel_launch(void* const* d_in, const int* in_sizes, int n_in, void* d_out, int out_size, void* d_ws, size_t ws_size,
                              hipStream_t stream) {
  static int grid_blocks = 0;
  if (!grid_blocks) {
    int dev = 0, cus = 0, per_cu = 0;
    hipGetDevice(&dev);
    hipDeviceGetAttribute(&cus, hipDeviceAttributeMultiprocessorCount, dev);
    hipOccupancyMaxActiveBlocksPerMultiprocessor(&per_cu, fwd_megakernel, NTHR, 0);
    (void)per_cu;
    grid_blocks = 256;
    if (cus < 256) { fprintf(stderr, "device has %d CUs, this kernel needs 256\n", cus); grid_blocks = -1; }
  }
  if (grid_blocks < 0) return;
  if (ws_size < OFF_BIG + BIG_T + 3 * SZ_T1) return;
  Params p{};
  for (int i = 0; i < 33; ++i) p.in[i] = (const float*)d_in[i];
  p.h = (float*)d_out;
  p.ws = (char*)d_ws;
  int lo = 0, hi = NPHASE;
  void* args[] = {&p, &lo, &hi};
  hipError_t e = hipLaunchCooperativeKernel((void*)fwd_megakernel, dim3(grid_blocks), dim3(NTHR), args, 0, stream);
  if (e != hipSuccess) fprintf(stderr, "cooperative launch failed: %s (grid %d)\n", hipGetErrorString(e), grid_blocks);
}
```

```cpp
#include <hip/hip_runtime.h>
#include <hip/hip_cooperative_groups.h>
#include <cstdio>
#include <cstdint>
namespace cg = cooperative_groups;

typedef unsigned short u16;
using bf16x8 = __attribute__((ext_vector_type(8))) short;
using f32x4 = __attribute__((ext_vector_type(4))) float;
using f32x2 = __attribute__((ext_vector_type(2))) float;
using i32x4 = __attribute__((ext_vector_type(4))) int;
typedef __attribute__((address_space(3))) char LDSC;
typedef __attribute__((address_space(3))) unsigned LDSU;
typedef __attribute__((address_space(3))) bf16x8 LDS_BF8;

constexpr int MT = 49152;
constexpr int MPROMPT = 32768;
constexpr int MR = MT;
constexpr int D = 1024;
constexpr int DFF = 2816;
constexpr int NTHR = 512;

constexpr size_t SZ_WIN = (size_t)5632 * 1024 * 2;
constexpr size_t SZ_WOUT = (size_t)1024 * 2816 * 2;
constexpr size_t OFF_WIN = 0;
constexpr size_t OFF_WOUT = OFF_WIN + 4 * SZ_WIN;
constexpr size_t OFF_WPG = OFF_WOUT + 4 * SZ_WOUT;
constexpr size_t OFF_WPP = OFF_WPG + 2 * (size_t)1024 * 1024 * 2;
constexpr size_t OFF_WRKV = OFF_WPP + 2 * (size_t)1024 * 256 * 2;
constexpr size_t OFF_W2W = OFF_WRKV + (size_t)3584 * 2048 * 2;
constexpr size_t OFF_W2A = OFF_W2W + 2 * (size_t)1024 * 64 * 2;
constexpr size_t OFF_WG2 = OFF_W2A + 2 * (size_t)1024 * 64 * 2;
constexpr size_t OFF_WRWO = OFF_WG2 + (size_t)1024 * 128 * 2;
constexpr size_t OFF_WQKV = OFF_WRWO + (size_t)1024 * 1024 * 2;
constexpr size_t OFF_WNAO = OFF_WQKV + (size_t)3072 * 1024 * 2;
constexpr size_t OFF_SS = OFF_WNAO + (size_t)1024 * 1024 * 2;
constexpr size_t OFF_BONUS = OFF_SS + 9 * (size_t)MT * 4;
constexpr size_t OFF_BAR = OFF_BONUS + 2 * (size_t)MR * 16 * 4;
constexpr size_t OFF_HB = OFF_BAR + 256;
constexpr size_t OFF_PBI = OFF_HB + (size_t)MT * 1024 * 2;
constexpr size_t OFF_BIG = OFF_PBI + 2 * (size_t)MT * 256 * 2;
constexpr size_t BIG_ACTB = 0;
constexpr size_t BIG_PB = 0;
constexpr size_t BIG_HBALT = (size_t)MT * 2816 * 2;
constexpr size_t BIG_A2 = 0;
constexpr size_t BIG_Y0 = 0;
constexpr size_t BIG_Y1 = (size_t)MR * 1024 * 2;
constexpr size_t BIG_RKV = (size_t)MR * 2048 * 2;
constexpr size_t SZ_RKV1 = (size_t)MR * 1024 * 2;
constexpr size_t BIG_T = BIG_RKV + 3 * SZ_RKV1;
constexpr size_t SZ_T1 = (size_t)MR * 128 * 2;
constexpr size_t BIG_Q = 0;
constexpr size_t BIG_K = (size_t)MT * 1024 * 2;
constexpr size_t BIG_VT = 2 * (size_t)MT * 1024 * 2;

struct Params {
  const float* in[33];
  float* h;
  char* ws;
};

__device__ __forceinline__ u16 f2bf(float f) {
  unsigned u = __float_as_uint(f);
  u += 0x7fffu + ((u >> 16) & 1u);
  return (u16)(u >> 16);
}
__device__ __forceinline__ float bf2f(u16 h) { return __uint_as_float(((unsigned)h) << 16); }
__device__ __forceinline__ unsigned pack2(float a, float b) { return (unsigned)f2bf(a) | ((unsigned)f2bf(b) << 16); }
__device__ __forceinline__ float sigm(float x) { return __builtin_amdgcn_rcpf(1.f + __expf(-x)); }
template <int CTRL> __device__ __forceinline__ float dppf(float v) {
  return __int_as_float(__builtin_amdgcn_update_dpp(0, __float_as_int(v), CTRL, 0xf, 0xf, true));
}
__device__ __forceinline__ float rowsum16(float v) {
  v += dppf<0xB1>(v);
  v += dppf<0x4E>(v);
  v += dppf<0x141>(v);
  v += dppf<0x140>(v);
  return v;
}
__device__ __forceinline__ int otid() { int t = __builtin_amdgcn_workitem_id_x(); asm volatile("" : "+v"(t)); return t; }
__device__ __forceinline__ float rstd_of(float ss) { return rsqrtf(ss * (1.f / 1024.f) + 1e-6f); }

struct PrepJob {
  const float* src; int K, N, ldsrc;
  u16* dst; int dld, koff, noff;
  const float* sc; int mode;
  int perm;
};

__device__ __forceinline__ void prep_tiles(const PrepJob& j, char* shm, int nblk, int bid) {
  u16* tl = (u16*)shm;
  int kt = j.K >> 6, nt = j.N >> 6, tiles = kt * nt;
  int tid = otid();
  for (int t = bid; t < tiles; t += nblk) {
    int k0 = (t / nt) << 6, n0 = (t % nt) << 6;
#pragma unroll
    for (int it = 0; it < 2; ++it) {
      int kk = (tid >> 4) + 32 * it, nn4 = (tid & 15) * 4;
      float4 v = *(const float4*)(j.src + (size_t)(k0 + kk) * j.ldsrc + n0 + nn4);
      float s = 1.f;
      if (j.mode == 1 || j.mode == 3) s = j.sc[k0 + kk];
      else if (j.mode == 2) s = 1.f - j.sc[k0 + kk];
      tl[(nn4 + 0) * 72 + kk] = f2bf(v.x * s);
      tl[(nn4 + 1) * 72 + kk] = f2bf(v.y * s);
      tl[(nn4 + 2) * 72 + kk] = f2bf(v.z * s);
      tl[(nn4 + 3) * 72 + kk] = f2bf(v.w * s);
    }
    __syncthreads();
    {
      int nn = tid >> 3, kk8 = (tid & 7) * 8;
      int c = n0 + nn, drow;
      if (j.perm) { int half = c / DFF, cp = c % DFF; drow = (cp >> 5) * 64 + half * 32 + (cp & 31); }
      else drow = c;
      i32x4 v = *(const i32x4*)(tl + nn * 72 + kk8);
      *(i32x4*)(j.dst + (size_t)(j.noff + drow) * j.dld + j.koff + k0 + kk8) = v;
    }
    __syncthreads();
  }
}

__device__ __forceinline__ bool prep_is_early(int jj) { return jj == 0 || jj == 4 || (jj >= 12 && jj < 32); }
__device__ __forceinline__ void prep_weights(const Params& p, char* shm, bool early, int nblk, int bid) {
  char* ws = p.ws;
  for (int jj = 0; jj < 36; ++jj) {
    if (prep_is_early(jj) != early) continue;
    PrepJob j; j.mode = 0; j.sc = nullptr; j.perm = 0; j.koff = 0; j.noff = 0;
    if (jj < 4) {
      j.src = p.in[5] + (size_t)jj * 1024 * 5632; j.K = 1024; j.N = 5632; j.ldsrc = 5632;
      j.dst = (u16*)(ws + OFF_WIN + jj * SZ_WIN); j.dld = 1024; j.sc = p.in[4] + jj * 1024; j.mode = 1; j.perm = 1;
    } else if (jj < 8) {
      int q = jj - 4;
      j.src = p.in[6] + (size_t)q * 2816 * 1024; j.K = 2816; j.N = 1024; j.ldsrc = 1024;
      j.dst = (u16*)(ws + OFF_WOUT + q * SZ_WOUT); j.dld = 2816;
    } else if (jj < 10) {
      int q = jj - 8;
      j.src = p.in[9] + (size_t)q * 1024 * 1024; j.K = 1024; j.N = 1024; j.ldsrc = 1024;
      j.dst = (u16*)(ws + OFF_WPG) + (size_t)q * 1024 * 1024; j.dld = 1024; j.sc = p.in[8] + q * 1024; j.mode = 1;
    } else if (jj < 12) {
      int q = jj - 10;
      j.src = p.in[10] + (size_t)q * 256 * 1024; j.K = 256; j.N = 1024; j.ldsrc = 1024;
      j.dst = (u16*)(ws + OFF_WPP) + (size_t)q * 1024 * 256; j.dld = 256;
    } else if (jj < 28) {
      int q = (jj - 12) >> 1, hf = (jj - 12) & 1;
      j.K = 1024; j.dst = (u16*)(ws + OFF_WRKV); j.dld = 2048; j.koff = hf * 1024; j.mode = hf ? 3 : 2;
      if (q < 3) { j.src = p.in[13] + (size_t)q * 1024 * 1024; j.N = 1024; j.ldsrc = 1024; j.noff = q * 1024; j.sc = p.in[12] + q * 1024; }
      else if (q < 5) { int z = q - 3; j.src = p.in[15] + (size_t)z * 1024 * 64; j.N = 64; j.ldsrc = 64; j.noff = 3072 + z * 64; j.sc = p.in[12] + 3 * 1024; }
      else if (q < 7) { int z = q - 5; j.src = p.in[18] + (size_t)z * 1024 * 64; j.N = 64; j.ldsrc = 64; j.noff = 3200 + z * 64; j.sc = p.in[12] + 4 * 1024; }
      else { j.src = p.in[20]; j.N = 128; j.ldsrc = 128; j.noff = 3328; j.sc = p.in[12] + 5 * 1024; }
    } else if (jj < 30) {
      int z = jj - 28;
      j.src = p.in[16] + (size_t)z * 64 * 1024; j.K = 64; j.N = 1024; j.ldsrc = 1024;
      j.dst = (u16*)(ws + OFF_W2W) + (size_t)z * 1024 * 64; j.dld = 64;
    } else if (jj < 32) {
      int z = jj - 30;
      j.src = p.in[19] + (size_t)z * 64 * 1024; j.K = 64; j.N = 1024; j.ldsrc = 1024;
      j.dst = (u16*)(ws + OFF_W2A) + (size_t)z * 1024 * 64; j.dld = 64;
    } else if (jj == 32) {
      j.src = p.in[21]; j.K = 128; j.N = 1024; j.ldsrc = 1024; j.dst = (u16*)(ws + OFF_WG2); j.dld = 128;
    } else if (jj == 33) {
      j.src = p.in[27]; j.K = 1024; j.N = 1024; j.ldsrc = 1024; j.dst = (u16*)(ws + OFF_WRWO); j.dld = 1024;
    } else if (jj == 34) {
      j.src = p.in[28]; j.K = 1024; j.N = 3072; j.ldsrc = 3072; j.dst = (u16*)(ws + OFF_WQKV); j.dld = 1024; j.sc = p.in[7] + 1024; j.mode = 1;
    } else if (jj == 35) {
      j.src = p.in[31]; j.K = 1024; j.N = 1024; j.ldsrc = 1024; j.dst = (u16*)(ws + OFF_WNAO); j.dld = 1024;
    } else continue;
    prep_tiles(j, shm, nblk, bid);
  }
}

__device__ __forceinline__ void phase_prep(const Params& p, char* shm) {
  char* ws = p.ws;
  prep_weights(p, shm, true, gridDim.x, blockIdx.x);
  float* ss = (float*)(ws + OFF_SS);
  u16* hb = (u16*)(ws + OFF_HB);
  int tid = otid(), half = tid >> 8, t4 = (tid & 255) * 4;
  float* red = (float*)shm;
  for (int r0 = blockIdx.x * 2; r0 < MT; r0 += gridDim.x * 2) {
    int row = r0 + half;
    const float* src = row < MPROMPT ? p.in[0] + (size_t)row * D : p.in[1] + (size_t)(row - MPROMPT) * D;
    float4 v = *(const float4*)(src + t4);
    *(float4*)(p.h + (size_t)row * D + t4) = v;
    uint2 pk; pk.x = pack2(v.x, v.y); pk.y = pack2(v.z, v.w);
    *(uint2*)(hb + (size_t)row * D + t4) = pk;
    float s = v.x * v.x + v.y * v.y + v.z * v.z + v.w * v.w;
#pragma unroll
    for (int o = 32; o > 0; o >>= 1) s += __shfl_xor(s, o);
    __syncthreads();
    if ((tid & 63) == 0) red[tid >> 6] = s;
    __syncthreads();
    if ((tid & 255) == 0) {
      float tot = red[half * 4] + red[half * 4 + 1] + red[half * 4 + 2] + red[half * 4 + 3];
      ss[row] = tot;
#pragma unroll
      for (int q = 1; q < 9; ++q) ss[(size_t)q * MT + row] = 0.f;
    }
  }
}

__device__ __forceinline__ void conv_p(const Params& p, int layer, int nblk, int bid) {
  u16* pbi = (u16*)(p.ws + OFF_PBI) + (size_t)layer * MT * 256;
  const float* pp = p.in[2] + (size_t)layer * MPROMPT * 256;
  const float* ps = p.in[3] + (size_t)layer * (MT - MPROMPT) * 256;
  size_t n4 = (size_t)MT * 256 / 4;
  for (size_t i = (size_t)bid * NTHR + otid(); i < n4; i += (size_t)nblk * NTHR) {
    size_t e = i * 4;
    const float* s = e < (size_t)MPROMPT * 256 ? pp + e : ps + (e - (size_t)MPROMPT * 256);
    float4 v = *(const float4*)s;
    uint2 pk; pk.x = pack2(v.x, v.y); pk.y = pack2(v.z, v.w);
    *(uint2*)(pbi + e) = pk;
  }
}

__device__ __forceinline__ void conv_h(const Params& p) {
  u16* hb = (u16*)(p.ws + OFF_HB);
  size_t n4 = (size_t)MT * D / 4;
  for (size_t i = (size_t)blockIdx.x * NTHR + otid(); i < n4; i += (size_t)gridDim.x * NTHR) {
    float4 v = *(const float4*)(p.h + i * 4);
    uint2 pk; pk.x = pack2(v.x, v.y); pk.y = pack2(v.z, v.w);
    *(uint2*)(hb + i * 4) = pk;
  }
}

enum { E_SWIGLU = 0, E_RESID = 1, E_PLEPROJ = 2, E_PLEGATE = 3, E_RKV = 4, E_RWFIN = 5, E_QKV = 6 };

struct GA {
  const u16* A; const u16* Bt; int K; int N;
  int mtiles, ntiles;
  int rowoff;
  const float* ss_in; float* ss_out;
  const float* bias; float scale;
  float* h; u16* hb;
  u16* o0; u16* o1; u16* o2;
  const float* f0; const float* f1; const float* f2;
};

template <int KS> __device__ __forceinline__ int lds_byte(int r, int c) {
  int st = (r >> 4) * KS + (c >> 5), ob = (r & 15) * 64 + (c & 31) * 2;
  return st * 1024 + (ob ^ (((ob >> 9) & 1) << 5));
}
template <int KS> __device__ __forceinline__ void stage_rc(int b, int& R, int& C) {
  int st = b >> 10, sb = b & 1023, swz = sb ^ (((sb >> 9) & 1) << 5);
  R = (st / KS) * 16 + swz / 64;
  C = (st % KS) * 32 + (swz % 64) / 2;
}

template <int EPI>
__device__ __forceinline__ void gemm_tile(const GA& g, int pm, int pn, bool prefetched, bool has_next, int pm_next, int pn_next, LDSC* shm) {
  constexpr int BK = 64, KS = 2, TILE_B = 256 * BK * 2, GL = 4, STAGE_B = 2 * TILE_B;
  const int K = g.K;
  const int tid = otid(), wid = tid >> 6, lane = tid & 63, wr = wid >> 2, wc = wid & 3, fr = lane & 15, fq = lane >> 4;
  const int brow = pm * 256, bcol = pn * 256;
  const u16* Ab = g.A + (size_t)brow * K;
  const u16* Bb = g.Bt + (size_t)bcol * K;
  const u16* Abn = g.A + (size_t)(pm_next * 256) * K;
  const u16* Bbn = g.Bt + (size_t)(pn_next * 256) * K;
  int sO[GL];
#pragma unroll
  for (int i = 0; i < GL; ++i) { int r_, c_; stage_rc<KS>(wid * 1024 + i * 8192 + lane * 16, r_, c_); sO[i] = r_ * K + c_; }
  f32x4 acc[8][4];
#pragma unroll
  for (int m = 0; m < 8; ++m)
#pragma unroll
    for (int n = 0; n < 4; ++n) acc[m][n] = f32x4{0.f, 0.f, 0.f, 0.f};
  const int nt = K / BK;
#define G_STAGE(buf, AB_, BB_, kt) do { _Pragma("unroll") for (int i = 0; i < GL; ++i) { \
    __builtin_amdgcn_global_load_lds((const unsigned*)((AB_) + (kt) * BK + sO[i]), (LDSU*)(shm + (buf) * STAGE_B + wid * 1024 + i * 8192), 16, 0, 0); \
    __builtin_amdgcn_global_load_lds((const unsigned*)((BB_) + (kt) * BK + sO[i]), (LDSU*)(shm + (buf) * STAGE_B + TILE_B + wid * 1024 + i * 8192), 16, 0, 0); } } while (0)
#define G_STAGE_H(hh, buf, AB_, BB_, kt) do { _Pragma("unroll") for (int i = (hh) * 2; i < (hh) * 2 + 2; ++i) { \
    __builtin_amdgcn_global_load_lds((const unsigned*)((AB_) + (kt) * BK + sO[i]), (LDSU*)(shm + (buf) * STAGE_B + wid * 1024 + i * 8192), 16, 0, 0); \
    __builtin_amdgcn_global_load_lds((const unsigned*)((BB_) + (kt) * BK + sO[i]), (LDSU*)(shm + (buf) * STAGE_B + TILE_B + wid * 1024 + i * 8192), 16, 0, 0); } } while (0)
  if (!prefetched) G_STAGE(0, Ab, Bb, 0);
  asm volatile("s_waitcnt vmcnt(0)" ::: "memory");
  __syncthreads();
  for (int t = 0; t < nt; ++t) {
    int cur = t & 1;
    if (t + 1 < nt) G_STAGE_H(0, cur ^ 1, Ab, Bb, t + 1);
    else if (has_next) G_STAGE_H(0, 0, Abn, Bbn, 0);
    const LDSC* SAp = shm + cur * STAGE_B;
    const LDSC* SBp = SAp + TILE_B;
#pragma unroll
    for (int ks = 0; ks < KS; ++ks) {
      if (ks == 1) {
        if (t + 1 < nt) G_STAGE_H(1, cur ^ 1, Ab, Bb, t + 1);
        else if (has_next) G_STAGE_H(1, 0, Abn, Bbn, 0);
      }
      bf16x8 At[8], Bf[4];
#pragma unroll
      for (int m = 0; m < 8; ++m) At[m] = *(const LDS_BF8*)(SAp + lds_byte<KS>(wr * 128 + m * 16 + fr, ks * 32 + fq * 8));
#pragma unroll
      for (int n = 0; n < 4; ++n) Bf[n] = *(const LDS_BF8*)(SBp + lds_byte<KS>(wc * 64 + n * 16 + fr, ks * 32 + fq * 8));
      __builtin_amdgcn_s_setprio(1);
#pragma unroll
      for (int m = 0; m < 8; ++m)
#pragma unroll
        for (int n = 0; n < 4; ++n) acc[m][n] = __builtin_amdgcn_mfma_f32_16x16x32_bf16(At[m], Bf[n], acc[m][n], 0, 0, 0);
      __builtin_amdgcn_s_setprio(0);
      __builtin_amdgcn_sched_barrier(0);
    }
    if (t + 1 < nt) asm volatile("s_waitcnt vmcnt(0)" ::: "memory");
    __syncthreads();
  }
#undef G_STAGE
#undef G_STAGE_H
  typedef __attribute__((address_space(3))) float LDSF;
  typedef __attribute__((address_space(3))) f32x4 LDSF4;
  LDSF* scr = (LDSF*)(shm + STAGE_B + wid * 4352);
  const int cb = bcol + wc * 64;
#define SLAB_WRITE(m) do { _Pragma("unroll") for (int n = 0; n < 4; ++n) _Pragma("unroll") for (int j = 0; j < 4; ++j) \
    scr[(fq * 4 + j) * 68 + n * 16 + fr] = acc[m][n][j]; asm volatile("s_waitcnt lgkmcnt(0)" ::: "memory"); } while (0)
#define SLAB_DONE() asm volatile("s_waitcnt lgkmcnt(0)" ::: "memory")
  if constexpr (EPI == E_SWIGLU) {
    const int l8 = lane & 7, r8 = lane >> 3;
#pragma unroll
    for (int m = 0; m < 8; ++m) {
      SLAB_WRITE(m);
#pragma unroll
      for (int k = 0; k < 2; ++k) {
        int rl = k * 8 + r8, row = brow + wr * 128 + m * 16 + rl;
        f32x4 gt = *(const LDSF4*)(scr + rl * 68 + l8 * 4), up = *(const LDSF4*)(scr + rl * 68 + 32 + l8 * 4);
        float rs = rstd_of(g.ss_in[g.rowoff + row]);
        float o[4];
#pragma unroll
        for (int e = 0; e < 4; ++e) { float a = gt[e] * rs; o[e] = a * sigm(a) * (up[e] * rs); }
        uint2 pk; pk.x = pack2(o[0], o[1]); pk.y = pack2(o[2], o[3]);
        *(uint2*)(g.o0 + (size_t)row * DFF + (cb >> 1) + l8 * 4) = pk;
      }
      SLAB_DONE();
    }
  } else if constexpr (EPI == E_QKV) {
    const int which = cb >> 10, c0 = cb & 1023;
    if (which == 2) {
#pragma unroll
      for (int m = 0; m < 8; ++m) {
        int row0 = brow + wr * 128 + m * 16 + fq * 4;
        float rs[4];
#pragma unroll
        for (int j = 0; j < 4; ++j) rs[j] = rstd_of(g.ss_in[row0 + j]);
#pragma unroll
        for (int n = 0; n < 4; ++n) {
          int col = c0 + n * 16 + fr;
          float b = g.bias[cb + n * 16 + fr];
          uint2 pk; pk.x = pack2(acc[m][n][0] * rs[0] + b, acc[m][n][1] * rs[1] + b); pk.y = pack2(acc[m][n][2] * rs[2] + b, acc[m][n][3] * rs[3] + b);
          *(uint2*)(g.o2 + (size_t)col * MT + row0) = pk;
        }
      }
    } else {
      u16* dst = which == 0 ? g.o0 : g.o1;
      const float sc = which == 0 ? 0.17677669529663687f : 1.f;
      f32x4 b4 = *(const f32x4*)(g.bias + cb + fr * 4);
#pragma unroll
      for (int m = 0; m < 8; ++m) {
        SLAB_WRITE(m);
#pragma unroll
        for (int k = 0; k < 4; ++k) {
          int rl = k * 4 + fq, row = brow + wr * 128 + m * 16 + rl;
          f32x4 v = *(const LDSF4*)(scr + rl * 68 + fr * 4);
          float rs = rstd_of(g.ss_in[row]);
          uint2 pk; pk.x = pack2((v[0] * rs + b4[0]) * sc, (v[1] * rs + b4[1]) * sc); pk.y = pack2((v[2] * rs + b4[2]) * sc, (v[3] * rs + b4[3]) * sc);
          *(uint2*)(dst + (size_t)row * D + c0 + fr * 4) = pk;
        }
        SLAB_DONE();
      }
    }
  } else {
    float lw[4] = {0.f, 0.f, 0.f, 0.f}, lb[4] = {0.f, 0.f, 0.f, 0.f}, bs[4] = {0.f, 0.f, 0.f, 0.f};
    if constexpr (EPI == E_RWFIN) {
#pragma unroll
      for (int e = 0; e < 4; ++e) { lw[e] = g.f1[cb + fr * 4 + e]; lb[e] = g.f2[cb + fr * 4 + e]; }
    }
    if constexpr (EPI == E_RESID) {
      if (g.bias) {
#pragma unroll
        for (int e = 0; e < 4; ++e) bs[e] = g.bias[cb + fr * 4 + e];
      }
    }
    f32x4 h_n[4]; uint2 a_n[4]; float f_n[4][2];
#define EPI_LOAD(m_) do { _Pragma("unroll") for (int k = 0; k < 4; ++k) { \
      const int row_ = brow + wr * 128 + (m_) * 16 + k * 4 + fq, col_ = cb + fr * 4; \
      if constexpr (EPI == E_RESID || EPI == E_PLEGATE) h_n[k] = *(const f32x4*)(g.h + (size_t)(g.rowoff + row_) * D + col_); \
      if constexpr (EPI == E_PLEGATE) { a_n[k] = *(const uint2*)(g.o0 + (size_t)(g.rowoff + row_) * D + col_); f_n[k][0] = g.ss_in[g.rowoff + row_]; } \
      } } while (0)
    f32x4 h_m[4]; uint2 a_m[4]; float f_m[4][2];
    EPI_LOAD(0);
#pragma unroll
    for (int k = 0; k < 4; ++k) { h_m[k] = h_n[k]; a_m[k] = a_n[k]; f_m[k][0] = f_n[k][0]; }
    EPI_LOAD(1);
#pragma unroll
    for (int m = 0; m < 8; ++m) {
      f32x4 h_c[4]; uint2 a_c[4]; float f_c[4][2];
#pragma unroll
      for (int k = 0; k < 4; ++k) { h_c[k] = h_m[k]; a_c[k] = a_m[k]; f_c[k][0] = f_m[k][0];
                                    h_m[k] = h_n[k]; a_m[k] = a_n[k]; f_m[k][0] = f_n[k][0]; }
      if (m + 2 < 8) EPI_LOAD(m + 2);
      SLAB_WRITE(m);
#pragma unroll
      for (int k = 0; k < 4; ++k) {
        const int rl = k * 4 + fq, row = brow + wr * 128 + m * 16 + rl;
        const int col = cb + fr * 4;
        f32x4 v = *(const LDSF4*)(scr + rl * 68 + fr * 4);
        if constexpr (EPI == E_RESID || EPI == E_PLEGATE) {
          size_t grow = (size_t)(g.rowoff + row);
          float* hp = g.h + grow * D + col;
          f32x4 hv = h_c[k];
          if constexpr (EPI == E_PLEGATE) {
            float rs = rstd_of(f_c[k][0]);
            uint2 pb = a_c[k];
            hv[0] += sigm(v[0] * rs) * bf2f((u16)(pb.x & 0xffff));
            hv[1] += sigm(v[1] * rs) * bf2f((u16)(pb.x >> 16));
            hv[2] += sigm(v[2] * rs) * bf2f((u16)(pb.y & 0xffff));
            hv[3] += sigm(v[3] * rs) * bf2f((u16)(pb.y >> 16));
          } else {
#pragma unroll
            for (int e = 0; e < 4; ++e) hv[e] += g.scale * v[e] + bs[e];
          }
          *(f32x4*)hp = hv;
          if (g.hb != nullptr) {
            uint2 pk; pk.x = pack2(hv[0], hv[1]); pk.y = pack2(hv[2], hv[3]);
            *(uint2*)(g.hb + grow * D + col) = pk;
          }
          float sq = rowsum16(hv[0] * hv[0] + hv[1] * hv[1] + hv[2] * hv[2] + hv[3] * hv[3]);
          if (fr == 0) atomicAdd(g.ss_out + grow, sq);
        } else if constexpr (EPI == E_PLEPROJ) {
          uint2 pk; pk.x = pack2(v[0], v[1]); pk.y = pack2(v[2], v[3]);
          *(uint2*)(g.o0 + (size_t)row * D + col) = pk;
        } else if constexpr (EPI == E_RKV) {
          if (cb < 3072) {
            u16* buf = g.o0 + (size_t)(cb >> 10) * ((size_t)MR * 1024);
            uint2 pk; pk.x = pack2(v[0], v[1]); pk.y = pack2(v[2], v[3]);
            *(uint2*)(buf + (size_t)row * D + (cb & 1023) + fr * 4) = pk;
          } else if (cb < 3456) {
            int which = (cb - 3072) >> 7, c0 = (cb - 3072) & 127;
            u16* buf = g.o1 + (size_t)which * ((size_t)MR * 128);
            if (which == 0) { v[0] = tanhf(v[0]); v[1] = tanhf(v[1]); v[2] = tanhf(v[2]); v[3] = tanhf(v[3]); }
            else if (which == 2) { v[0] = sigm(v[0]); v[1] = sigm(v[1]); v[2] = sigm(v[2]); v[3] = sigm(v[3]); }
            uint2 pk; pk.x = pack2(v[0], v[1]); pk.y = pack2(v[2], v[3]);
            *(uint2*)(buf + (size_t)row * 128 + c0 + fr * 4) = pk;
          }
        } else if constexpr (EPI == E_RWFIN) {
          const int head = cb >> 6;
          size_t idx = (size_t)row * D + col;
          uint2 a0 = *(const uint2*)(g.o0 + idx), a1 = *(const uint2*)(g.o1 + idx), vv = *(const uint2*)(g.o2 + idx);
          float y[4];
          y[0] = bf2f((u16)(a0.x & 0xffff)) + bf2f((u16)(a1.x & 0xffff));
          y[1] = bf2f((u16)(a0.x >> 16)) + bf2f((u16)(a1.x >> 16));
          y[2] = bf2f((u16)(a0.y & 0xffff)) + bf2f((u16)(a1.y & 0xffff));
          y[3] = bf2f((u16)(a0.y >> 16)) + bf2f((u16)(a1.y >> 16));
          float mean = rowsum16(y[0] + y[1] + y[2] + y[3]) * (1.f / 64.f);
#pragma unroll
          for (int e = 0; e < 4; ++e) y[e] -= mean;
          float inv = rsqrtf(rowsum16(y[0] * y[0] + y[1] * y[1] + y[2] * y[2] + y[3] * y[3]) * (1.f / 64.f) + 64e-5f);
          float bon = g.f0[(size_t)row * 16 + head] + g.f0[(size_t)MR * 16 + (size_t)row * 16 + head];
          float vf[4] = {bf2f((u16)(vv.x & 0xffff)), bf2f((u16)(vv.x >> 16)), bf2f((u16)(vv.y & 0xffff)), bf2f((u16)(vv.y >> 16))};
          float o[4];
#pragma unroll
          for (int e = 0; e < 4; ++e) o[e] = (y[e] * inv * lw[e] + lb[e] + bon * vf[e]) * v[e];
          uint2 pk; pk.x = pack2(o[0], o[1]); pk.y = pack2(o[2], o[3]);
          *(uint2*)(g.hb + idx) = pk;
        }
      }
      SLAB_DONE();
    }
  }
#undef SLAB_WRITE
#undef EPI_LOAD
#undef SLAB_DONE
}

template <int EPI> __device__ __forceinline__ void gemm_phase(const GA& g, const GA& g2, LDSC* shm) {
  const int nM = g.mtiles, nN = g.ntiles;
  const int G = gridDim.x;
  const int PN = (nN & 3) == 0 ? 4 : 2, PM = 32 / PN;
  const int sN = nN / PN, sM = nM / PM, nsup = sN * sM;
  const int per = G >> 8;
  const int b = blockIdx.x, x = b & 7, l = (b >> 3) & 31, rep = b >> 8;
  bool pref = false;
  for (int s = x + 8 * rep; s < nsup; s += 8 * per) {
    int sm = s / sN, sn = s % sN;
    int pm = sm * PM + (l % PM), pn = sn * PN + (l / PM);
    int s2 = s + 8 * per;
    bool hn = s2 < nsup;
    int pm2 = (s2 / sN) * PM + (l % PM), pn2 = (s2 % sN) * PN + (l / PM);
    if constexpr (EPI == E_PLEGATE) {
      gemm_tile<E_PLEPROJ>(g2, pm, pn, false, false, pm, pn, shm);
      gemm_tile<E_PLEGATE>(g, pm, pn, false, false, pm, pn, shm);
    } else {
      gemm_tile<EPI>(g, pm, pn, pref, hn, hn ? pm2 : pm, hn ? pn2 : pn, shm);
      pref = hn;
    }
  }
  __syncthreads();
}

__device__ __forceinline__ void phase_mix(const Params& p, int tok0, int ntok) {
  const float* ss1 = (const float*)(p.ws + OFF_SS) + (size_t)1 * MT;
  const float* gain = p.in[7];
  u16* A2 = (u16*)(p.ws + OFF_BIG + BIG_A2);
  int tid = otid(), half = tid >> 8, c4 = (tid & 255) * 4;
  float4 gn = *(const float4*)(gain + c4);
  for (int l0 = blockIdx.x * 2; l0 < ntok; l0 += gridDim.x * 2) {
    int l = l0 + half, tok = tok0 + l;
    int pos, T;
    if (tok < MPROMPT) { pos = tok & 2047; T = 2048; } else { pos = tok - MPROMPT; T = 16384; }
    float4 c = *(const float4*)(p.h + (size_t)tok * D + c4);
    float rc = rstd_of(ss1[tok]);
    float4 hn = {c.x * rc * gn.x, c.y * rc * gn.y, c.z * rc * gn.z, c.w * rc * gn.w};
    float4 av = {0.f, 0.f, 0.f, 0.f};
    if (pos > 0) {
      float4 q = *(const float4*)(p.h + (size_t)(tok - 1) * D + c4);
      float r = rstd_of(ss1[tok - 1]);
      av.x += q.x * r * gn.x; av.y += q.y * r * gn.y; av.z += q.z * r * gn.z; av.w += q.w * r * gn.w;
    }
    if (pos < T - 1) {
      float4 q = *(const float4*)(p.h + (size_t)(tok + 1) * D + c4);
      float r = rstd_of(ss1[tok + 1]);
      av.x += q.x * r * gn.x; av.y += q.y * r * gn.y; av.z += q.z * r * gn.z; av.w += q.w * r * gn.w;
    }
    uint2 a, b;
    a.x = pack2(hn.x, hn.y); a.y = pack2(hn.z, hn.w);
    b.x = pack2(0.5f * av.x, 0.5f * av.y); b.y = pack2(0.5f * av.z, 0.5f * av.w);
    *(uint2*)(A2 + (size_t)l * 2048 + c4) = a;
    *(uint2*)(A2 + (size_t)l * 2048 + 1024 + c4) = b;
  }
}

constexpr int SC_T = 32;
constexpr int SC_ARR = SC_T * 64 * 4;
constexpr int SC_BUF = 6 * SC_ARR;
template <int E> __device__ __forceinline__ float rowsumL(float v) {
  v += dppf<0xB1>(v); v += dppf<0x4E>(v); v += dppf<0x141>(v);
  if (E == 4) v += dppf<0x140>(v);
  return v;
}

template <int E, int R = 1>
__device__ __forceinline__ void scan_item(const Params& p, int seq_loc0, int T, int head, int z, int rowbase, int nw, char* shm) {
  char* big = p.ws + OFF_BIG;
  const u16* Rb = (const u16*)(big + BIG_RKV);
  const u16* Kb = (const u16*)(big + BIG_RKV + SZ_RKV1);
  const u16* Vb = (const u16*)(big + BIG_RKV + 2 * SZ_RKV1);
  const u16* TW = (const u16*)(big + BIG_T);
  const u16* TA = (const u16*)(big + BIG_T + SZ_T1);
  u16* Y = (u16*)(big + (z ? BIG_Y1 : BIG_Y0));
  float* bonus = (float*)(p.ws + OFF_BONUS) + (size_t)z * MR * 16;
  const u16* W2 = (const u16*)(p.ws + OFF_W2W) + (size_t)z * 1024 * 64;
  const u16* A2w = (const u16*)(p.ws + OFF_W2A) + (size_t)z * 1024 * 64;
  const float* w0 = p.in[14] + z * 1024 + head * 64;
  const float* a0 = p.in[17] + z * 1024 + head * 64;
  const int tid = otid(), wv = tid >> 6, lane = tid & 63, fr = lane & 15, fq = lane >> 4;
  float* Ybuf = (float*)(shm + 2 * SC_BUF);
  const int si = tid >> 4, ec4 = (tid & 15) * 4;
  float4 ckk = *(const float4*)(p.in[22] + head * 64 + ec4);
  float4 cka = *(const float4*)(p.in[23] + head * 64 + ec4);
  float4 crk = *(const float4*)(p.in[24] + head * 64 + ec4);
  const int mt = wv >> 2, ntl = wv & 3;
  bf16x8 Bw[2], Ba[2];
#pragma unroll
  for (int ks = 0; ks < 2; ++ks) {
    Bw[ks] = *(const bf16x8*)(W2 + (size_t)(head * 64 + ntl * 16 + fr) * 64 + ks * 32 + fq * 8);
    Ba[ks] = *(const bf16x8*)(A2w + (size_t)(head * 64 + ntl * 16 + fr) * 64 + ks * 32 + fq * 8);
  }
  const float w0c = w0[ntl * 16 + fr], a0c = a0[ntl * 16 + fr];
  constexpr int LPR = 64 / E, RPW = R * (64 / LPR), NP = E / 2, NQ = E / 4;
  const int le = lane % LPR, row0 = rowbase + wv * RPW + (lane / LPR) * R;
  f32x2 st[R][NP];
#pragma unroll
  for (int r = 0; r < R; ++r)
#pragma unroll
    for (int q = 0; q < NP; ++q) st[r][q] = f32x2{0.f, 0.f};
  float skc = 0.f, sklast = 0.f;
  f32x2 ulast0 = {0.f, 0.f}, ulast1 = {0.f, 0.f};
  f32x4 kalast = {0.f, 0.f, 0.f, 0.f};
  const int nch = T / SC_T;
  uint2 pr, pk, pv; bf16x8 Aw[2], Aa[2];
  auto tok_of = [&](int t) { return seq_loc0 + (z ? (T - 1 - t) : t); };
#define SC_LOAD(c) do { \
    int tk_ = tok_of((c) * SC_T + si); \
    pr = *(const uint2*)(Rb + (size_t)tk_ * D + head * 64 + ec4); \
    pk = *(const uint2*)(Kb + (size_t)tk_ * D + head * 64 + ec4); \
    pv = *(const uint2*)(Vb + (size_t)tk_ * D + head * 64 + ec4); \
    int tm_ = tok_of((c) * SC_T + mt * 16 + fr); \
    _Pragma("unroll") for (int ks = 0; ks < 2; ++ks) { \
      Aw[ks] = *(const bf16x8*)(TW + (size_t)tm_ * 128 + z * 64 + ks * 32 + fq * 8); \
      Aa[ks] = *(const bf16x8*)(TA + (size_t)tm_ * 128 + z * 64 + ks * 32 + fq * 8); } } while (0)
#define SC_LORA(b) do { \
    f32x4 cw = {0.f, 0.f, 0.f, 0.f}, ca = {0.f, 0.f, 0.f, 0.f}; \
    _Pragma("unroll") for (int ks = 0; ks < 2; ++ks) { \
      cw = __builtin_amdgcn_mfma_f32_16x16x32_bf16(Aw[ks], Bw[ks], cw, 0, 0, 0); \
      ca = __builtin_amdgcn_mfma_f32_16x16x32_bf16(Aa[ks], Ba[ks], ca, 0, 0, 0); } \
    float* Wl_ = (float*)(shm + (b) * SC_BUF); float* Al_ = (float*)(shm + (b) * SC_BUF + 3 * SC_ARR); \
    _Pragma("unroll") for (int j = 0; j < 4; ++j) { \
      int st_ = mt * 16 + fq * 4 + j; \
      Wl_[st_ * 64 + ntl * 16 + fr] = __expf(-0.6065306597126334f * sigm(w0c + cw[j])); \
      Al_[st_ * 64 + ntl * 16 + fr] = sigm(a0c + ca[j]); } } while (0)
#define SC_ELEM(b, c) do { \
    char* bb_ = shm + (b) * SC_BUF; \
    float4 a4 = *(const float4*)(bb_ + 3 * SC_ARR + (si * 64 + ec4) * 4); \
    float r0 = bf2f((u16)(pr.x & 0xffff)), r1 = bf2f((u16)(pr.x >> 16)), r2 = bf2f((u16)(pr.y & 0xffff)), r3 = bf2f((u16)(pr.y >> 16)); \
    float k0 = bf2f((u16)(pk.x & 0xffff)), k1 = bf2f((u16)(pk.x >> 16)), k2 = bf2f((u16)(pk.y & 0xffff)), k3 = bf2f((u16)(pk.y >> 16)); \
    float v0 = bf2f((u16)(pv.x & 0xffff)), v1 = bf2f((u16)(pv.x >> 16)), v2 = bf2f((u16)(pv.y & 0xffff)), v3 = bf2f((u16)(pv.y >> 16)); \
    float q0 = k0 * ckk.x, q1 = k1 * ckk.y, q2 = k2 * ckk.z, q3 = k3 * ckk.w; \
    float n2 = rowsum16(q0 * q0 + q1 * q1 + q2 * q2 + q3 * q3); \
    float inv_ = rsqrtf(fmaxf(n2, 1e-24f)); \
    q0 *= inv_; q1 *= inv_; q2 *= inv_; q3 *= inv_; \
    float d0 = k0 * (1.f + (a4.x - 1.f) * cka.x), d1 = k1 * (1.f + (a4.y - 1.f) * cka.y), d2 = k2 * (1.f + (a4.z - 1.f) * cka.z), d3 = k3 * (1.f + (a4.w - 1.f) * cka.w); \
    float bn = rowsum16(r0 * d0 * crk.x + r1 * d1 * crk.y + r2 * d2 * crk.z + r3 * d3 * crk.w); \
    if (rowbase == 0 && (tid & 15) == 0) bonus[(size_t)tok_of((c) * SC_T + si) * 16 + head] = bn; \
    *(float4*)(bb_ + 1 * SC_ARR + (si * 64 + ec4) * 4) = float4{q0, q1, q2, q3}; \
    *(float4*)(bb_ + 2 * SC_ARR + (si * 64 + ec4) * 4) = float4{d0, d1, d2, d3}; \
    *(float4*)(bb_ + 3 * SC_ARR + (si * 64 + ec4) * 4) = float4{q0 * a4.x, q1 * a4.y, q2 * a4.z, q3 * a4.w}; \
    *(float4*)(bb_ + 4 * SC_ARR + (si * 64 + ec4) * 4) = float4{r0, r1, r2, r3}; \
    *(float4*)(bb_ + 5 * SC_ARR + (si * 64 + ec4) * 4) = float4{v0, v1, v2, v3}; } while (0)

  __syncthreads();
  SC_LOAD(0);
  SC_LORA(0);
  __syncthreads();
  SC_ELEM(0, 0);
  __syncthreads();
  for (int c = 0; c < nch; ++c) {
    const int b = c & 1;
    if (c + 1 < nch) SC_LOAD(c + 1);
    const char* bb = shm + b * SC_BUF;
    if (wv < nw) {
      f32x4 cw[NQ], ckq[NQ], ckd[NQ], cka4[NQ], cr[NQ]; float vv[R];
#define SC_LD(i_, W_, KK_, KD_, KA_, R_, V_) do { _Pragma("unroll") for (int q = 0; q < NQ; ++q) { \
        W_[q] = *(const f32x4*)(bb + 0 * SC_ARR + ((i_) * 64 + le * E + q * 4) * 4); \
        KK_[q] = *(const f32x4*)(bb + 1 * SC_ARR + ((i_) * 64 + le * E + q * 4) * 4); \
        KD_[q] = *(const f32x4*)(bb + 2 * SC_ARR + ((i_) * 64 + le * E + q * 4) * 4); \
        KA_[q] = *(const f32x4*)(bb + 3 * SC_ARR + ((i_) * 64 + le * E + q * 4) * 4); \
        R_[q] = *(const f32x4*)(bb + 4 * SC_ARR + ((i_) * 64 + le * E + q * 4) * 4); } \
        _Pragma("unroll") for (int r = 0; r < R; ++r) V_[r] = *(const float*)(bb + 5 * SC_ARR + ((i_) * 64 + row0 + r) * 4); } while (0)
      SC_LD(0, cw, ckq, ckd, cka4, cr, vv);
      f32x4 mw_[NQ], mkq[NQ], mkd[NQ], mka[NQ], mr[NQ]; float mvv[R];
      if constexpr (E == 4) {
        SC_LD(1, mw_, mkq, mkd, mka, mr, mvv);
        f32x2 pu = ulast0 * ckq[0].lo + ulast1 * ckq[0].hi;
        f32x2 pc = kalast.lo * ckq[0].lo + kalast.hi * ckq[0].hi;
        skc = rowsumL<E>(pu.x + pu.y) - sklast * rowsumL<E>(pc.x + pc.y);
      }
#pragma unroll 8
      for (int i = 0; i < SC_T; ++i) {
        f32x4 nw_[NQ], nkq[NQ], nkd[NQ], nka[NQ], nr[NQ]; float nvv[R];
        const int in_ = (i + (E == 4 ? 2 : 1)) & (SC_T - 1);
        SC_LD(in_, nw_, nkq, nkd, nka, nr, nvv);
        float sk[R], yy[R];
        f32x2 uq[R][NP];
        if constexpr (E == 4) {
          f32x2 u0 = st[0][0] * cw[0].lo + ckd[0].lo * vv[0];
          f32x2 u1 = st[0][1] * cw[0].hi + ckd[0].hi * vv[0];
          st[0][0] = u0 - cka4[0].lo * skc;
          st[0][1] = u1 - cka4[0].hi * skc;
          f32x2 pu = u0 * mkq[0].lo + u1 * mkq[0].hi;
          f32x2 pc = cka4[0].lo * mkq[0].lo + cka4[0].hi * mkq[0].hi;
          const float rr_ = rowsumL<E>(pu.x + pu.y), cc_ = rowsumL<E>(pc.x + pc.y);
          ulast0 = u0; ulast1 = u1; kalast = cka4[0]; sklast = skc;
          skc = rr_ - skc * cc_;
          f32x2 ya = st[0][0] * cr[0].lo + st[0][1] * cr[0].hi;
          yy[0] = ya.x + ya.y;
        } else {
#pragma unroll
        for (int r = 0; r < R; ++r) {
          f32x2 da = st[r][0] * ckq[0].lo;
#pragma unroll
          for (int q = 1; q < NP; ++q) da += st[r][q] * ((q & 1) ? ckq[q >> 1].hi : ckq[q >> 1].lo);
#pragma unroll
          for (int q = 0; q < NP; ++q) {
            f32x2 kdq = (q & 1) ? ckd[q >> 1].hi : ckd[q >> 1].lo;
            f32x2 wq = (q & 1) ? cw[q >> 1].hi : cw[q >> 1].lo;
            uq[r][q] = st[r][q] * wq + kdq * vv[r];
          }
          sk[r] = da.x + da.y;
        }
#pragma unroll
        for (int r = 0; r < R; ++r) sk[r] = rowsumL<E>(sk[r]);
#pragma unroll
        for (int r = 0; r < R; ++r) {
#pragma unroll
          for (int q = 0; q < NP; ++q) {
            f32x2 kaq = (q & 1) ? cka4[q >> 1].hi : cka4[q >> 1].lo;
            st[r][q] = uq[r][q] - kaq * sk[r];
          }
          f32x2 ya = st[r][0] * cr[0].lo;
#pragma unroll
          for (int q = 1; q < NP; ++q) ya += st[r][q] * ((q & 1) ? cr[q >> 1].hi : cr[q >> 1].lo);
          yy[r] = ya.x + ya.y;
        }
        }
#pragma unroll
        for (int r = 0; r < R; ++r) yy[r] = rowsumL<E>(yy[r]);
        if (le == 0) {
#pragma unroll
          for (int r = 0; r < R; ++r) Ybuf[i * 64 + row0 + r] = yy[r];
        }
        if constexpr (E == 4) {
#pragma unroll
          for (int q = 0; q < NQ; ++q) { cw[q] = mw_[q]; ckq[q] = mkq[q]; ckd[q] = mkd[q]; cka4[q] = mka[q]; cr[q] = mr[q];
                                         mw_[q] = nw_[q]; mkq[q] = nkq[q]; mkd[q] = nkd[q]; mka[q] = nka[q]; mr[q] = nr[q]; }
#pragma unroll
          for (int r = 0; r < R; ++r) { vv[r] = mvv[r]; mvv[r] = nvv[r]; }
        } else {
#pragma unroll
          for (int q = 0; q < NQ; ++q) { cw[q] = nw_[q]; ckq[q] = nkq[q]; ckd[q] = nkd[q]; cka4[q] = nka[q]; cr[q] = nr[q]; }
#pragma unroll
          for (int r = 0; r < R; ++r) vv[r] = nvv[r];
        }
      }
#undef SC_LD
    }
    if (c + 1 < nch) SC_LORA(b ^ 1);
    __syncthreads();
    if (c + 1 < nch) SC_ELEM(b ^ 1, c + 1);
    {
      int tk = tok_of(c * SC_T + si);
      int rr = (tid & 15) * 4;
      if (rr >= rowbase && rr < rowbase + nw * RPW) {
        float4 yv = *(const float4*)(Ybuf + si * 64 + rr);
        uint2 pk2; pk2.x = pack2(yv.x, yv.y); pk2.y = pack2(yv.z, yv.w);
        *(uint2*)(Y + (size_t)tk * D + head * 64 + rr) = pk2;
      }
    }
    __syncthreads();
  }
#undef SC_LOAD
#undef SC_LORA
#undef SC_ELEM
}

__device__ __forceinline__ void phase_scan(const Params& p, char* shm) {
  const int G = gridDim.x, b = blockIdx.x;
  const int nS = 128, nP = 16 * 32;
  int j, step;
  if (G > nS) { if (b < nS) { j = b; step = 1 << 30; } else { j = nS + (b - nS); step = G - nS; } }
  else { j = b; step = G; }
  for (; j < nS + nP; j += step) {
    if (j < nS) scan_item<4>(p, MPROMPT, 16384, (j >> 3) & 15, (j >> 2) & 1, (j & 3) * 16, 4, shm);
    else { int q = j - nS; scan_item<8, 2>(p, (q >> 5) * 2048, 2048, (q >> 1) & 15, q & 1, 0, 4, shm); }
  }
  __syncthreads();
  if (G > nS) { if (b >= nS) { prep_weights(p, shm, false, G - nS, b - nS); conv_p(p, 0, G - nS, b - nS); conv_p(p, 1, G - nS, b - nS); } }
  else { prep_weights(p, shm, false, G, b); conv_p(p, 0, G, b); conv_p(p, 1, G, b); }
}

__device__ __forceinline__ void phase_natt(const Params& p, u16* Odst, char* shm) {
  char* big = p.ws + OFF_BIG;
  const u16* Q = (const u16*)(big + BIG_Q);
  const u16* Kb = (const u16*)(big + BIG_K);
  const u16* Vt = (const u16*)(big + BIG_VT);
  const int tid = otid(), wv = tid >> 6, lane = tid & 63, fr = lane & 15, fq = lane >> 4;
  const int hg = blockIdx.x & 3, h = hg * 8 + wv;
  float* tab = (float*)(shm + wv * 3840);
  {
    const float* rp = p.in[30] + (size_t)h * 15 * 31;
    for (int idx = lane; idx < 960; idx += 64) tab[idx] = 0.f;
    asm volatile("s_waitcnt lgkmcnt(0)" ::: "memory");
    for (int idx = lane; idx < 465; idx += 64) { int r = idx / 31, c = idx - r * 31; tab[r * 64 + 16 + c] = rp[idx]; }
    asm volatile("s_waitcnt lgkmcnt(0)" ::: "memory");
  }
  const int nqb = MT / 16, qstep = gridDim.x >> 2;
  for (int qb = blockIdx.x >> 2; qb < nqb; qb += qstep) {
    int tb = qb * 16;
    int seqbase, T, loc;
    if (tb < MPROMPT) { seqbase = tb & ~2047; T = 2048; loc = tb & 2047; } else { seqbase = MPROMPT; T = 16384; loc = tb - MPROMPT; }
    int rows = T >> 6, i = loc >> 6, cbq = (loc & 63) >> 4;
    int rs = min(max(i - 4, 0), rows - 8);
    int kvs = min(max(cbq * 16 - 8, 0), 32);
    int qc = cbq * 16 + fr;
    int ws_ = min(max(qc - 8, 0), 48);
    bf16x8 qf = *(const bf16x8*)(Q + (size_t)(tb + fr) * D + h * 32 + fq * 8);
    unsigned vm = 0;
#pragma unroll
    for (int e = 0; e < 8; ++e) { int kcol = kvs + fq * 8 + e; vm |= ((kcol >= ws_) && (kcol < ws_ + 16)) ? (1u << e) : 0u; }
    const float* trow = tab + (rs - i + 7) * 64 + 16 + (kvs + fq * 8 - qc + 15);
    bf16x8 kf[8][2];
#pragma unroll
    for (int r = 0; r < 8; ++r)
#pragma unroll
      for (int hb2 = 0; hb2 < 2; ++hb2) {
        int kcolA = kvs + (fr >> 2) * 8 + hb2 * 4 + (fr & 3);
        size_t ktok = (size_t)seqbase + (size_t)(rs + r) * 64 + kcolA;
        kf[r][hb2] = *(const bf16x8*)(Kb + ktok * D + h * 32 + fq * 8);
      }
    f32x4 sc[8][2];
    float mx = -1e30f;
#pragma unroll
    for (int r = 0; r < 8; ++r) {
#pragma unroll
      for (int hb2 = 0; hb2 < 2; ++hb2) {
        f32x4 a = __builtin_amdgcn_mfma_f32_16x16x32_bf16(kf[r][hb2], qf, f32x4{0.f, 0.f, 0.f, 0.f}, 0, 0, 0);
#pragma unroll
        for (int j = 0; j < 4; ++j) {
          float sv = ((vm >> (hb2 * 4 + j)) & 1u) ? a[j] + trow[r * 64 + hb2 * 4 + j] : -1e30f;
          a[j] = sv; mx = fmaxf(mx, sv);
        }
        sc[r][hb2] = a;
      }
    }
    mx = fmaxf(mx, __shfl_xor(mx, 16));
    mx = fmaxf(mx, __shfl_xor(mx, 32));
    float sum = 0.f;
    f32x4 o0 = {0.f, 0.f, 0.f, 0.f}, o1 = {0.f, 0.f, 0.f, 0.f};
#pragma unroll
    for (int r = 0; r < 8; ++r) {
      bf16x8 pf;
#pragma unroll
      for (int e = 0; e < 8; ++e) {
        float pe = __expf(sc[r][e >> 2][e & 3] - mx);
        sum += pe;
        pf[e] = (short)f2bf(pe);
      }
      size_t vbase = (size_t)seqbase + (size_t)(rs + r) * 64 + kvs + fq * 8;
      bf16x8 v0 = *(const bf16x8*)(Vt + (size_t)(h * 32 + fr) * MT + vbase);
      bf16x8 v1 = *(const bf16x8*)(Vt + (size_t)(h * 32 + 16 + fr) * MT + vbase);
      o0 = __builtin_amdgcn_mfma_f32_16x16x32_bf16(v0, pf, o0, 0, 0, 0);
      o1 = __builtin_amdgcn_mfma_f32_16x16x32_bf16(v1, pf, o1, 0, 0, 0);
    }
    sum += __shfl_xor(sum, 16);
    sum += __shfl_xor(sum, 32);
    float inv = 1.f / sum;
    uint2 w0, w1;
    w0.x = pack2(o0[0] * inv, o0[1] * inv); w0.y = pack2(o0[2] * inv, o0[3] * inv);
    w1.x = pack2(o1[0] * inv, o1[1] * inv); w1.y = pack2(o1[2] * inv, o1[3] * inv);
    *(uint2*)(Odst + (size_t)(tb + fr) * D + h * 32 + fq * 4) = w0;
    *(uint2*)(Odst + (size_t)(tb + fr) * D + h * 32 + 16 + fq * 4) = w1;
  }
}

__device__ __forceinline__ void phase_final(const Params& p) {
  const float* ss8 = (const float*)(p.ws + OFF_SS) + (size_t)8 * MT;
  const float* gain = p.in[11];
  int tid = otid(), half = tid >> 8, c4 = (tid & 255) * 4;
  float4 gn = *(const float4*)(gain + c4);
  for (int r0 = blockIdx.x * 2; r0 < MT; r0 += gridDim.x * 2) {
    int row = r0 + half;
    float rs = rstd_of(ss8[row]);
    float4 v = *(float4*)(p.h + (size_t)row * D + c4);
    v.x *= rs * gn.x; v.y *= rs * gn.y; v.z *= rs * gn.z; v.w *= rs * gn.w;
    *(float4*)(p.h + (size_t)row * D + c4) = v;
  }
}

constexpr int NPHASE = 20;
#ifndef PROBE_MASK
#define PROBE_MASK 0ull
#endif

enum { K_NONE = 0, K_PREP, K_FFN1, K_FFN2, K_MIX, K_RKV, K_SCAN, K_FIN, K_RWO, K_PPROJ, K_PGATE, K_CONVH, K_QKV, K_NATT, K_NAO, K_FINAL };

__device__ __forceinline__ void run_phase(const Params& p, int ph, LDSC* shml) {
  char* shm = (char*)shml;
  char* ws = p.ws;
  float* ss = (float*)(ws + OFF_SS);
  u16* hb = (u16*)(ws + OFF_HB);
  char* big = ws + OFF_BIG;
  int kind = K_NONE, a = 0, b = 0, c = 0, d = 0;
  switch (ph) {
    case 0: kind = K_PREP; break;
    case 1: kind = K_FFN1; a = 0; b = 0; c = 0; d = 0; break;
    case 2: kind = K_FFN2; a = 0; b = 0; c = 1; break;
    case 3: kind = K_MIX; break;
    case 4: kind = K_RKV; break;
    case 5: kind = K_SCAN; break;
    case 6: kind = K_FIN; break;
    case 7: kind = K_RWO; break;
    case 8: kind = K_FFN1; a = 0; b = 1; c = 2; d = 1; break;
    case 9: kind = K_FFN2; a = 0; b = 1; c = 3; break;
    case 10: kind = K_PGATE; a = 0; b = 3; c = 4; break;
    case 11: kind = K_FFN1; a = 1; b = 0; c = 4; d = 0; break;
    case 12: kind = K_FFN2; a = 1; b = 0; c = 5; break;
    case 13: kind = K_QKV; break;
    case 14: kind = K_NATT; break;
    case 15: kind = K_NAO; break;
    case 16: kind = K_FFN1; a = 1; b = 1; c = 6; d = 1; break;
    case 17: kind = K_FFN2; a = 1; b = 1; c = 7; break;
    case 18: kind = K_PGATE; a = 1; b = 7; c = 8; break;
    case 19: kind = K_FINAL; break;
    default: break;
  }
  GA g;
  g.A = nullptr; g.Bt = nullptr; g.K = 0; g.N = 0; g.mtiles = 0; g.ntiles = 0; g.rowoff = 0;
  g.ss_in = nullptr; g.ss_out = nullptr; g.bias = nullptr; g.scale = 1.f; g.h = p.h; g.hb = hb;
  g.o0 = nullptr; g.o1 = nullptr; g.o2 = nullptr; g.f0 = nullptr; g.f1 = nullptr; g.f2 = nullptr;
  GA g2 = g;
  int epi = -1;
  const int tok0 = 0, ntok = MT;
  switch (kind) {
    case K_PREP: phase_prep(p, shm); break;
    case K_FFN1:
      g.A = (a == 1 && b == 0) ? (const u16*)(big + BIG_HBALT) : hb;
      g.Bt = (const u16*)(ws + OFF_WIN + (size_t)(a * 2 + b) * SZ_WIN); g.K = 1024; g.N = 5632;
      g.mtiles = MT / 256; g.ntiles = 22; g.ss_in = ss + (size_t)c * MT; g.o0 = (u16*)(big + BIG_ACTB);
      epi = E_SWIGLU; break;
    case K_FFN2:
      g.A = (const u16*)(big + BIG_ACTB); g.Bt = (const u16*)(ws + OFF_WOUT + (size_t)(a * 2 + b) * SZ_WOUT); g.K = DFF; g.N = 1024;
      g.mtiles = MT / 256; g.ntiles = 4; g.ss_out = ss + (size_t)c * MT; g.scale = 0.5f;
      if (a == 0 && b == 0) g.hb = nullptr;
      epi = E_RESID; break;
    case K_MIX: phase_mix(p, tok0, ntok); break;
    case K_RKV:
      g.A = (const u16*)(big + BIG_A2); g.Bt = (const u16*)(ws + OFF_WRKV); g.K = 2048; g.N = 3456;
      g.mtiles = ntok / 256; g.ntiles = 14; g.o0 = (u16*)(big + BIG_RKV); g.o1 = (u16*)(big + BIG_T);
      epi = E_RKV; break;
    case K_SCAN: phase_scan(p, shm); break;
    case K_FIN:
      g.A = (const u16*)(big + BIG_T + 2 * SZ_T1); g.Bt = (const u16*)(ws + OFF_WG2); g.K = 128; g.N = 1024;
      g.mtiles = ntok / 256; g.ntiles = 4;
      g.o0 = (u16*)(big + BIG_Y0); g.o1 = (u16*)(big + BIG_Y1); g.o2 = (u16*)(big + BIG_RKV + 2 * SZ_RKV1);
      g.hb = (u16*)(big + BIG_RKV + SZ_RKV1);
      g.f0 = (const float*)(ws + OFF_BONUS); g.f1 = p.in[25]; g.f2 = p.in[26];
      epi = E_RWFIN; break;
    case K_RWO:
      g.A = (const u16*)(big + BIG_RKV + SZ_RKV1); g.Bt = (const u16*)(ws + OFF_WRWO); g.K = 1024; g.N = 1024;
      g.mtiles = ntok / 256; g.ntiles = 4; g.rowoff = tok0; g.ss_out = ss + (size_t)2 * MT; g.scale = 1.f;
      epi = E_RESID; break;
    case K_PGATE:
      g2 = g;
      g2.A = (const u16*)(ws + OFF_PBI) + (size_t)a * MT * 256; g2.Bt = (const u16*)(ws + OFF_WPP) + (size_t)a * 1024 * 256; g2.K = 256; g2.N = 1024;
      g2.mtiles = MT / 256; g2.ntiles = 4; g2.o0 = (u16*)(big + BIG_PB);
      g.hb = a == 0 ? (u16*)(big + BIG_HBALT) : nullptr;
      g.A = hb; g.Bt = (const u16*)(ws + OFF_WPG) + (size_t)a * 1024 * 1024; g.K = 1024; g.N = 1024;
      g.mtiles = MT / 256; g.ntiles = 4; g.ss_in = ss + (size_t)b * MT; g.ss_out = ss + (size_t)c * MT; g.o0 = (u16*)(big + BIG_PB);
      epi = E_PLEGATE; break;
    case K_QKV:
      g.A = hb; g.Bt = (const u16*)(ws + OFF_WQKV); g.K = 1024; g.N = 3072; g.mtiles = MT / 256; g.ntiles = 12;
      g.ss_in = ss + (size_t)5 * MT; g.bias = p.in[29];
      g.o0 = (u16*)(big + BIG_Q); g.o1 = (u16*)(big + BIG_K); g.o2 = (u16*)(big + BIG_VT);
      epi = E_QKV; break;
    case K_NATT:
#ifdef PROBE_NATT
      phase_natt(p, hb, shm); __syncthreads();
#endif
      phase_natt(p, (u16*)(big + BIG_Q), shm); break;
    case K_NAO:
      g.A = (const u16*)(big + BIG_Q); g.Bt = (const u16*)(ws + OFF_WNAO); g.K = 1024; g.N = 1024; g.mtiles = MT / 256; g.ntiles = 4;
      g.ss_out = ss + (size_t)6 * MT; g.bias = p.in[32]; g.scale = 1.f;
      epi = E_RESID; break;
    case K_FINAL: phase_final(p); break;
    default: break;
  }
  switch (epi) {
    case E_SWIGLU: gemm_phase<E_SWIGLU>(g, g2, shml); break;
    case E_RESID: gemm_phase<E_RESID>(g, g2, shml); break;
    case E_PLEGATE: gemm_phase<E_PLEGATE>(g, g2, shml); break;
    case E_RKV: gemm_phase<E_RKV>(g, g2, shml); break;
    case E_RWFIN: gemm_phase<E_RWFIN>(g, g2, shml); break;
    case E_QKV: gemm_phase<E_QKV>(g, g2, shml); break;
    default: break;
  }
}

__device__ __forceinline__ void grid_barrier(unsigned* bar, unsigned& nbar) {
  asm volatile("s_waitcnt vmcnt(0)" ::: "memory");
  __syncthreads();
  nbar += 1;
  if (otid() == 0) {
    __builtin_amdgcn_s_waitcnt(0);
    __builtin_amdgcn_fence(__ATOMIC_RELEASE, "agent");
    asm volatile("s_waitcnt vmcnt(0)" ::: "memory");
    __hip_atomic_fetch_add(bar, 1u, __ATOMIC_RELAXED, __HIP_MEMORY_SCOPE_AGENT);
    const unsigned target = nbar * gridDim.x;
    while (__hip_atomic_load(bar, __ATOMIC_RELAXED, __HIP_MEMORY_SCOPE_AGENT) < target) __builtin_amdgcn_s_sleep(1);
    __builtin_amdgcn_fence(__ATOMIC_ACQUIRE, "agent");
    asm volatile("s_waitcnt vmcnt(0)" ::: "memory");
  }
  __syncthreads();
}

__global__ void __launch_bounds__(NTHR, 2) fwd_megakernel(Params p, int ph_lo, int ph_hi) {
  __shared__ __attribute__((aligned(1024))) char shm[131072];
  cg::grid_group grid = cg::this_grid();
  unsigned* bar = (unsigned*)(p.ws + OFF_BAR);
  if (blockIdx.x == 0 && otid() == 0) __hip_atomic_store(bar, 0u, __ATOMIC_RELAXED, __HIP_MEMORY_SCOPE_AGENT);
  unsigned nbar = 0;
  for (int ph = ph_lo; ph < ph_hi; ++ph) {
#if PROBE_MASK
    if ((PROBE_MASK >> ph) & 1ull) { run_phase(p, ph, (LDSC*)shm); if (ph == ph_lo) grid.sync(); else grid_barrier(bar, nbar); }
#endif
    run_phase(p, ph, (LDSC*)shm);
    if (ph + 1 < ph_hi) {
      if (ph == ph_lo) grid.sync(); else grid_barrier(bar, nbar);
    }
  }
}

extern "C" void kernel_launch(void* const* d_in, const int* in_sizes, int n_in, void* d_out, int out_size, void* d_ws, size_t ws_size,
                              hipStream_t stream) {
  static int grid_blocks = 0;
  if (!grid_blocks) {
    int dev = 0, cus = 0, per_cu = 0;
    hipGetDevice(&dev);
    hipDeviceGetAttribute(&cus, hipDeviceAttributeMultiprocessorCount, dev);
    hipOccupancyMaxActiveBlocksPerMultiprocessor(&per_cu, fwd_megakernel, NTHR, 0);
    (void)per_cu;
    grid_blocks = 256;
    if (cus < 256) { fprintf(stderr, "device has %d CUs, this kernel needs 256\n", cus); grid_blocks = -1; }
  }
  if (grid_blocks < 0) return;
  if (ws_size < OFF_BIG + BIG_T + 3 * SZ_T1) return;
  Params p{};
  for (int i = 0; i < 33; ++i) p.in[i] = (const float*)d_in[i];
  p.h = (float*)d_out;
  p.ws = (char*)d_ws;
  int lo = 0, hi = NPHASE;
  void* args[] = {&p, &lo, &hi};
  hipError_t e = hipLaunchCooperativeKernel((void*)fwd_megakernel, dim3(grid_blocks), dim3(NTHR), args, 0, stream);
  if (e != hipSuccess) fprintf(stderr, "cooperative launch failed: %s (grid %d)\n", hipGetErrorString(e), grid_blocks);
}
```

```cpp
#include <hip/hip_runtime.h>
#include <hip/hip_cooperative_groups.h>
#include <cstdio>
#include <cstdint>
namespace cg = cooperative_groups;

typedef unsigned short u16;
using bf16x8 = __attribute__((ext_vector_type(8))) short;
using f32x4 = __attribute__((ext_vector_type(4))) float;
using f32x2 = __attribute__((ext_vector_type(2))) float;
using i32x4 = __attribute__((ext_vector_type(4))) int;
typedef __attribute__((address_space(3))) char LDSC;
typedef __attribute__((address_space(3))) unsigned LDSU;
typedef __attribute__((address_space(3))) bf16x8 LDS_BF8;

constexpr int MT = 49152;
constexpr int MPROMPT = 32768;
constexpr int MR = MT;
constexpr int D = 1024;
constexpr int DFF = 2816;
constexpr int NTHR = 512;

constexpr size_t SZ_WIN = (size_t)5632 * 1024 * 2;
constexpr size_t SZ_WOUT = (size_t)1024 * 2816 * 2;
constexpr size_t OFF_WIN = 0;
constexpr size_t OFF_WOUT = OFF_WIN + 4 * SZ_WIN;
constexpr size_t OFF_WPG = OFF_WOUT + 4 * SZ_WOUT;
constexpr size_t OFF_WPP = OFF_WPG + 2 * (size_t)1024 * 1024 * 2;
constexpr size_t OFF_WRKV = OFF_WPP + 2 * (size_t)1024 * 256 * 2;
constexpr size_t OFF_W2W = OFF_WRKV + (size_t)3584 * 2048 * 2;
constexpr size_t OFF_W2A = OFF_W2W + 2 * (size_t)1024 * 64 * 2;
constexpr size_t OFF_WG2 = OFF_W2A + 2 * (size_t)1024 * 64 * 2;
constexpr size_t OFF_WRWO = OFF_WG2 + (size_t)1024 * 128 * 2;
constexpr size_t OFF_WQKV = OFF_WRWO + (size_t)1024 * 1024 * 2;
constexpr size_t OFF_WNAO = OFF_WQKV + (size_t)3072 * 1024 * 2;
constexpr size_t OFF_SS = OFF_WNAO + (size_t)1024 * 1024 * 2;
constexpr size_t OFF_BONUS = OFF_SS + 9 * (size_t)MT * 4;
constexpr size_t OFF_BAR = OFF_BONUS + 2 * (size_t)MR * 16 * 4;
constexpr size_t OFF_HB = OFF_BAR + 256;
constexpr size_t OFF_PBI = OFF_HB + (size_t)MT * 1024 * 2;
constexpr size_t OFF_BIG = OFF_PBI + 2 * (size_t)MT * 256 * 2;
constexpr size_t BIG_ACTB = 0;
constexpr size_t BIG_PB = 0;
constexpr size_t BIG_HBALT = (size_t)MT * 2816 * 2;
constexpr size_t BIG_A2 = 0;
constexpr size_t BIG_Y0 = 0;
constexpr size_t BIG_Y1 = (size_t)MR * 1024 * 2;
constexpr size_t BIG_RKV = (size_t)MR * 2048 * 2;
constexpr size_t SZ_RKV1 = (size_t)MR * 1024 * 2;
constexpr size_t BIG_T = BIG_RKV + 3 * SZ_RKV1;
constexpr size_t SZ_T1 = (size_t)MR * 128 * 2;
constexpr size_t BIG_Q = 0;
constexpr size_t BIG_K = (size_t)MT * 1024 * 2;
constexpr size_t BIG_VT = 2 * (size_t)MT * 1024 * 2;

struct Params {
  const float* in[33];
  float* h;
  char* ws;
};

__device__ __forceinline__ u16 f2bf(float f) {
  unsigned u = __float_as_uint(f);
  u += 0x7fffu + ((u >> 16) & 1u);
  return (u16)(u >> 16);
}
__device__ __forceinline__ float bf2f(u16 h) { return __uint_as_float(((unsigned)h) << 16); }
__device__ __forceinline__ unsigned pack2(float a, float b) { return (unsigned)f2bf(a) | ((unsigned)f2bf(b) << 16); }
__device__ __forceinline__ float sigm(float x) { return __builtin_amdgcn_rcpf(1.f + __expf(-x)); }
template <int CTRL> __device__ __forceinline__ float dppf(float v) {
  return __int_as_float(__builtin_amdgcn_update_dpp(0, __float_as_int(v), CTRL, 0xf, 0xf, true));
}
__device__ __forceinline__ float rowsum16(float v) {
  v += dppf<0xB1>(v);
  v += dppf<0x4E>(v);
  v += dppf<0x141>(v);
  v += dppf<0x140>(v);
  return v;
}
__device__ __forceinline__ int otid() { int t = __builtin_amdgcn_workitem_id_x(); asm volatile("" : "+v"(t)); return t; }
__device__ __forceinline__ float rstd_of(float ss) { return rsqrtf(ss * (1.f / 1024.f) + 1e-6f); }

struct PrepJob {
  const float* src; int K, N, ldsrc;
  u16* dst; int dld, koff, noff;
  const float* sc; int mode;
  int perm;
};

__device__ __forceinline__ void prep_tiles(const PrepJob& j, char* shm, int nblk, int bid) {
  u16* tl = (u16*)shm;
  int kt = j.K >> 6, nt = j.N >> 6, tiles = kt * nt;
  int tid = otid();
  for (int t = bid; t < tiles; t += nblk) {
    int k0 = (t / nt) << 6, n0 = (t % nt) << 6;
#pragma unroll
    for (int it = 0; it < 2; ++it) {
      int kk = (tid >> 4) + 32 * it, nn4 = (tid & 15) * 4;
      float4 v = *(const float4*)(j.src + (size_t)(k0 + kk) * j.ldsrc + n0 + nn4);
      float s = 1.f;
      if (j.mode == 1 || j.mode == 3) s = j.sc[k0 + kk];
      else if (j.mode == 2) s = 1.f - j.sc[k0 + kk];
      tl[(nn4 + 0) * 72 + kk] = f2bf(v.x * s);
      tl[(nn4 + 1) * 72 + kk] = f2bf(v.y * s);
      tl[(nn4 + 2) * 72 + kk] = f2bf(v.z * s);
      tl[(nn4 + 3) * 72 + kk] = f2bf(v.w * s);
    }
    __syncthreads();
    {
      int nn = tid >> 3, kk8 = (tid & 7) * 8;
      int c = n0 + nn, drow;
      if (j.perm) { int half = c / DFF, cp = c % DFF; drow = (cp >> 5) * 64 + half * 32 + (cp & 31); }
      else drow = c;
      i32x4 v = *(const i32x4*)(tl + nn * 72 + kk8);
      *(i32x4*)(j.dst + (size_t)(j.noff + drow) * j.dld + j.koff + k0 + kk8) = v;
    }
    __syncthreads();
  }
}

__device__ __forceinline__ bool prep_is_early(int jj) { return jj == 0 || jj == 4 || (jj >= 12 && jj < 32); }
__device__ __forceinline__ void prep_weights(const Params& p, char* shm, bool early, int nblk, int bid) {
  char* ws = p.ws;
  for (int jj = 0; jj < 36; ++jj) {
    if (prep_is_early(jj) != early) continue;
    PrepJob j; j.mode = 0; j.sc = nullptr; j.perm = 0; j.koff = 0; j.noff = 0;
    if (jj < 4) {
      j.src = p.in[5] + (size_t)jj * 1024 * 5632; j.K = 1024; j.N = 5632; j.ldsrc = 5632;
      j.dst = (u16*)(ws + OFF_WIN + jj * SZ_WIN); j.dld = 1024; j.sc = p.in[4] + jj * 1024; j.mode = 1; j.perm = 1;
    } else if (jj < 8) {
      int q = jj - 4;
      j.src = p.in[6] + (size_t)q * 2816 * 1024; j.K = 2816; j.N = 1024; j.ldsrc = 1024;
      j.dst = (u16*)(ws + OFF_WOUT + q * SZ_WOUT); j.dld = 2816;
    } else if (jj < 10) {
      int q = jj - 8;
      j.src = p.in[9] + (size_t)q * 1024 * 1024; j.K = 1024; j.N = 1024; j.ldsrc = 1024;
      j.dst = (u16*)(ws + OFF_WPG) + (size_t)q * 1024 * 1024; j.dld = 1024; j.sc = p.in[8] + q * 1024; j.mode = 1;
    } else if (jj < 12) {
      int q = jj - 10;
      j.src = p.in[10] + (size_t)q * 256 * 1024; j.K = 256; j.N = 1024; j.ldsrc = 1024;
      j.dst = (u16*)(ws + OFF_WPP) + (size_t)q * 1024 * 256; j.dld = 256;
    } else if (jj < 28) {
      int q = (jj - 12) >> 1, hf = (jj - 12) & 1;
      j.K = 1024; j.dst = (u16*)(ws + OFF_WRKV); j.dld = 2048; j.koff = hf * 1024; j.mode = hf ? 3 : 2;
      if (q < 3) { j.src = p.in[13] + (size_t)q * 1024 * 1024; j.N = 1024; j.ldsrc = 1024; j.noff = q * 1024; j.sc = p.in[12] + q * 1024; }
      else if (q < 5) { int z = q - 3; j.src = p.in[15] + (size_t)z * 1024 * 64; j.N = 64; j.ldsrc = 64; j.noff = 3072 + z * 64; j.sc = p.in[12] + 3 * 1024; }
      else if (q < 7) { int z = q - 5; j.src = p.in[18] + (size_t)z * 1024 * 64; j.N = 64; j.ldsrc = 64; j.noff = 3200 + z * 64; j.sc = p.in[12] + 4 * 1024; }
      else { j.src = p.in[20]; j.N = 128; j.ldsrc = 128; j.noff = 3328; j.sc = p.in[12] + 5 * 1024; }
    } else if (jj < 30) {
      int z = jj - 28;
      j.src = p.in[16] + (size_t)z * 64 * 1024; j.K = 64; j.N = 1024; j.ldsrc = 1024;
      j.dst = (u16*)(ws + OFF_W2W) + (size_t)z * 1024 * 64; j.dld = 64;
    } else if (jj < 32) {
      int z = jj - 30;
      j.src = p.in[19] + (size_t)z * 64 * 1024; j.K = 64; j.N = 1024; j.ldsrc = 1024;
      j.dst = (u16*)(ws + OFF_W2A) + (size_t)z * 1024 * 64; j.dld = 64;
    } else if (jj == 32) {
      j.src = p.in[21]; j.K = 128; j.N = 1024; j.ldsrc = 1024; j.dst = (u16*)(ws + OFF_WG2); j.dld = 128;
    } else if (jj == 33) {
      j.src = p.in[27]; j.K = 1024; j.N = 1024; j.ldsrc = 1024; j.dst = (u16*)(ws + OFF_WRWO); j.dld = 1024;
    } else if (jj == 34) {
      j.src = p.in[28]; j.K = 1024; j.N = 3072; j.ldsrc = 3072; j.dst = (u16*)(ws + OFF_WQKV); j.dld = 1024; j.sc = p.in[7] + 1024; j.mode = 1;
    } else if (jj == 35) {
      j.src = p.in[31]; j.K = 1024; j.N = 1024; j.ldsrc = 1024; j.dst = (u16*)(ws + OFF_WNAO); j.dld = 1024;
    } else continue;
    prep_tiles(j, shm, nblk, bid);
  }
}

__device__ __forceinline__ void phase_prep(const Params& p, char* shm) {
  char* ws = p.ws;
  prep_weights(p, shm, true, gridDim.x, blockIdx.x);
  float* ss = (float*)(ws + OFF_SS);
  u16* hb = (u16*)(ws + OFF_HB);
  int tid = otid(), half = tid >> 8, t4 = (tid & 255) * 4;
  float* red = (float*)shm;
  for (int r0 = blockIdx.x * 2; r0 < MT; r0 += gridDim.x * 2) {
    int row = r0 + half;
    const float* src = row < MPROMPT ? p.in[0] + (size_t)row * D : p.in[1] + (size_t)(row - MPROMPT) * D;
    float4 v = *(const float4*)(src + t4);
    *(float4*)(p.h + (size_t)row * D + t4) = v;
    uint2 pk; pk.x = pack2(v.x, v.y); pk.y = pack2(v.z, v.w);
    *(uint2*)(hb + (size_t)row * D + t4) = pk;
    float s = v.x * v.x + v.y * v.y + v.z * v.z + v.w * v.w;
#pragma unroll
    for (int o = 32; o > 0; o >>= 1) s += __shfl_xor(s, o);
    __syncthreads();
    if ((tid & 63) == 0) red[tid >> 6] = s;
    __syncthreads();
    if ((tid & 255) == 0) {
      float tot = red[half * 4] + red[half * 4 + 1] + red[half * 4 + 2] + red[half * 4 + 3];
      ss[row] = tot;
#pragma unroll
      for (int q = 1; q < 9; ++q) ss[(size_t)q * MT + row] = 0.f;
    }
  }
}

__device__ __forceinline__ void conv_p(const Params& p, int layer, int nblk, int bid) {
  u16* pbi = (u16*)(p.ws + OFF_PBI) + (size_t)layer * MT * 256;
  const float* pp = p.in[2] + (size_t)layer * MPROMPT * 256;
  const float* ps = p.in[3] + (size_t)layer * (MT - MPROMPT) * 256;
  size_t n4 = (size_t)MT * 256 / 4;
  for (size_t i = (size_t)bid * NTHR + otid(); i < n4; i += (size_t)nblk * NTHR) {
    size_t e = i * 4;
    const float* s = e < (size_t)MPROMPT * 256 ? pp + e : ps + (e - (size_t)MPROMPT * 256);
    float4 v = *(const float4*)s;
    uint2 pk; pk.x = pack2(v.x, v.y); pk.y = pack2(v.z, v.w);
    *(uint2*)(pbi + e) = pk;
  }
}

__device__ __forceinline__ void conv_h(const Params& p) {
  u16* hb = (u16*)(p.ws + OFF_HB);
  size_t n4 = (size_t)MT * D / 4;
  for (size_t i = (size_t)blockIdx.x * NTHR + otid(); i < n4; i += (size_t)gridDim.x * NTHR) {
    float4 v = *(const float4*)(p.h + i * 4);
    uint2 pk; pk.x = pack2(v.x, v.y); pk.y = pack2(v.z, v.w);
    *(uint2*)(hb + i * 4) = pk;
  }
}

enum { E_SWIGLU = 0, E_RESID = 1, E_PLEPROJ = 2, E_PLEGATE = 3, E_RKV = 4, E_RWFIN = 5, E_QKV = 6 };

struct GA {
  const u16* A; const u16* Bt; int K; int N;
  int mtiles, ntiles;
  int rowoff;
  const float* ss_in; float* ss_out;
  const float* bias; float scale;
  float* h; u16* hb;
  u16* o0; u16* o1; u16* o2;
  const float* f0; const float* f1; const float* f2;
};

template <int KS> __device__ __forceinline__ int lds_byte(int r, int c) {
  int st = (r >> 4) * KS + (c >> 5), ob = (r & 15) * 64 + (c & 31) * 2;
  return st * 1024 + (ob ^ (((ob >> 9) & 1) << 5));
}
template <int KS> __device__ __forceinline__ void stage_rc(int b, int& R, int& C) {
  int st = b >> 10, sb = b & 1023, swz = sb ^ (((sb >> 9) & 1) << 5);
  R = (st / KS) * 16 + swz / 64;
  C = (st % KS) * 32 + (swz % 64) / 2;
}

template <int EPI>
__device__ __forceinline__ void gemm_tile(const GA& g, int pm, int pn, bool prefetched, bool has_next, int pm_next, int pn_next, LDSC* shm) {
  constexpr int BK = 64, KS = 2, TILE_B = 256 * BK * 2, GL = 4, STAGE_B = 2 * TILE_B;
  const int K = g.K;
  const int tid = otid(), wid = tid >> 6, lane = tid & 63, wr = wid >> 2, wc = wid & 3, fr = lane & 15, fq = lane >> 4;
  const int brow = pm * 256, bcol = pn * 256;
  const u16* Ab = g.A + (size_t)brow * K;
  const u16* Bb = g.Bt + (size_t)bcol * K;
  const u16* Abn = g.A + (size_t)(pm_next * 256) * K;
  const u16* Bbn = g.Bt + (size_t)(pn_next * 256) * K;
  int sO[GL];
#pragma unroll
  for (int i = 0; i < GL; ++i) { int r_, c_; stage_rc<KS>(wid * 1024 + i * 8192 + lane * 16, r_, c_); sO[i] = r_ * K + c_; }
  f32x4 acc[8][4];
#pragma unroll
  for (int m = 0; m < 8; ++m)
#pragma unroll
    for (int n = 0; n < 4; ++n) acc[m][n] = f32x4{0.f, 0.f, 0.f, 0.f};
  const int nt = K / BK;
#define G_STAGE(buf, AB_, BB_, kt) do { _Pragma("unroll") for (int i = 0; i < GL; ++i) { \
    __builtin_amdgcn_global_load_lds((const unsigned*)((AB_) + (kt) * BK + sO[i]), (LDSU*)(shm + (buf) * STAGE_B + wid * 1024 + i * 8192), 16, 0, 0); \
    __builtin_amdgcn_global_load_lds((const unsigned*)((BB_) + (kt) * BK + sO[i]), (LDSU*)(shm + (buf) * STAGE_B + TILE_B + wid * 1024 + i * 8192), 16, 0, 0); } } while (0)
#define G_STAGE_H(hh, buf, AB_, BB_, kt) do { _Pragma("unroll") for (int i = (hh) * 2; i < (hh) * 2 + 2; ++i) { \
    __builtin_amdgcn_global_load_lds((const unsigned*)((AB_) + (kt) * BK + sO[i]), (LDSU*)(shm + (buf) * STAGE_B + wid * 1024 + i * 8192), 16, 0, 0); \
    __builtin_amdgcn_global_load_lds((const unsigned*)((BB_) + (kt) * BK + sO[i]), (LDSU*)(shm + (buf) * STAGE_B + TILE_B + wid * 1024 + i * 8192), 16, 0, 0); } } while (0)
  if (!prefetched) G_STAGE(0, Ab, Bb, 0);
  asm volatile("s_waitcnt vmcnt(0)" ::: "memory");
  __syncthreads();
  for (int t = 0; t < nt; ++t) {
    int cur = t & 1;
    if (t + 1 < nt) G_STAGE_H(0, cur ^ 1, Ab, Bb, t + 1);
    else if (has_next) G_STAGE_H(0, 0, Abn, Bbn, 0);
    const LDSC* SAp = shm + cur * STAGE_B;
    const LDSC* SBp = SAp + TILE_B;
#pragma unroll
    for (int ks = 0; ks < KS; ++ks) {
      if (ks == 1) {
        if (t + 1 < nt) G_STAGE_H(1, cur ^ 1, Ab, Bb, t + 1);
        else if (has_next) G_STAGE_H(1, 0, Abn, Bbn, 0);
      }
      bf16x8 At[8], Bf[4];
#pragma unroll
      for (int m = 0; m < 8; ++m) At[m] = *(const LDS_BF8*)(SAp + lds_byte<KS>(wr * 128 + m * 16 + fr, ks * 32 + fq * 8));
#pragma unroll
      for (int n = 0; n < 4; ++n) Bf[n] = *(const LDS_BF8*)(SBp + lds_byte<KS>(wc * 64 + n * 16 + fr, ks * 32 + fq * 8));
      __builtin_amdgcn_s_setprio(1);
#pragma unroll
      for (int m = 0; m < 8; ++m)
#pragma unroll
        for (int n = 0; n < 4; ++n) acc[m][n] = __builtin_amdgcn_mfma_f32_16x16x32_bf16(At[m], Bf[n], acc[m][n], 0, 0, 0);
      __builtin_amdgcn_s_setprio(0);
      __builtin_amdgcn_sched_barrier(0);
    }
    if (t + 1 < nt) asm volatile("s_waitcnt vmcnt(0)" ::: "memory");
    __syncthreads();
  }
#undef G_STAGE
#undef G_STAGE_H
  typedef __attribute__((address_space(3))) float LDSF;
  typedef __attribute__((address_space(3))) f32x4 LDSF4;
  LDSF* scr = (LDSF*)(shm + STAGE_B + wid * 4352);
  const int cb = bcol + wc * 64;
#define SLAB_WRITE(m) do { _Pragma("unroll") for (int n = 0; n < 4; ++n) _Pragma("unroll") for (int j = 0; j < 4; ++j) \
    scr[(fq * 4 + j) * 68 + n * 16 + fr] = acc[m][n][j]; asm volatile("s_waitcnt lgkmcnt(0)" ::: "memory"); } while (0)
#define SLAB_DONE() asm volatile("s_waitcnt lgkmcnt(0)" ::: "memory")
  if constexpr (EPI == E_SWIGLU) {
    const int l8 = lane & 7, r8 = lane >> 3;
    float ssv[8][2];
#pragma unroll
    for (int m = 0; m < 8; ++m)
#pragma unroll
      for (int k = 0; k < 2; ++k) ssv[m][k] = g.ss_in[g.rowoff + brow + wr * 128 + m * 16 + k * 8 + r8];
#pragma unroll
    for (int m = 0; m < 8; ++m) {
      SLAB_WRITE(m);
#pragma unroll
      for (int k = 0; k < 2; ++k) {
        int rl = k * 8 + r8, row = brow + wr * 128 + m * 16 + rl;
        f32x4 gt = *(const LDSF4*)(scr + rl * 68 + l8 * 4), up = *(const LDSF4*)(scr + rl * 68 + 32 + l8 * 4);
        float rs = rstd_of(ssv[m][k]);
        float o[4];
#pragma unroll
        for (int e = 0; e < 4; ++e) { float a = gt[e] * rs; o[e] = a * sigm(a) * (up[e] * rs); }
        uint2 pk; pk.x = pack2(o[0], o[1]); pk.y = pack2(o[2], o[3]);
        *(uint2*)(g.o0 + (size_t)row * DFF + (cb >> 1) + l8 * 4) = pk;
      }
      SLAB_DONE();
    }
  } else if constexpr (EPI == E_QKV) {
    const int which = cb >> 10, c0 = cb & 1023;
    if (which == 2) {
#pragma unroll
      for (int m = 0; m < 8; ++m) {
        int row0 = brow + wr * 128 + m * 16 + fq * 4;
        float rs[4];
#pragma unroll
        for (int j = 0; j < 4; ++j) rs[j] = rstd_of(g.ss_in[row0 + j]);
#pragma unroll
        for (int n = 0; n < 4; ++n) {
          int col = c0 + n * 16 + fr;
          float b = g.bias[cb + n * 16 + fr];
          uint2 pk; pk.x = pack2(acc[m][n][0] * rs[0] + b, acc[m][n][1] * rs[1] + b); pk.y = pack2(acc[m][n][2] * rs[2] + b, acc[m][n][3] * rs[3] + b);
          *(uint2*)(g.o2 + (size_t)col * MT + row0) = pk;
        }
      }
    } else {
      u16* dst = which == 0 ? g.o0 : g.o1;
      const float sc = which == 0 ? 0.17677669529663687f : 1.f;
      f32x4 b4 = *(const f32x4*)(g.bias + cb + fr * 4);
      float ssq[8][4];
#pragma unroll
      for (int m = 0; m < 8; ++m)
#pragma unroll
        for (int k = 0; k < 4; ++k) ssq[m][k] = g.ss_in[brow + wr * 128 + m * 16 + k * 4 + fq];
#pragma unroll
      for (int m = 0; m < 8; ++m) {
        SLAB_WRITE(m);
#pragma unroll
        for (int k = 0; k < 4; ++k) {
          int rl = k * 4 + fq, row = brow + wr * 128 + m * 16 + rl;
          f32x4 v = *(const LDSF4*)(scr + rl * 68 + fr * 4);
          float rs = rstd_of(ssq[m][k]);
          uint2 pk; pk.x = pack2((v[0] * rs + b4[0]) * sc, (v[1] * rs + b4[1]) * sc); pk.y = pack2((v[2] * rs + b4[2]) * sc, (v[3] * rs + b4[3]) * sc);
          *(uint2*)(dst + (size_t)row * D + c0 + fr * 4) = pk;
        }
        SLAB_DONE();
      }
    }
  } else {
    float lw[4] = {0.f, 0.f, 0.f, 0.f}, lb[4] = {0.f, 0.f, 0.f, 0.f}, bs[4] = {0.f, 0.f, 0.f, 0.f};
    if constexpr (EPI == E_RWFIN) {
#pragma unroll
      for (int e = 0; e < 4; ++e) { lw[e] = g.f1[cb + fr * 4 + e]; lb[e] = g.f2[cb + fr * 4 + e]; }
    }
    if constexpr (EPI == E_RESID) {
      if (g.bias) {
#pragma unroll
        for (int e = 0; e < 4; ++e) bs[e] = g.bias[cb + fr * 4 + e];
      }
    }
    f32x4 h_n[4]; uint2 a_n[4]; float f_n[4][2];
#define EPI_LOAD(m_) do { _Pragma("unroll") for (int k = 0; k < 4; ++k) { \
      const int row_ = brow + wr * 128 + (m_) * 16 + k * 4 + fq, col_ = cb + fr * 4; \
      if constexpr (EPI == E_RESID || EPI == E_PLEGATE) h_n[k] = *(const f32x4*)(g.h + (size_t)(g.rowoff + row_) * D + col_); \
      if constexpr (EPI == E_PLEGATE) { a_n[k] = *(const uint2*)(g.o0 + (size_t)(g.rowoff + row_) * D + col_); f_n[k][0] = g.ss_in[g.rowoff + row_]; } \
      } } while (0)
    f32x4 h_m[4]; uint2 a_m[4]; float f_m[4][2];
    EPI_LOAD(0);
#pragma unroll
    for (int k = 0; k < 4; ++k) { h_m[k] = h_n[k]; a_m[k] = a_n[k]; f_m[k][0] = f_n[k][0]; }
    EPI_LOAD(1);
#pragma unroll
    for (int m = 0; m < 8; ++m) {
      f32x4 h_c[4]; uint2 a_c[4]; float f_c[4][2];
#pragma unroll
      for (int k = 0; k < 4; ++k) { h_c[k] = h_m[k]; a_c[k] = a_m[k]; f_c[k][0] = f_m[k][0];
                                    h_m[k] = h_n[k]; a_m[k] = a_n[k]; f_m[k][0] = f_n[k][0]; }
      if (m + 2 < 8) EPI_LOAD(m + 2);
      SLAB_WRITE(m);
#pragma unroll
      for (int k = 0; k < 4; ++k) {
        const int rl = k * 4 + fq, row = brow + wr * 128 + m * 16 + rl;
        const int col = cb + fr * 4;
        f32x4 v = *(const LDSF4*)(scr + rl * 68 + fr * 4);
        if constexpr (EPI == E_RESID || EPI == E_PLEGATE) {
          size_t grow = (size_t)(g.rowoff + row);
          float* hp = g.h + grow * D + col;
          f32x4 hv = h_c[k];
          if constexpr (EPI == E_PLEGATE) {
            float rs = rstd_of(f_c[k][0]);
            uint2 pb = a_c[k];
            hv[0] += sigm(v[0] * rs) * bf2f((u16)(pb.x & 0xffff));
            hv[1] += sigm(v[1] * rs) * bf2f((u16)(pb.x >> 16));
            hv[2] += sigm(v[2] * rs) * bf2f((u16)(pb.y & 0xffff));
            hv[3] += sigm(v[3] * rs) * bf2f((u16)(pb.y >> 16));
          } else {
#pragma unroll
            for (int e = 0; e < 4; ++e) hv[e] += g.scale * v[e] + bs[e];
          }
          *(f32x4*)hp = hv;
          if (g.hb != nullptr) {
            uint2 pk; pk.x = pack2(hv[0], hv[1]); pk.y = pack2(hv[2], hv[3]);
            *(uint2*)(g.hb + grow * D + col) = pk;
          }
          float sq = rowsum16(hv[0] * hv[0] + hv[1] * hv[1] + hv[2] * hv[2] + hv[3] * hv[3]);
          if (fr == 0) atomicAdd(g.ss_out + grow, sq);
        } else if constexpr (EPI == E_PLEPROJ) {
          uint2 pk; pk.x = pack2(v[0], v[1]); pk.y = pack2(v[2], v[3]);
          *(uint2*)(g.o0 + (size_t)row * D + col) = pk;
        } else if constexpr (EPI == E_RKV) {
          if (cb < 3072) {
            u16* buf = g.o0 + (size_t)(cb >> 10) * ((size_t)MR * 1024);
            uint2 pk; pk.x = pack2(v[0], v[1]); pk.y = pack2(v[2], v[3]);
            *(uint2*)(buf + (size_t)row * D + (cb & 1023) + fr * 4) = pk;
          } else if (cb < 3456) {
            int which = (cb - 3072) >> 7, c0 = (cb - 3072) & 127;
            u16* buf = g.o1 + (size_t)which * ((size_t)MR * 128);
            if (which == 0) { v[0] = tanhf(v[0]); v[1] = tanhf(v[1]); v[2] = tanhf(v[2]); v[3] = tanhf(v[3]); }
            else if (which == 2) { v[0] = sigm(v[0]); v[1] = sigm(v[1]); v[2] = sigm(v[2]); v[3] = sigm(v[3]); }
            uint2 pk; pk.x = pack2(v[0], v[1]); pk.y = pack2(v[2], v[3]);
            *(uint2*)(buf + (size_t)row * 128 + c0 + fr * 4) = pk;
          }
        } else if constexpr (EPI == E_RWFIN) {
          const int head = cb >> 6;
          size_t idx = (size_t)row * D + col;
          uint2 a0 = *(const uint2*)(g.o0 + idx), a1 = *(const uint2*)(g.o1 + idx), vv = *(const uint2*)(g.o2 + idx);
          float y[4];
          y[0] = bf2f((u16)(a0.x & 0xffff)) + bf2f((u16)(a1.x & 0xffff));
          y[1] = bf2f((u16)(a0.x >> 16)) + bf2f((u16)(a1.x >> 16));
          y[2] = bf2f((u16)(a0.y & 0xffff)) + bf2f((u16)(a1.y & 0xffff));
          y[3] = bf2f((u16)(a0.y >> 16)) + bf2f((u16)(a1.y >> 16));
          float mean = rowsum16(y[0] + y[1] + y[2] + y[3]) * (1.f / 64.f);
#pragma unroll
          for (int e = 0; e < 4; ++e) y[e] -= mean;
          float inv = rsqrtf(rowsum16(y[0] * y[0] + y[1] * y[1] + y[2] * y[2] + y[3] * y[3]) * (1.f / 64.f) + 64e-5f);
          float bon = g.f0[(size_t)row * 16 + head] + g.f0[(size_t)MR * 16 + (size_t)row * 16 + head];
          float vf[4] = {bf2f((u16)(vv.x & 0xffff)), bf2f((u16)(vv.x >> 16)), bf2f((u16)(vv.y & 0xffff)), bf2f((u16)(vv.y >> 16))};
          float o[4];
#pragma unroll
          for (int e = 0; e < 4; ++e) o[e] = (y[e] * inv * lw[e] + lb[e] + bon * vf[e]) * v[e];
          uint2 pk; pk.x = pack2(o[0], o[1]); pk.y = pack2(o[2], o[3]);
          *(uint2*)(g.hb + idx) = pk;
        }
      }
      SLAB_DONE();
    }
  }
#undef SLAB_WRITE
#undef EPI_LOAD
#undef SLAB_DONE
}

template <int EPI> __device__ __forceinline__ void gemm_phase(const GA& g, const GA& g2, LDSC* shm) {
  const int nM = g.mtiles, nN = g.ntiles;
  const int G = gridDim.x;
  const int PN = (nN & 3) == 0 ? 4 : 2, PM = 32 / PN;
  const int sN = nN / PN, sM = nM / PM, nsup = sN * sM;
  const int per = G >> 8;
  const int b = blockIdx.x, x = b & 7, l = (b >> 3) & 31, rep = b >> 8;
  bool pref = false;
  for (int s = x + 8 * rep; s < nsup; s += 8 * per) {
    int sm = s / sN, sn = s % sN;
    int pm = sm * PM + (l % PM), pn = sn * PN + (l / PM);
    int s2 = s + 8 * per;
    bool hn = s2 < nsup;
    int pm2 = (s2 / sN) * PM + (l % PM), pn2 = (s2 % sN) * PN + (l / PM);
    if constexpr (EPI == E_PLEGATE) {
      gemm_tile<E_PLEPROJ>(g2, pm, pn, false, false, pm, pn, shm);
      gemm_tile<E_PLEGATE>(g, pm, pn, false, false, pm, pn, shm);
    } else {
      gemm_tile<EPI>(g, pm, pn, pref, hn, hn ? pm2 : pm, hn ? pn2 : pn, shm);
      pref = hn;
    }
  }
  __syncthreads();
}

__device__ __forceinline__ void phase_mix(const Params& p, int tok0, int ntok) {
  const float* ss1 = (const float*)(p.ws + OFF_SS) + (size_t)1 * MT;
  const float* gain = p.in[7];
  u16* A2 = (u16*)(p.ws + OFF_BIG + BIG_A2);
  int tid = otid(), half = tid >> 8, c4 = (tid & 255) * 4;
  float4 gn = *(const float4*)(gain + c4);
  for (int l0 = blockIdx.x * 2; l0 < ntok; l0 += gridDim.x * 2) {
    int l = l0 + half, tok = tok0 + l;
    int pos, T;
    if (tok < MPROMPT) { pos = tok & 2047; T = 2048; } else { pos = tok - MPROMPT; T = 16384; }
    float4 c = *(const float4*)(p.h + (size_t)tok * D + c4);
    float rc = rstd_of(ss1[tok]);
    float4 hn = {c.x * rc * gn.x, c.y * rc * gn.y, c.z * rc * gn.z, c.w * rc * gn.w};
    float4 av = {0.f, 0.f, 0.f, 0.f};
    if (pos > 0) {
      float4 q = *(const float4*)(p.h + (size_t)(tok - 1) * D + c4);
      float r = rstd_of(ss1[tok - 1]);
      av.x += q.x * r * gn.x; av.y += q.y * r * gn.y; av.z += q.z * r * gn.z; av.w += q.w * r * gn.w;
    }
    if (pos < T - 1) {
      float4 q = *(const float4*)(p.h + (size_t)(tok + 1) * D + c4);
      float r = rstd_of(ss1[tok + 1]);
      av.x += q.x * r * gn.x; av.y += q.y * r * gn.y; av.z += q.z * r * gn.z; av.w += q.w * r * gn.w;
    }
    uint2 a, b;
    a.x = pack2(hn.x, hn.y); a.y = pack2(hn.z, hn.w);
    b.x = pack2(0.5f * av.x, 0.5f * av.y); b.y = pack2(0.5f * av.z, 0.5f * av.w);
    *(uint2*)(A2 + (size_t)l * 2048 + c4) = a;
    *(uint2*)(A2 + (size_t)l * 2048 + 1024 + c4) = b;
  }
}

constexpr int SC_T = 32;
constexpr int SC_ARR = SC_T * 64 * 4;
constexpr int SC_BUF = 6 * SC_ARR;
template <int E> __device__ __forceinline__ float rowsumL(float v) {
  v += dppf<0xB1>(v); v += dppf<0x4E>(v); v += dppf<0x141>(v);
  if (E == 4) v += dppf<0x140>(v);
  return v;
}

template <int E, int R = 1>
__device__ __forceinline__ void scan_item(const Params& p, int seq_loc0, int T, int head, int z, int rowbase, int nw, char* shm) {
  char* big = p.ws + OFF_BIG;
  const u16* Rb = (const u16*)(big + BIG_RKV);
  const u16* Kb = (const u16*)(big + BIG_RKV + SZ_RKV1);
  const u16* Vb = (const u16*)(big + BIG_RKV + 2 * SZ_RKV1);
  const u16* TW = (const u16*)(big + BIG_T);
  const u16* TA = (const u16*)(big + BIG_T + SZ_T1);
  u16* Y = (u16*)(big + (z ? BIG_Y1 : BIG_Y0));
  float* bonus = (float*)(p.ws + OFF_BONUS) + (size_t)z * MR * 16;
  const u16* W2 = (const u16*)(p.ws + OFF_W2W) + (size_t)z * 1024 * 64;
  const u16* A2w = (const u16*)(p.ws + OFF_W2A) + (size_t)z * 1024 * 64;
  const float* w0 = p.in[14] + z * 1024 + head * 64;
  const float* a0 = p.in[17] + z * 1024 + head * 64;
  const int tid = otid(), wv = tid >> 6, lane = tid & 63, fr = lane & 15, fq = lane >> 4;
  float* Ybuf = (float*)(shm + 2 * SC_BUF);
  const int si = tid >> 4, ec4 = (tid & 15) * 4;
  float4 ckk = *(const float4*)(p.in[22] + head * 64 + ec4);
  float4 cka = *(const float4*)(p.in[23] + head * 64 + ec4);
  float4 crk = *(const float4*)(p.in[24] + head * 64 + ec4);
  const int mt = wv >> 2, ntl = wv & 3;
  bf16x8 Bw[2], Ba[2];
#pragma unroll
  for (int ks = 0; ks < 2; ++ks) {
    Bw[ks] = *(const bf16x8*)(W2 + (size_t)(head * 64 + ntl * 16 + fr) * 64 + ks * 32 + fq * 8);
    Ba[ks] = *(const bf16x8*)(A2w + (size_t)(head * 64 + ntl * 16 + fr) * 64 + ks * 32 + fq * 8);
  }
  const float w0c = w0[ntl * 16 + fr], a0c = a0[ntl * 16 + fr];
  constexpr int LPR = 64 / E, RPW = R * (64 / LPR), NP = E / 2, NQ = E / 4;
  const int le = lane % LPR, row0 = rowbase + wv * RPW + (lane / LPR) * R;
  f32x2 st[R][NP];
#pragma unroll
  for (int r = 0; r < R; ++r)
#pragma unroll
    for (int q = 0; q < NP; ++q) st[r][q] = f32x2{0.f, 0.f};
  float skc = 0.f, sklast = 0.f;
  f32x2 ulast0 = {0.f, 0.f}, ulast1 = {0.f, 0.f};
  f32x4 kalast = {0.f, 0.f, 0.f, 0.f};
  const int nch = T / SC_T;
  uint2 pr, pk, pv; bf16x8 Aw[2], Aa[2];
  auto tok_of = [&](int t) { return seq_loc0 + (z ? (T - 1 - t) : t); };
#define SC_LOAD(c) do { \
    int tk_ = tok_of((c) * SC_T + si); \
    pr = *(const uint2*)(Rb + (size_t)tk_ * D + head * 64 + ec4); \
    pk = *(const uint2*)(Kb + (size_t)tk_ * D + head * 64 + ec4); \
    pv = *(const uint2*)(Vb + (size_t)tk_ * D + head * 64 + ec4); \
    int tm_ = tok_of((c) * SC_T + mt * 16 + fr); \
    _Pragma("unroll") for (int ks = 0; ks < 2; ++ks) { \
      Aw[ks] = *(const bf16x8*)(TW + (size_t)tm_ * 128 + z * 64 + ks * 32 + fq * 8); \
      Aa[ks] = *(const bf16x8*)(TA + (size_t)tm_ * 128 + z * 64 + ks * 32 + fq * 8); } } while (0)
#define SC_LORA(b) do { \
    f32x4 cw = {0.f, 0.f, 0.f, 0.f}, ca = {0.f, 0.f, 0.f, 0.f}; \
    _Pragma("unroll") for (int ks = 0; ks < 2; ++ks) { \
      cw = __builtin_amdgcn_mfma_f32_16x16x32_bf16(Aw[ks], Bw[ks], cw, 0, 0, 0); \
      ca = __builtin_amdgcn_mfma_f32_16x16x32_bf16(Aa[ks], Ba[ks], ca, 0, 0, 0); } \
    float* Wl_ = (float*)(shm + (b) * SC_BUF); float* Al_ = (float*)(shm + (b) * SC_BUF + 3 * SC_ARR); \
    _Pragma("unroll") for (int j = 0; j < 4; ++j) { \
      int st_ = mt * 16 + fq * 4 + j; \
      Wl_[st_ * 64 + ntl * 16 + fr] = __expf(-0.6065306597126334f * sigm(w0c + cw[j])); \
      Al_[st_ * 64 + ntl * 16 + fr] = sigm(a0c + ca[j]); } } while (0)
#define SC_ELEM(b, c) do { \
    char* bb_ = shm + (b) * SC_BUF; \
    float4 a4 = *(const float4*)(bb_ + 3 * SC_ARR + (si * 64 + ec4) * 4); \
    float r0 = bf2f((u16)(pr.x & 0xffff)), r1 = bf2f((u16)(pr.x >> 16)), r2 = bf2f((u16)(pr.y & 0xffff)), r3 = bf2f((u16)(pr.y >> 16)); \
    float k0 = bf2f((u16)(pk.x & 0xffff)), k1 = bf2f((u16)(pk.x >> 16)), k2 = bf2f((u16)(pk.y & 0xffff)), k3 = bf2f((u16)(pk.y >> 16)); \
    float v0 = bf2f((u16)(pv.x & 0xffff)), v1 = bf2f((u16)(pv.x >> 16)), v2 = bf2f((u16)(pv.y & 0xffff)), v3 = bf2f((u16)(pv.y >> 16)); \
    float q0 = k0 * ckk.x, q1 = k1 * ckk.y, q2 = k2 * ckk.z, q3 = k3 * ckk.w; \
    float n2 = rowsum16(q0 * q0 + q1 * q1 + q2 * q2 + q3 * q3); \
    float inv_ = rsqrtf(fmaxf(n2, 1e-24f)); \
    q0 *= inv_; q1 *= inv_; q2 *= inv_; q3 *= inv_; \
    float d0 = k0 * (1.f + (a4.x - 1.f) * cka.x), d1 = k1 * (1.f + (a4.y - 1.f) * cka.y), d2 = k2 * (1.f + (a4.z - 1.f) * cka.z), d3 = k3 * (1.f + (a4.w - 1.f) * cka.w); \
    float bn = rowsum16(r0 * d0 * crk.x + r1 * d1 * crk.y + r2 * d2 * crk.z + r3 * d3 * crk.w); \
    if (rowbase == 0 && (tid & 15) == 0) bonus[(size_t)tok_of((c) * SC_T + si) * 16 + head] = bn; \
    *(float4*)(bb_ + 1 * SC_ARR + (si * 64 + ec4) * 4) = float4{q0, q1, q2, q3}; \
    *(float4*)(bb_ + 2 * SC_ARR + (si * 64 + ec4) * 4) = float4{d0, d1, d2, d3}; \
    *(float4*)(bb_ + 3 * SC_ARR + (si * 64 + ec4) * 4) = float4{q0 * a4.x, q1 * a4.y, q2 * a4.z, q3 * a4.w}; \
    *(float4*)(bb_ + 4 * SC_ARR + (si * 64 + ec4) * 4) = float4{r0, r1, r2, r3}; \
    *(float4*)(bb_ + 5 * SC_ARR + (si * 64 + ec4) * 4) = float4{v0, v1, v2, v3}; } while (0)

  __syncthreads();
  SC_LOAD(0);
  SC_LORA(0);
  __syncthreads();
  SC_ELEM(0, 0);
  __syncthreads();
  for (int c = 0; c < nch; ++c) {
    const int b = c & 1;
    if (c + 1 < nch) SC_LOAD(c + 1);
    const char* bb = shm + b * SC_BUF;
    if (wv < nw) {
      f32x4 cw[NQ], ckq[NQ], ckd[NQ], cka4[NQ], cr[NQ]; float vv[R];
#define SC_LD(i_, W_, KK_, KD_, KA_, R_, V_) do { _Pragma("unroll") for (int q = 0; q < NQ; ++q) { \
        W_[q] = *(const f32x4*)(bb + 0 * SC_ARR + ((i_) * 64 + le * E + q * 4) * 4); \
        KK_[q] = *(const f32x4*)(bb + 1 * SC_ARR + ((i_) * 64 + le * E + q * 4) * 4); \
        KD_[q] = *(const f32x4*)(bb + 2 * SC_ARR + ((i_) * 64 + le * E + q * 4) * 4); \
        KA_[q] = *(const f32x4*)(bb + 3 * SC_ARR + ((i_) * 64 + le * E + q * 4) * 4); \
        R_[q] = *(const f32x4*)(bb + 4 * SC_ARR + ((i_) * 64 + le * E + q * 4) * 4); } \
        _Pragma("unroll") for (int r = 0; r < R; ++r) V_[r] = *(const float*)(bb + 5 * SC_ARR + ((i_) * 64 + row0 + r) * 4); } while (0)
      SC_LD(0, cw, ckq, ckd, cka4, cr, vv);
      f32x4 mw_[NQ], mkq[NQ], mkd[NQ], mka[NQ], mr[NQ]; float mvv[R];
      if constexpr (E == 4) {
        SC_LD(1, mw_, mkq, mkd, mka, mr, mvv);
        f32x2 pu = ulast0 * ckq[0].lo + ulast1 * ckq[0].hi;
        f32x2 pc = kalast.lo * ckq[0].lo + kalast.hi * ckq[0].hi;
        skc = rowsumL<E>(pu.x + pu.y) - sklast * rowsumL<E>(pc.x + pc.y);
      }
#pragma unroll 8
      for (int i = 0; i < SC_T; ++i) {
        f32x4 nw_[NQ], nkq[NQ], nkd[NQ], nka[NQ], nr[NQ]; float nvv[R];
        const int in_ = (i + (E == 4 ? 2 : 1)) & (SC_T - 1);
        SC_LD(in_, nw_, nkq, nkd, nka, nr, nvv);
        float sk[R], yy[R];
        f32x2 uq[R][NP];
        if constexpr (E == 4) {
          f32x2 u0 = st[0][0] * cw[0].lo + ckd[0].lo * vv[0];
          f32x2 u1 = st[0][1] * cw[0].hi + ckd[0].hi * vv[0];
          st[0][0] = u0 - cka4[0].lo * skc;
          st[0][1] = u1 - cka4[0].hi * skc;
          f32x2 pu = u0 * mkq[0].lo + u1 * mkq[0].hi;
          f32x2 pc = cka4[0].lo * mkq[0].lo + cka4[0].hi * mkq[0].hi;
          const float rr_ = rowsumL<E>(pu.x + pu.y), cc_ = rowsumL<E>(pc.x + pc.y);
          ulast0 = u0; ulast1 = u1; kalast = cka4[0]; sklast = skc;
          skc = rr_ - skc * cc_;
          f32x2 ya = st[0][0] * cr[0].lo + st[0][1] * cr[0].hi;
          yy[0] = ya.x + ya.y;
        } else {
#pragma unroll
        for (int r = 0; r < R; ++r) {
          f32x2 da = st[r][0] * ckq[0].lo;
#pragma unroll
          for (int q = 1; q < NP; ++q) da += st[r][q] * ((q & 1) ? ckq[q >> 1].hi : ckq[q >> 1].lo);
#pragma unroll
          for (int q = 0; q < NP; ++q) {
            f32x2 kdq = (q & 1) ? ckd[q >> 1].hi : ckd[q >> 1].lo;
            f32x2 wq = (q & 1) ? cw[q >> 1].hi : cw[q >> 1].lo;
            uq[r][q] = st[r][q] * wq + kdq * vv[r];
          }
          sk[r] = da.x + da.y;
        }
#pragma unroll
        for (int r = 0; r < R; ++r) sk[r] = rowsumL<E>(sk[r]);
#pragma unroll
        for (int r = 0; r < R; ++r) {
#pragma unroll
          for (int q = 0; q < NP; ++q) {
            f32x2 kaq = (q & 1) ? cka4[q >> 1].hi : cka4[q >> 1].lo;
            st[r][q] = uq[r][q] - kaq * sk[r];
          }
          f32x2 ya = st[r][0] * cr[0].lo;
#pragma unroll
          for (int q = 1; q < NP; ++q) ya += st[r][q] * ((q & 1) ? cr[q >> 1].hi : cr[q >> 1].lo);
          yy[r] = ya.x + ya.y;
        }
        }
#pragma unroll
        for (int r = 0; r < R; ++r) yy[r] = rowsumL<E>(yy[r]);
        if (le == 0) {
#pragma unroll
          for (int r = 0; r < R; ++r) Ybuf[i * 64 + row0 + r] = yy[r];
        }
        if constexpr (E == 4) {
#pragma unroll
          for (int q = 0; q < NQ; ++q) { cw[q] = mw_[q]; ckq[q] = mkq[q]; ckd[q] = mkd[q]; cka4[q] = mka[q]; cr[q] = mr[q];
                                         mw_[q] = nw_[q]; mkq[q] = nkq[q]; mkd[q] = nkd[q]; mka[q] = nka[q]; mr[q] = nr[q]; }
#pragma unroll
          for (int r = 0; r < R; ++r) { vv[r] = mvv[r]; mvv[r] = nvv[r]; }
        } else {
#pragma unroll
          for (int q = 0; q < NQ; ++q) { cw[q] = nw_[q]; ckq[q] = nkq[q]; ckd[q] = nkd[q]; cka4[q] = nka[q]; cr[q] = nr[q]; }
#pragma unroll
          for (int r = 0; r < R; ++r) vv[r] = nvv[r];
        }
      }
#undef SC_LD
    }
    if (c + 1 < nch) SC_LORA(b ^ 1);
    __syncthreads();
    if (c + 1 < nch) SC_ELEM(b ^ 1, c + 1);
    {
      int tk = tok_of(c * SC_T + si);
      int rr = (tid & 15) * 4;
      if (rr >= rowbase && rr < rowbase + nw * RPW) {
        float4 yv = *(const float4*)(Ybuf + si * 64 + rr);
        uint2 pk2; pk2.x = pack2(yv.x, yv.y); pk2.y = pack2(yv.z, yv.w);
        *(uint2*)(Y + (size_t)tk * D + head * 64 + rr) = pk2;
      }
    }
    __syncthreads();
  }
#undef SC_LOAD
#undef SC_LORA
#undef SC_ELEM
}

__device__ __forceinline__ void phase_scan(const Params& p, char* shm) {
  const int G = gridDim.x, b = blockIdx.x;
  const int nS = 128, nP = 16 * 32;
  int j, step;
  if (G > nS) { if (b < nS) { j = b; step = 1 << 30; } else { j = nS + (b - nS); step = G - nS; } }
  else { j = b; step = G; }
  for (; j < nS + nP; j += step) {
    if (j < nS) scan_item<4>(p, MPROMPT, 16384, (j >> 3) & 15, (j >> 2) & 1, (j & 3) * 16, 4, shm);
    else { int q = j - nS; scan_item<8, 2>(p, (q >> 5) * 2048, 2048, (q >> 1) & 15, q & 1, 0, 4, shm); }
  }
  __syncthreads();
  if (G > nS) { if (b >= nS) { prep_weights(p, shm, false, G - nS, b - nS); conv_p(p, 0, G - nS, b - nS); conv_p(p, 1, G - nS, b - nS); } }
  else { prep_weights(p, shm, false, G, b); conv_p(p, 0, G, b); conv_p(p, 1, G, b); }
}

__device__ __forceinline__ void phase_natt(const Params& p, u16* Odst, char* shm) {
  char* big = p.ws + OFF_BIG;
  const u16* Q = (const u16*)(big + BIG_Q);
  const u16* Kb = (const u16*)(big + BIG_K);
  const u16* Vt = (const u16*)(big + BIG_VT);
  const int tid = otid(), wv = tid >> 6, lane = tid & 63, fr = lane & 15, fq = lane >> 4;
  const int hg = blockIdx.x & 3, h = hg * 8 + wv;
  float* tab = (float*)(shm + wv * 3840);
  {
    const float* rp = p.in[30] + (size_t)h * 15 * 31;
    for (int idx = lane; idx < 960; idx += 64) tab[idx] = 0.f;
    asm volatile("s_waitcnt lgkmcnt(0)" ::: "memory");
    for (int idx = lane; idx < 465; idx += 64) { int r = idx / 31, c = idx - r * 31; tab[r * 64 + 16 + c] = rp[idx]; }
    asm volatile("s_waitcnt lgkmcnt(0)" ::: "memory");
  }
  const int nqb = MT / 16, qstep = gridDim.x >> 2;
  for (int qb = blockIdx.x >> 2; qb < nqb; qb += qstep) {
    int tb = qb * 16;
    int seqbase, T, loc;
    if (tb < MPROMPT) { seqbase = tb & ~2047; T = 2048; loc = tb & 2047; } else { seqbase = MPROMPT; T = 16384; loc = tb - MPROMPT; }
    int rows = T >> 6, i = loc >> 6, cbq = (loc & 63) >> 4;
    int rs = min(max(i - 4, 0), rows - 8);
    int kvs = min(max(cbq * 16 - 8, 0), 32);
    int qc = cbq * 16 + fr;
    int ws_ = min(max(qc - 8, 0), 48);
    bf16x8 qf = *(const bf16x8*)(Q + (size_t)(tb + fr) * D + h * 32 + fq * 8);
    unsigned vm = 0;
#pragma unroll
    for (int e = 0; e < 8; ++e) { int kcol = kvs + fq * 8 + e; vm |= ((kcol >= ws_) && (kcol < ws_ + 16)) ? (1u << e) : 0u; }
    const float* trow = tab + (rs - i + 7) * 64 + 16 + (kvs + fq * 8 - qc + 15);
    bf16x8 kf[8][2];
#pragma unroll
    for (int r = 0; r < 8; ++r)
#pragma unroll
      for (int hb2 = 0; hb2 < 2; ++hb2) {
        int kcolA = kvs + (fr >> 2) * 8 + hb2 * 4 + (fr & 3);
        size_t ktok = (size_t)seqbase + (size_t)(rs + r) * 64 + kcolA;
        kf[r][hb2] = *(const bf16x8*)(Kb + ktok * D + h * 32 + fq * 8);
      }
    f32x4 sc[8][2];
    float mx = -1e30f;
#pragma unroll
    for (int r = 0; r < 8; ++r) {
#pragma unroll
      for (int hb2 = 0; hb2 < 2; ++hb2) {
        f32x4 a = __builtin_amdgcn_mfma_f32_16x16x32_bf16(kf[r][hb2], qf, f32x4{0.f, 0.f, 0.f, 0.f}, 0, 0, 0);
#pragma unroll
        for (int j = 0; j < 4; ++j) {
          float sv = ((vm >> (hb2 * 4 + j)) & 1u) ? a[j] + trow[r * 64 + hb2 * 4 + j] : -1e30f;
          a[j] = sv; mx = fmaxf(mx, sv);
        }
        sc[r][hb2] = a;
      }
    }
    mx = fmaxf(mx, __shfl_xor(mx, 16));
    mx = fmaxf(mx, __shfl_xor(mx, 32));
    float sum = 0.f;
    f32x4 o0 = {0.f, 0.f, 0.f, 0.f}, o1 = {0.f, 0.f, 0.f, 0.f};
#pragma unroll
    for (int r = 0; r < 8; ++r) {
      bf16x8 pf;
#pragma unroll
      for (int e = 0; e < 8; ++e) {
        float pe = __expf(sc[r][e >> 2][e & 3] - mx);
        sum += pe;
        pf[e] = (short)f2bf(pe);
      }
      size_t vbase = (size_t)seqbase + (size_t)(rs + r) * 64 + kvs + fq * 8;
      bf16x8 v0 = *(const bf16x8*)(Vt + (size_t)(h * 32 + fr) * MT + vbase);
      bf16x8 v1 = *(const bf16x8*)(Vt + (size_t)(h * 32 + 16 + fr) * MT + vbase);
      o0 = __builtin_amdgcn_mfma_f32_16x16x32_bf16(v0, pf, o0, 0, 0, 0);
      o1 = __builtin_amdgcn_mfma_f32_16x16x32_bf16(v1, pf, o1, 0, 0, 0);
    }
    sum += __shfl_xor(sum, 16);
    sum += __shfl_xor(sum, 32);
    float inv = 1.f / sum;
    uint2 w0, w1;
    w0.x = pack2(o0[0] * inv, o0[1] * inv); w0.y = pack2(o0[2] * inv, o0[3] * inv);
    w1.x = pack2(o1[0] * inv, o1[1] * inv); w1.y = pack2(o1[2] * inv, o1[3] * inv);
    *(uint2*)(Odst + (size_t)(tb + fr) * D + h * 32 + fq * 4) = w0;
    *(uint2*)(Odst + (size_t)(tb + fr) * D + h * 32 + 16 + fq * 4) = w1;
  }
}

__device__ __forceinline__ void phase_final(const Params& p) {
  const float* ss8 = (const float*)(p.ws + OFF_SS) + (size_t)8 * MT;
  const float* gain = p.in[11];
  int tid = otid(), half = tid >> 8, c4 = (tid & 255) * 4;
  float4 gn = *(const float4*)(gain + c4);
  for (int r0 = blockIdx.x * 2; r0 < MT; r0 += gridDim.x * 2) {
    int row = r0 + half;
    float rs = rstd_of(ss8[row]);
    float4 v = *(float4*)(p.h + (size_t)row * D + c4);
    v.x *= rs * gn.x; v.y *= rs * gn.y; v.z *= rs * gn.z; v.w *= rs * gn.w;
    *(float4*)(p.h + (size_t)row * D + c4) = v;
  }
}

constexpr int NPHASE = 20;
#ifndef PROBE_MASK
#define PROBE_MASK 0ull
#endif

enum { K_NONE = 0, K_PREP, K_FFN1, K_FFN2, K_MIX, K_RKV, K_SCAN, K_FIN, K_RWO, K_PPROJ, K_PGATE, K_CONVH, K_QKV, K_NATT, K_NAO, K_FINAL };

__device__ __forceinline__ void run_phase(const Params& p, int ph, LDSC* shml) {
  char* shm = (char*)shml;
  char* ws = p.ws;
  float* ss = (float*)(ws + OFF_SS);
  u16* hb = (u16*)(ws + OFF_HB);
  char* big = ws + OFF_BIG;
  int kind = K_NONE, a = 0, b = 0, c = 0, d = 0;
  switch (ph) {
    case 0: kind = K_PREP; break;
    case 1: kind = K_FFN1; a = 0; b = 0; c = 0; d = 0; break;
    case 2: kind = K_FFN2; a = 0; b = 0; c = 1; break;
    case 3: kind = K_MIX; break;
    case 4: kind = K_RKV; break;
    case 5: kind = K_SCAN; break;
    case 6: kind = K_FIN; break;
    case 7: kind = K_RWO; break;
    case 8: kind = K_FFN1; a = 0; b = 1; c = 2; d = 1; break;
    case 9: kind = K_FFN2; a = 0; b = 1; c = 3; break;
    case 10: kind = K_PGATE; a = 0; b = 3; c = 4; break;
    case 11: kind = K_FFN1; a = 1; b = 0; c = 4; d = 0; break;
    case 12: kind = K_FFN2; a = 1; b = 0; c = 5; break;
    case 13: kind = K_QKV; break;
    case 14: kind = K_NATT; break;
    case 15: kind = K_NAO; break;
    case 16: kind = K_FFN1; a = 1; b = 1; c = 6; d = 1; break;
    case 17: kind = K_FFN2; a = 1; b = 1; c = 7; break;
    case 18: kind = K_PGATE; a = 1; b = 7; c = 8; break;
    case 19: kind = K_FINAL; break;
    default: break;
  }
  GA g;
  g.A = nullptr; g.Bt = nullptr; g.K = 0; g.N = 0; g.mtiles = 0; g.ntiles = 0; g.rowoff = 0;
  g.ss_in = nullptr; g.ss_out = nullptr; g.bias = nullptr; g.scale = 1.f; g.h = p.h; g.hb = hb;
  g.o0 = nullptr; g.o1 = nullptr; g.o2 = nullptr; g.f0 = nullptr; g.f1 = nullptr; g.f2 = nullptr;
  GA g2 = g;
  int epi = -1;
  const int tok0 = 0, ntok = MT;
  switch (kind) {
    case K_PREP: phase_prep(p, shm); break;
    case K_FFN1:
      g.A = (a == 1 && b == 0) ? (const u16*)(big + BIG_HBALT) : hb;
      g.Bt = (const u16*)(ws + OFF_WIN + (size_t)(a * 2 + b) * SZ_WIN); g.K = 1024; g.N = 5632;
      g.mtiles = MT / 256; g.ntiles = 22; g.ss_in = ss + (size_t)c * MT; g.o0 = (u16*)(big + BIG_ACTB);
      epi = E_SWIGLU; break;
    case K_FFN2:
      g.A = (const u16*)(big + BIG_ACTB); g.Bt = (const u16*)(ws + OFF_WOUT + (size_t)(a * 2 + b) * SZ_WOUT); g.K = DFF; g.N = 1024;
      g.mtiles = MT / 256; g.ntiles = 4; g.ss_out = ss + (size_t)c * MT; g.scale = 0.5f;
      if (a == 0 && b == 0) g.hb = nullptr;
      epi = E_RESID; break;
    case K_MIX: phase_mix(p, tok0, ntok); break;
    case K_RKV:
      g.A = (const u16*)(big + BIG_A2); g.Bt = (const u16*)(ws + OFF_WRKV); g.K = 2048; g.N = 3456;
      g.mtiles = ntok / 256; g.ntiles = 14; g.o0 = (u16*)(big + BIG_RKV); g.o1 = (u16*)(big + BIG_T);
      epi = E_RKV; break;
    case K_SCAN: phase_scan(p, shm); break;
    case K_FIN:
      g.A = (const u16*)(big + BIG_T + 2 * SZ_T1); g.Bt = (const u16*)(ws + OFF_WG2); g.K = 128; g.N = 1024;
      g.mtiles = ntok / 256; g.ntiles = 4;
      g.o0 = (u16*)(big + BIG_Y0); g.o1 = (u16*)(big + BIG_Y1); g.o2 = (u16*)(big + BIG_RKV + 2 * SZ_RKV1);
      g.hb = (u16*)(big + BIG_RKV + SZ_RKV1);
      g.f0 = (const float*)(ws + OFF_BONUS); g.f1 = p.in[25]; g.f2 = p.in[26];
      epi = E_RWFIN; break;
    case K_RWO:
      g.A = (const u16*)(big + BIG_RKV + SZ_RKV1); g.Bt = (const u16*)(ws + OFF_WRWO); g.K = 1024; g.N = 1024;
      g.mtiles = ntok / 256; g.ntiles = 4; g.rowoff = tok0; g.ss_out = ss + (size_t)2 * MT; g.scale = 1.f;
      epi = E_RESID; break;
    case K_PGATE:
      g2 = g;
      g2.A = (const u16*)(ws + OFF_PBI) + (size_t)a * MT * 256; g2.Bt = (const u16*)(ws + OFF_WPP) + (size_t)a * 1024 * 256; g2.K = 256; g2.N = 1024;
      g2.mtiles = MT / 256; g2.ntiles = 4; g2.o0 = (u16*)(big + BIG_PB);
      g.hb = a == 0 ? (u16*)(big + BIG_HBALT) : nullptr;
      g.A = hb; g.Bt = (const u16*)(ws + OFF_WPG) + (size_t)a * 1024 * 1024; g.K = 1024; g.N = 1024;
      g.mtiles = MT / 256; g.ntiles = 4; g.ss_in = ss + (size_t)b * MT; g.ss_out = ss + (size_t)c * MT; g.o0 = (u16*)(big + BIG_PB);
      epi = E_PLEGATE; break;
    case K_QKV:
      g.A = hb; g.Bt = (const u16*)(ws + OFF_WQKV); g.K = 1024; g.N = 3072; g.mtiles = MT / 256; g.ntiles = 12;
      g.ss_in = ss + (size_t)5 * MT; g.bias = p.in[29];
      g.o0 = (u16*)(big + BIG_Q); g.o1 = (u16*)(big + BIG_K); g.o2 = (u16*)(big + BIG_VT);
      epi = E_QKV; break;
    case K_NATT:
#ifdef PROBE_NATT
      phase_natt(p, hb, shm); __syncthreads();
#endif
      phase_natt(p, (u16*)(big + BIG_Q), shm); break;
    case K_NAO:
      g.A = (const u16*)(big + BIG_Q); g.Bt = (const u16*)(ws + OFF_WNAO); g.K = 1024; g.N = 1024; g.mtiles = MT / 256; g.ntiles = 4;
      g.ss_out = ss + (size_t)6 * MT; g.bias = p.in[32]; g.scale = 1.f;
      epi = E_RESID; break;
    case K_FINAL: phase_final(p); break;
    default: break;
  }
  switch (epi) {
    case E_SWIGLU: gemm_phase<E_SWIGLU>(g, g2, shml); break;
    case E_RESID: gemm_phase<E_RESID>(g, g2, shml); break;
    case E_PLEGATE: gemm_phase<E_PLEGATE>(g, g2, shml); break;
    case E_RKV: gemm_phase<E_RKV>(g, g2, shml); break;
    case E_RWFIN: gemm_phase<E_RWFIN>(g, g2, shml); break;
    case E_QKV: gemm_phase<E_QKV>(g, g2, shml); break;
    default: break;
  }
}

__device__ __forceinline__ void grid_barrier(unsigned* bar, unsigned& nbar) {
  asm volatile("s_waitcnt vmcnt(0)" ::: "memory");
  __syncthreads();
  nbar += 1;
  if (otid() == 0) {
    __builtin_amdgcn_s_waitcnt(0);
    __builtin_amdgcn_fence(__ATOMIC_RELEASE, "agent");
    asm volatile("s_waitcnt vmcnt(0)" ::: "memory");
    __hip_atomic_fetch_add(bar, 1u, __ATOMIC_RELAXED, __HIP_MEMORY_SCOPE_AGENT);
    const unsigned target = nbar * gridDim.x;
    while (__hip_atomic_load(bar, __ATOMIC_RELAXED, __HIP_MEMORY_SCOPE_AGENT) < target) __builtin_amdgcn_s_sleep(1);
    __builtin_amdgcn_fence(__ATOMIC_ACQUIRE, "agent");
    asm volatile("s_waitcnt vmcnt(0)" ::: "memory");
  }
  __syncthreads();
}

__global__ void __launch_bounds__(NTHR, 2) fwd_megakernel(Params p, int ph_lo, int ph_hi) {
  __shared__ __attribute__((aligned(1024))) char shm[131072];
  cg::grid_group grid = cg::this_grid();
  unsigned* bar = (unsigned*)(p.ws + OFF_BAR);
  if (blockIdx.x == 0 && otid() == 0) __hip_atomic_store(bar, 0u, __ATOMIC_RELAXED, __HIP_MEMORY_SCOPE_AGENT);
  unsigned nbar = 0;
  for (int ph = ph_lo; ph < ph_hi; ++ph) {
#if PROBE_MASK
    if ((PROBE_MASK >> ph) & 1ull) { run_phase(p, ph, (LDSC*)shm); if (ph == ph_lo) grid.sync(); else grid_barrier(bar, nbar); }
#endif
    run_phase(p, ph, (LDSC*)shm);
    if (ph + 1 < ph_hi) {
      if (ph == ph_lo) grid.sync(); else grid_barrier(bar, nbar);
    }
  }
}

extern "C" void kernel_launch(void* const* d_in, const int* in_sizes, int n_in, void* d_out, int out_size, void* d_ws, size_t ws_size,
                              hipStream_t stream) {
  static int grid_blocks = 0;
  if (!grid_blocks) {
    int dev = 0, cus = 0, per_cu = 0;
    hipGetDevice(&dev);
    hipDeviceGetAttribute(&cus, hipDeviceAttributeMultiprocessorCount, dev);
    hipOccupancyMaxActiveBlocksPerMultiprocessor(&per_cu, fwd_megakernel, NTHR, 0);
    (void)per_cu;
    grid_blocks = 256;
    if (cus < 256) { fprintf(stderr, "device has %d CUs, this kernel needs 256\n", cus); grid_blocks = -1; }
  }
  if (grid_blocks < 0) return;
  if (ws_size < OFF_BIG + BIG_T + 3 * SZ_T1) return;
  Params p{};
  for (int i = 0; i < 33; ++i) p.in[i] = (const float*)d_in[i];
  p.h = (float*)d_out;
  p.ws = (char*)d_ws;
  int lo = 0, hi = NPHASE;
  void* args[] = {&p, &lo, &hi};
  hipError_t e = hipLaunchCooperativeKernel((void*)fwd_megakernel, dim3(grid_blocks), dim3(NTHR), args, 0, stream);
  if (e != hipSuccess) fprintf(stderr, "cooperative launch failed: %s (grid %d)\n", hipGetErrorString(e), grid_blocks);
}
```

```cpp
#include <hip/hip_runtime.h>
#include <hip/hip_cooperative_groups.h>
#include <cstdio>
#include <cstdint>
namespace cg = cooperative_groups;

typedef unsigned short u16;
using bf16x8 = __attribute__((ext_vector_type(8))) short;
using f32x4 = __attribute__((ext_vector_type(4))) float;
using f32x2 = __attribute__((ext_vector_type(2))) float;
using i32x4 = __attribute__((ext_vector_type(4))) int;
typedef __attribute__((address_space(3))) char LDSC;
typedef __attribute__((address_space(3))) unsigned LDSU;
typedef __attribute__((address_space(3))) bf16x8 LDS_BF8;

constexpr int MT = 49152;
constexpr int MPROMPT = 32768;
constexpr int MR = MT;
constexpr int D = 1024;
constexpr int DFF = 2816;
constexpr int NTHR = 512;

constexpr size_t SZ_WIN = (size_t)5632 * 1024 * 2;
constexpr size_t SZ_WOUT = (size_t)1024 * 2816 * 2;
constexpr size_t OFF_WIN = 0;
constexpr size_t OFF_WOUT = OFF_WIN + 4 * SZ_WIN;
constexpr size_t OFF_WPG = OFF_WOUT + 4 * SZ_WOUT;
constexpr size_t OFF_WPP = OFF_WPG + 2 * (size_t)1024 * 1024 * 2;
constexpr size_t OFF_WRKV = OFF_WPP + 2 * (size_t)1024 * 256 * 2;
constexpr size_t OFF_W2W = OFF_WRKV + (size_t)3584 * 2048 * 2;
constexpr size_t OFF_W2A = OFF_W2W + 2 * (size_t)1024 * 64 * 2;
constexpr size_t OFF_WG2 = OFF_W2A + 2 * (size_t)1024 * 64 * 2;
constexpr size_t OFF_WRWO = OFF_WG2 + (size_t)1024 * 128 * 2;
constexpr size_t OFF_WQKV = OFF_WRWO + (size_t)1024 * 1024 * 2;
constexpr size_t OFF_WNAO = OFF_WQKV + (size_t)3072 * 1024 * 2;
constexpr size_t OFF_SS = OFF_WNAO + (size_t)1024 * 1024 * 2;
constexpr size_t OFF_BONUS = OFF_SS + 9 * (size_t)MT * 4;
constexpr size_t OFF_BAR = OFF_BONUS + 2 * (size_t)MR * 16 * 4;
constexpr size_t OFF_HB = OFF_BAR + 256;
constexpr size_t OFF_PBI = OFF_HB + (size_t)MT * 1024 * 2;
constexpr size_t OFF_BIG = OFF_PBI + 2 * (size_t)MT * 256 * 2;
constexpr size_t BIG_ACTB = 0;
constexpr size_t BIG_PB = 0;
constexpr size_t BIG_HBALT = (size_t)MT * 2816 * 2;
constexpr size_t BIG_A2 = 0;
constexpr size_t BIG_Y0 = 0;
constexpr size_t BIG_Y1 = (size_t)MR * 1024 * 2;
constexpr size_t BIG_RKV = (size_t)MR * 2048 * 2;
constexpr size_t SZ_RKV1 = (size_t)MR * 1024 * 2;
constexpr size_t BIG_T = BIG_RKV + 3 * SZ_RKV1;
constexpr size_t SZ_T1 = (size_t)MR * 128 * 2;
constexpr size_t BIG_Q = 0;
constexpr size_t BIG_K = (size_t)MT * 1024 * 2;
constexpr size_t BIG_VT = 2 * (size_t)MT * 1024 * 2;

struct Params {
  const float* in[33];
  float* h;
  char* ws;
};

__device__ __forceinline__ u16 f2bf(float f) {
  unsigned u = __float_as_uint(f);
  u += 0x7fffu + ((u >> 16) & 1u);
  return (u16)(u >> 16);
}
__device__ __forceinline__ float bf2f(u16 h) { return __uint_as_float(((unsigned)h) << 16); }
__device__ __forceinline__ unsigned pack2(float a, float b) { return (unsigned)f2bf(a) | ((unsigned)f2bf(b) << 16); }
__device__ __forceinline__ float sigm(float x) { return __builtin_amdgcn_rcpf(1.f + __expf(-x)); }
template <int CTRL> __device__ __forceinline__ float dppf(float v) {
  return __int_as_float(__builtin_amdgcn_update_dpp(0, __float_as_int(v), CTRL, 0xf, 0xf, true));
}
__device__ __forceinline__ float rowsum16(float v) {
  v += dppf<0xB1>(v);
  v += dppf<0x4E>(v);
  v += dppf<0x141>(v);
  v += dppf<0x140>(v);
  return v;
}
__device__ __forceinline__ int otid() { int t = __builtin_amdgcn_workitem_id_x(); asm volatile("" : "+v"(t)); return t; }
__device__ __forceinline__ float rstd_of(float ss) { return rsqrtf(ss * (1.f / 1024.f) + 1e-6f); }

struct PrepJob {
  const float* src; int K, N, ldsrc;
  u16* dst; int dld, koff, noff;
  const float* sc; int mode;
  int perm;
};

__device__ __forceinline__ void prep_tiles(const PrepJob& j, char* shm, int nblk, int bid) {
  u16* tl = (u16*)shm;
  int kt = j.K >> 6, nt = j.N >> 6, tiles = kt * nt;
  int tid = otid();
  for (int t = bid; t < tiles; t += nblk) {
    int k0 = (t / nt) << 6, n0 = (t % nt) << 6;
#pragma unroll
    for (int it = 0; it < 2; ++it) {
      int kk = (tid >> 4) + 32 * it, nn4 = (tid & 15) * 4;
      float4 v = *(const float4*)(j.src + (size_t)(k0 + kk) * j.ldsrc + n0 + nn4);
      float s = 1.f;
      if (j.mode == 1 || j.mode == 3) s = j.sc[k0 + kk];
      else if (j.mode == 2) s = 1.f - j.sc[k0 + kk];
      tl[(nn4 + 0) * 72 + kk] = f2bf(v.x * s);
      tl[(nn4 + 1) * 72 + kk] = f2bf(v.y * s);
      tl[(nn4 + 2) * 72 + kk] = f2bf(v.z * s);
      tl[(nn4 + 3) * 72 + kk] = f2bf(v.w * s);
    }
    __syncthreads();
    {
      int nn = tid >> 3, kk8 = (tid & 7) * 8;
      int c = n0 + nn, drow;
      if (j.perm) { int half = c / DFF, cp = c % DFF; drow = (cp >> 5) * 64 + half * 32 + (cp & 31); }
      else drow = c;
      i32x4 v = *(const i32x4*)(tl + nn * 72 + kk8);
      *(i32x4*)(j.dst + (size_t)(j.noff + drow) * j.dld + j.koff + k0 + kk8) = v;
    }
    __syncthreads();
  }
}

__device__ __forceinline__ bool prep_is_early(int jj) { return jj == 0 || jj == 4 || (jj >= 12 && jj < 32); }
__device__ __forceinline__ void prep_weights(const Params& p, char* shm, bool early, int nblk, int bid) {
  char* ws = p.ws;
  for (int jj = 0; jj < 36; ++jj) {
    if (prep_is_early(jj) != early) continue;
    PrepJob j; j.mode = 0; j.sc = nullptr; j.perm = 0; j.koff = 0; j.noff = 0;
    if (jj < 4) {
      j.src = p.in[5] + (size_t)jj * 1024 * 5632; j.K = 1024; j.N = 5632; j.ldsrc = 5632;
      j.dst = (u16*)(ws + OFF_WIN + jj * SZ_WIN); j.dld = 1024; j.sc = p.in[4] + jj * 1024; j.mode = 1; j.perm = 1;
    } else if (jj < 8) {
      int q = jj - 4;
      j.src = p.in[6] + (size_t)q * 2816 * 1024; j.K = 2816; j.N = 1024; j.ldsrc = 1024;
      j.dst = (u16*)(ws + OFF_WOUT + q * SZ_WOUT); j.dld = 2816;
    } else if (jj < 10) {
      int q = jj - 8;
      j.src = p.in[9] + (size_t)q * 1024 * 1024; j.K = 1024; j.N = 1024; j.ldsrc = 1024;
      j.dst = (u16*)(ws + OFF_WPG) + (size_t)q * 1024 * 1024; j.dld = 1024; j.sc = p.in[8] + q * 1024; j.mode = 1;
    } else if (jj < 12) {
      int q = jj - 10;
      j.src = p.in[10] + (size_t)q * 256 * 1024; j.K = 256; j.N = 1024; j.ldsrc = 1024;
      j.dst = (u16*)(ws + OFF_WPP) + (size_t)q * 1024 * 256; j.dld = 256;
    } else if (jj < 28) {
      int q = (jj - 12) >> 1, hf = (jj - 12) & 1;
      j.K = 1024; j.dst = (u16*)(ws + OFF_WRKV); j.dld = 2048; j.koff = hf * 1024; j.mode = hf ? 3 : 2;
      if (q < 3) { j.src = p.in[13] + (size_t)q * 1024 * 1024; j.N = 1024; j.ldsrc = 1024; j.noff = q * 1024; j.sc = p.in[12] + q * 1024; }
      else if (q < 5) { int z = q - 3; j.src = p.in[15] + (size_t)z * 1024 * 64; j.N = 64; j.ldsrc = 64; j.noff = 3072 + z * 64; j.sc = p.in[12] + 3 * 1024; }
      else if (q < 7) { int z = q - 5; j.src = p.in[18] + (size_t)z * 1024 * 64; j.N = 64; j.ldsrc = 64; j.noff = 3200 + z * 64; j.sc = p.in[12] + 4 * 1024; }
      else { j.src = p.in[20]; j.N = 128; j.ldsrc = 128; j.noff = 3328; j.sc = p.in[12] + 5 * 1024; }
    } else if (jj < 30) {
      int z = jj - 28;
      j.src = p.in[16] + (size_t)z * 64 * 1024; j.K = 64; j.N = 1024; j.ldsrc = 1024;
      j.dst = (u16*)(ws + OFF_W2W) + (size_t)z * 1024 * 64; j.dld = 64;
    } else if (jj < 32) {
      int z = jj - 30;
      j.src = p.in[19] + (size_t)z * 64 * 1024; j.K = 64; j.N = 1024; j.ldsrc = 1024;
      j.dst = (u16*)(ws + OFF_W2A) + (size_t)z * 1024 * 64; j.dld = 64;
    } else if (jj == 32) {
      j.src = p.in[21]; j.K = 128; j.N = 1024; j.ldsrc = 1024; j.dst = (u16*)(ws + OFF_WG2); j.dld = 128;
    } else if (jj == 33) {
      j.src = p.in[27]; j.K = 1024; j.N = 1024; j.ldsrc = 1024; j.dst = (u16*)(ws + OFF_WRWO); j.dld = 1024;
    } else if (jj == 34) {
      j.src = p.in[28]; j.K = 1024; j.N = 3072; j.ldsrc = 3072; j.dst = (u16*)(ws + OFF_WQKV); j.dld = 1024; j.sc = p.in[7] + 1024; j.mode = 1;
    } else if (jj == 35) {
      j.src = p.in[31]; j.K = 1024; j.N = 1024; j.ldsrc = 1024; j.dst = (u16*)(ws + OFF_WNAO); j.dld = 1024;
    } else continue;
    prep_tiles(j, shm, nblk, bid);
  }
}

__device__ __forceinline__ void phase_prep(const Params& p, char* shm) {
  char* ws = p.ws;
  prep_weights(p, shm, true, gridDim.x, blockIdx.x);
  float* ss = (float*)(ws + OFF_SS);
  u16* hb = (u16*)(ws + OFF_HB);
  int tid = otid(), half = tid >> 8, t4 = (tid & 255) * 4;
  float* red = (float*)shm;
  for (int r0 = blockIdx.x * 2; r0 < MT; r0 += gridDim.x * 2) {
    int row = r0 + half;
    const float* src = row < MPROMPT ? p.in[0] + (size_t)row * D : p.in[1] + (size_t)(row - MPROMPT) * D;
    float4 v = *(const float4*)(src + t4);
    *(float4*)(p.h + (size_t)row * D + t4) = v;
    uint2 pk; pk.x = pack2(v.x, v.y); pk.y = pack2(v.z, v.w);
    *(uint2*)(hb + (size_t)row * D + t4) = pk;
    float s = v.x * v.x + v.y * v.y + v.z * v.z + v.w * v.w;
#pragma unroll
    for (int o = 32; o > 0; o >>= 1) s += __shfl_xor(s, o);
    __syncthreads();
    if ((tid & 63) == 0) red[tid >> 6] = s;
    __syncthreads();
    if ((tid & 255) == 0) {
      float tot = red[half * 4] + red[half * 4 + 1] + red[half * 4 + 2] + red[half * 4 + 3];
      ss[row] = tot;
#pragma unroll
      for (int q = 1; q < 9; ++q) ss[(size_t)q * MT + row] = 0.f;
    }
  }
}

__device__ __forceinline__ void conv_p(const Params& p, int layer, int nblk, int bid) {
  u16* pbi = (u16*)(p.ws + OFF_PBI) + (size_t)layer * MT * 256;
  const float* pp = p.in[2] + (size_t)layer * MPROMPT * 256;
  const float* ps = p.in[3] + (size_t)layer * (MT - MPROMPT) * 256;
  size_t n4 = (size_t)MT * 256 / 4;
  for (size_t i = (size_t)bid * NTHR + otid(); i < n4; i += (size_t)nblk * NTHR) {
    size_t e = i * 4;
    const float* s = e < (size_t)MPROMPT * 256 ? pp + e : ps + (e - (size_t)MPROMPT * 256);
    float4 v = *(const float4*)s;
    uint2 pk; pk.x = pack2(v.x, v.y); pk.y = pack2(v.z, v.w);
    *(uint2*)(pbi + e) = pk;
  }
}

__device__ __forceinline__ void conv_h(const Params& p) {
  u16* hb = (u16*)(p.ws + OFF_HB);
  size_t n4 = (size_t)MT * D / 4;
  for (size_t i = (size_t)blockIdx.x * NTHR + otid(); i < n4; i += (size_t)gridDim.x * NTHR) {
    float4 v = *(const float4*)(p.h + i * 4);
    uint2 pk; pk.x = pack2(v.x, v.y); pk.y = pack2(v.z, v.w);
    *(uint2*)(hb + i * 4) = pk;
  }
}

enum { E_SWIGLU = 0, E_RESID = 1, E_PLEPROJ = 2, E_PLEGATE = 3, E_RKV = 4, E_RWFIN = 5, E_QKV = 6 };

struct GA {
  const u16* A; const u16* Bt; int K; int N;
  int mtiles, ntiles;
  int rowoff;
  const float* ss_in; float* ss_out;
  const float* bias; float scale;
  float* h; u16* hb;
  u16* o0; u16* o1; u16* o2;
  const float* f0; const float* f1; const float* f2;
};

template <int KS> __device__ __forceinline__ int lds_byte(int r, int c) {
  int st = (r >> 4) * KS + (c >> 5), ob = (r & 15) * 64 + (c & 31) * 2;
  return st * 1024 + (ob ^ (((ob >> 9) & 1) << 5));
}
template <int KS> __device__ __forceinline__ void stage_rc(int b, int& R, int& C) {
  int st = b >> 10, sb = b & 1023, swz = sb ^ (((sb >> 9) & 1) << 5);
  R = (st / KS) * 16 + swz / 64;
  C = (st % KS) * 32 + (swz % 64) / 2;
}

template <int EPI>
__device__ __forceinline__ void gemm_tile(const GA& g, int pm, int pn, bool prefetched, bool has_next, int pm_next, int pn_next, LDSC* shm) {
  constexpr int BK = 64, KS = 2, TILE_B = 256 * BK * 2, GL = 4, STAGE_B = 2 * TILE_B;
  const int K = g.K;
  const int tid = otid(), wid = tid >> 6, lane = tid & 63, wr = wid >> 2, wc = wid & 3, fr = lane & 15, fq = lane >> 4;
  const int brow = pm * 256, bcol = pn * 256;
  const u16* Ab = g.A + (size_t)brow * K;
  const u16* Bb = g.Bt + (size_t)bcol * K;
  const u16* Abn = g.A + (size_t)(pm_next * 256) * K;
  const u16* Bbn = g.Bt + (size_t)(pn_next * 256) * K;
  int sO[GL];
#pragma unroll
  for (int i = 0; i < GL; ++i) { int r_, c_; stage_rc<KS>(wid * 1024 + i * 8192 + lane * 16, r_, c_); sO[i] = r_ * K + c_; }
  f32x4 acc[8][4];
#pragma unroll
  for (int m = 0; m < 8; ++m)
#pragma unroll
    for (int n = 0; n < 4; ++n) acc[m][n] = f32x4{0.f, 0.f, 0.f, 0.f};
  const int nt = K / BK;
#define G_STAGE(buf, AB_, BB_, kt) do { _Pragma("unroll") for (int i = 0; i < GL; ++i) { \
    __builtin_amdgcn_global_load_lds((const unsigned*)((AB_) + (kt) * BK + sO[i]), (LDSU*)(shm + (buf) * STAGE_B + wid * 1024 + i * 8192), 16, 0, 0); \
    __builtin_amdgcn_global_load_lds((const unsigned*)((BB_) + (kt) * BK + sO[i]), (LDSU*)(shm + (buf) * STAGE_B + TILE_B + wid * 1024 + i * 8192), 16, 0, 0); } } while (0)
#define G_STAGE_H(hh, buf, AB_, BB_, kt) do { _Pragma("unroll") for (int i = (hh) * 2; i < (hh) * 2 + 2; ++i) { \
    __builtin_amdgcn_global_load_lds((const unsigned*)((AB_) + (kt) * BK + sO[i]), (LDSU*)(shm + (buf) * STAGE_B + wid * 1024 + i * 8192), 16, 0, 0); \
    __builtin_amdgcn_global_load_lds((const unsigned*)((BB_) + (kt) * BK + sO[i]), (LDSU*)(shm + (buf) * STAGE_B + TILE_B + wid * 1024 + i * 8192), 16, 0, 0); } } while (0)
  if (!prefetched) G_STAGE(0, Ab, Bb, 0);
  asm volatile("s_waitcnt vmcnt(0)" ::: "memory");
  __syncthreads();
  for (int t = 0; t < nt; ++t) {
    int cur = t & 1;
    if (t + 1 < nt) G_STAGE_H(0, cur ^ 1, Ab, Bb, t + 1);
    else if (has_next) G_STAGE_H(0, 0, Abn, Bbn, 0);
    const LDSC* SAp = shm + cur * STAGE_B;
    const LDSC* SBp = SAp + TILE_B;
#pragma unroll
    for (int ks = 0; ks < KS; ++ks) {
      if (ks == 1) {
        if (t + 1 < nt) G_STAGE_H(1, cur ^ 1, Ab, Bb, t + 1);
        else if (has_next) G_STAGE_H(1, 0, Abn, Bbn, 0);
      }
      bf16x8 At[8], Bf[4];
#pragma unroll
      for (int m = 0; m < 8; ++m) At[m] = *(const LDS_BF8*)(SAp + lds_byte<KS>(wr * 128 + m * 16 + fr, ks * 32 + fq * 8));
#pragma unroll
      for (int n = 0; n < 4; ++n) Bf[n] = *(const LDS_BF8*)(SBp + lds_byte<KS>(wc * 64 + n * 16 + fr, ks * 32 + fq * 8));
      __builtin_amdgcn_s_setprio(1);
#pragma unroll
      for (int m = 0; m < 8; ++m)
#pragma unroll
        for (int n = 0; n < 4; ++n) acc[m][n] = __builtin_amdgcn_mfma_f32_16x16x32_bf16(At[m], Bf[n], acc[m][n], 0, 0, 0);
      __builtin_amdgcn_s_setprio(0);
      __builtin_amdgcn_sched_barrier(0);
    }
    if (t + 1 < nt) asm volatile("s_waitcnt vmcnt(0)" ::: "memory");
    __syncthreads();
  }
#undef G_STAGE
#undef G_STAGE_H
  typedef __attribute__((address_space(3))) float LDSF;
  typedef __attribute__((address_space(3))) f32x4 LDSF4;
  LDSF* scr = (LDSF*)(shm + STAGE_B + wid * 4352);
  const int cb = bcol + wc * 64;
#define SLAB_WRITE(m) do { _Pragma("unroll") for (int n = 0; n < 4; ++n) _Pragma("unroll") for (int j = 0; j < 4; ++j) \
    scr[(fq * 4 + j) * 68 + n * 16 + fr] = acc[m][n][j]; asm volatile("s_waitcnt lgkmcnt(0)" ::: "memory"); } while (0)
#define SLAB_DONE() asm volatile("s_waitcnt lgkmcnt(0)" ::: "memory")
  if constexpr (EPI == E_SWIGLU) {
    const int l8 = lane & 7, r8 = lane >> 3;
    float ssv[8][2];
#pragma unroll
    for (int m = 0; m < 8; ++m)
#pragma unroll
      for (int k = 0; k < 2; ++k) ssv[m][k] = g.ss_in[g.rowoff + brow + wr * 128 + m * 16 + k * 8 + r8];
#pragma unroll
    for (int m = 0; m < 8; ++m) {
      SLAB_WRITE(m);
#pragma unroll
      for (int k = 0; k < 2; ++k) {
        int rl = k * 8 + r8, row = brow + wr * 128 + m * 16 + rl;
        f32x4 gt = *(const LDSF4*)(scr + rl * 68 + l8 * 4), up = *(const LDSF4*)(scr + rl * 68 + 32 + l8 * 4);
        float rs = rstd_of(ssv[m][k]);
        float o[4];
#pragma unroll
        for (int e = 0; e < 4; ++e) { float a = gt[e] * rs; o[e] = a * sigm(a) * (up[e] * rs); }
        uint2 pk; pk.x = pack2(o[0], o[1]); pk.y = pack2(o[2], o[3]);
        *(uint2*)(g.o0 + (size_t)row * DFF + (cb >> 1) + l8 * 4) = pk;
      }
      SLAB_DONE();
    }
  } else if constexpr (EPI == E_QKV) {
    const int which = cb >> 10, c0 = cb & 1023;
    if (which == 2) {
#pragma unroll
      for (int m = 0; m < 8; ++m) {
        int row0 = brow + wr * 128 + m * 16 + fq * 4;
        float rs[4];
#pragma unroll
        for (int j = 0; j < 4; ++j) rs[j] = rstd_of(g.ss_in[row0 + j]);
#pragma unroll
        for (int n = 0; n < 4; ++n) {
          int col = c0 + n * 16 + fr;
          float b = g.bias[cb + n * 16 + fr];
          uint2 pk; pk.x = pack2(acc[m][n][0] * rs[0] + b, acc[m][n][1] * rs[1] + b); pk.y = pack2(acc[m][n][2] * rs[2] + b, acc[m][n][3] * rs[3] + b);
          *(uint2*)(g.o2 + (size_t)col * MT + row0) = pk;
        }
      }
    } else {
      u16* dst = which == 0 ? g.o0 : g.o1;
      const float sc = which == 0 ? 0.17677669529663687f : 1.f;
      f32x4 b4 = *(const f32x4*)(g.bias + cb + fr * 4);
      float ssq[8][4];
#pragma unroll
      for (int m = 0; m < 8; ++m)
#pragma unroll
        for (int k = 0; k < 4; ++k) ssq[m][k] = g.ss_in[brow + wr * 128 + m * 16 + k * 4 + fq];
#pragma unroll
      for (int m = 0; m < 8; ++m) {
        SLAB_WRITE(m);
#pragma unroll
        for (int k = 0; k < 4; ++k) {
          int rl = k * 4 + fq, row = brow + wr * 128 + m * 16 + rl;
          f32x4 v = *(const LDSF4*)(scr + rl * 68 + fr * 4);
          float rs = rstd_of(ssq[m][k]);
          uint2 pk; pk.x = pack2((v[0] * rs + b4[0]) * sc, (v[1] * rs + b4[1]) * sc); pk.y = pack2((v[2] * rs + b4[2]) * sc, (v[3] * rs + b4[3]) * sc);
          *(uint2*)(dst + (size_t)row * D + c0 + fr * 4) = pk;
        }
        SLAB_DONE();
      }
    }
  } else {
    float lw[4] = {0.f, 0.f, 0.f, 0.f}, lb[4] = {0.f, 0.f, 0.f, 0.f}, bs[4] = {0.f, 0.f, 0.f, 0.f};
    if constexpr (EPI == E_RWFIN) {
#pragma unroll
      for (int e = 0; e < 4; ++e) { lw[e] = g.f1[cb + fr * 4 + e]; lb[e] = g.f2[cb + fr * 4 + e]; }
    }
    if constexpr (EPI == E_RESID) {
      if (g.bias) {
#pragma unroll
        for (int e = 0; e < 4; ++e) bs[e] = g.bias[cb + fr * 4 + e];
      }
    }
    f32x4 h_n[4]; uint2 a_n[4]; float f_n[4][2];
#define EPI_LOAD(m_) do { _Pragma("unroll") for (int k = 0; k < 4; ++k) { \
      const int row_ = brow + wr * 128 + (m_) * 16 + k * 4 + fq, col_ = cb + fr * 4; \
      if constexpr (EPI == E_RESID || EPI == E_PLEGATE) h_n[k] = *(const f32x4*)(g.h + (size_t)(g.rowoff + row_) * D + col_); \
      if constexpr (EPI == E_PLEGATE) { a_n[k] = *(const uint2*)(g.o0 + (size_t)(g.rowoff + row_) * D + col_); f_n[k][0] = g.ss_in[g.rowoff + row_]; } \
      } } while (0)
    f32x4 h_m[4]; uint2 a_m[4]; float f_m[4][2];
    EPI_LOAD(0);
#pragma unroll
    for (int k = 0; k < 4; ++k) { h_m[k] = h_n[k]; a_m[k] = a_n[k]; f_m[k][0] = f_n[k][0]; }
    EPI_LOAD(1);
#pragma unroll
    for (int m = 0; m < 8; ++m) {
      f32x4 h_c[4]; uint2 a_c[4]; float f_c[4][2];
#pragma unroll
      for (int k = 0; k < 4; ++k) { h_c[k] = h_m[k]; a_c[k] = a_m[k]; f_c[k][0] = f_m[k][0];
                                    h_m[k] = h_n[k]; a_m[k] = a_n[k]; f_m[k][0] = f_n[k][0]; }
      if (m + 2 < 8) EPI_LOAD(m + 2);
      uint2 fy0[4], fy1[4], fvv[4]; float fbn[4];
      if constexpr (EPI == E_RWFIN) {
#pragma unroll
        for (int k = 0; k < 4; ++k) {
          const int row_ = brow + wr * 128 + m * 16 + k * 4 + fq;
          const size_t idx_ = (size_t)row_ * D + cb + fr * 4;
          fy0[k] = *(const uint2*)(g.o0 + idx_); fy1[k] = *(const uint2*)(g.o1 + idx_); fvv[k] = *(const uint2*)(g.o2 + idx_);
          fbn[k] = g.f0[(size_t)row_ * 16 + (cb >> 6)] + g.f0[(size_t)MR * 16 + (size_t)row_ * 16 + (cb >> 6)];
        }
      }
      SLAB_WRITE(m);
#pragma unroll
      for (int k = 0; k < 4; ++k) {
        const int rl = k * 4 + fq, row = brow + wr * 128 + m * 16 + rl;
        const int col = cb + fr * 4;
        f32x4 v = *(const LDSF4*)(scr + rl * 68 + fr * 4);
        if constexpr (EPI == E_RESID || EPI == E_PLEGATE) {
          size_t grow = (size_t)(g.rowoff + row);
          float* hp = g.h + grow * D + col;
          f32x4 hv = h_c[k];
          if constexpr (EPI == E_PLEGATE) {
            float rs = rstd_of(f_c[k][0]);
            uint2 pb = a_c[k];
            hv[0] += sigm(v[0] * rs) * bf2f((u16)(pb.x & 0xffff));
            hv[1] += sigm(v[1] * rs) * bf2f((u16)(pb.x >> 16));
            hv[2] += sigm(v[2] * rs) * bf2f((u16)(pb.y & 0xffff));
            hv[3] += sigm(v[3] * rs) * bf2f((u16)(pb.y >> 16));
          } else {
#pragma unroll
            for (int e = 0; e < 4; ++e) hv[e] += g.scale * v[e] + bs[e];
          }
          *(f32x4*)hp = hv;
          if (g.hb != nullptr) {
            uint2 pk; pk.x = pack2(hv[0], hv[1]); pk.y = pack2(hv[2], hv[3]);
            *(uint2*)(g.hb + grow * D + col) = pk;
          }
          float sq = rowsum16(hv[0] * hv[0] + hv[1] * hv[1] + hv[2] * hv[2] + hv[3] * hv[3]);
          if (fr == 0) atomicAdd(g.ss_out + grow, sq);
        } else if constexpr (EPI == E_PLEPROJ) {
          uint2 pk; pk.x = pack2(v[0], v[1]); pk.y = pack2(v[2], v[3]);
          *(uint2*)(g.o0 + (size_t)row * D + col) = pk;
        } else if constexpr (EPI == E_RKV) {
          if (cb < 3072) {
            u16* buf = g.o0 + (size_t)(cb >> 10) * ((size_t)MR * 1024);
            uint2 pk; pk.x = pack2(v[0], v[1]); pk.y = pack2(v[2], v[3]);
            *(uint2*)(buf + (size_t)row * D + (cb & 1023) + fr * 4) = pk;
          } else if (cb < 3456) {
            int which = (cb - 3072) >> 7, c0 = (cb - 3072) & 127;
            u16* buf = g.o1 + (size_t)which * ((size_t)MR * 128);
            if (which == 0) { v[0] = tanhf(v[0]); v[1] = tanhf(v[1]); v[2] = tanhf(v[2]); v[3] = tanhf(v[3]); }
            else if (which == 2) { v[0] = sigm(v[0]); v[1] = sigm(v[1]); v[2] = sigm(v[2]); v[3] = sigm(v[3]); }
            uint2 pk; pk.x = pack2(v[0], v[1]); pk.y = pack2(v[2], v[3]);
            *(uint2*)(buf + (size_t)row * 128 + c0 + fr * 4) = pk;
          }
        } else if constexpr (EPI == E_RWFIN) {
          const int head = cb >> 6;
          size_t idx = (size_t)row * D + col;
          uint2 a0 = fy0[k], a1 = fy1[k], vv = fvv[k];
          float y[4];
          y[0] = bf2f((u16)(a0.x & 0xffff)) + bf2f((u16)(a1.x & 0xffff));
          y[1] = bf2f((u16)(a0.x >> 16)) + bf2f((u16)(a1.x >> 16));
          y[2] = bf2f((u16)(a0.y & 0xffff)) + bf2f((u16)(a1.y & 0xffff));
          y[3] = bf2f((u16)(a0.y >> 16)) + bf2f((u16)(a1.y >> 16));
          float mean = rowsum16(y[0] + y[1] + y[2] + y[3]) * (1.f / 64.f);
#pragma unroll
          for (int e = 0; e < 4; ++e) y[e] -= mean;
          float inv = rsqrtf(rowsum16(y[0] * y[0] + y[1] * y[1] + y[2] * y[2] + y[3] * y[3]) * (1.f / 64.f) + 64e-5f);
          float bon = fbn[k];
          float vf[4] = {bf2f((u16)(vv.x & 0xffff)), bf2f((u16)(vv.x >> 16)), bf2f((u16)(vv.y & 0xffff)), bf2f((u16)(vv.y >> 16))};
          float o[4];
#pragma unroll
          for (int e = 0; e < 4; ++e) o[e] = (y[e] * inv * lw[e] + lb[e] + bon * vf[e]) * v[e];
          uint2 pk; pk.x = pack2(o[0], o[1]); pk.y = pack2(o[2], o[3]);
          *(uint2*)(g.hb + idx) = pk;
        }
      }
      SLAB_DONE();
    }
  }
#undef SLAB_WRITE
#undef EPI_LOAD
#undef SLAB_DONE
}

template <int EPI> __device__ __forceinline__ void gemm_phase(const GA& g, const GA& g2, LDSC* shm) {
  const int nM = g.mtiles, nN = g.ntiles;
  const int G = gridDim.x;
  const int PN = (nN & 3) == 0 ? 4 : 2, PM = 32 / PN;
  const int sN = nN / PN, sM = nM / PM, nsup = sN * sM;
  const int per = G >> 8;
  const int b = blockIdx.x, x = b & 7, l = (b >> 3) & 31, rep = b >> 8;
  bool pref = false;
  for (int s = x + 8 * rep; s < nsup; s += 8 * per) {
    int sm = s / sN, sn = s % sN;
    int pm = sm * PM + (l % PM), pn = sn * PN + (l / PM);
    int s2 = s + 8 * per;
    bool hn = s2 < nsup;
    int pm2 = (s2 / sN) * PM + (l % PM), pn2 = (s2 % sN) * PN + (l / PM);
    if constexpr (EPI == E_PLEGATE) {
      gemm_tile<E_PLEPROJ>(g2, pm, pn, false, false, pm, pn, shm);
      gemm_tile<E_PLEGATE>(g, pm, pn, false, false, pm, pn, shm);
    } else {
      gemm_tile<EPI>(g, pm, pn, pref, hn, hn ? pm2 : pm, hn ? pn2 : pn, shm);
      pref = hn;
    }
  }
  __syncthreads();
}

__device__ __forceinline__ void phase_mix(const Params& p, int tok0, int ntok) {
  const float* ss1 = (const float*)(p.ws + OFF_SS) + (size_t)1 * MT;
  const float* gain = p.in[7];
  u16* A2 = (u16*)(p.ws + OFF_BIG + BIG_A2);
  int tid = otid(), half = tid >> 8, c4 = (tid & 255) * 4;
  float4 gn = *(const float4*)(gain + c4);
  for (int l0 = blockIdx.x * 2; l0 < ntok; l0 += gridDim.x * 2) {
    int l = l0 + half, tok = tok0 + l;
    int pos, T;
    if (tok < MPROMPT) { pos = tok & 2047; T = 2048; } else { pos = tok - MPROMPT; T = 16384; }
    float4 c = *(const float4*)(p.h + (size_t)tok * D + c4);
    float rc = rstd_of(ss1[tok]);
    float4 hn = {c.x * rc * gn.x, c.y * rc * gn.y, c.z * rc * gn.z, c.w * rc * gn.w};
    float4 av = {0.f, 0.f, 0.f, 0.f};
    if (pos > 0) {
      float4 q = *(const float4*)(p.h + (size_t)(tok - 1) * D + c4);
      float r = rstd_of(ss1[tok - 1]);
      av.x += q.x * r * gn.x; av.y += q.y * r * gn.y; av.z += q.z * r * gn.z; av.w += q.w * r * gn.w;
    }
    if (pos < T - 1) {
      float4 q = *(const float4*)(p.h + (size_t)(tok + 1) * D + c4);
      float r = rstd_of(ss1[tok + 1]);
      av.x += q.x * r * gn.x; av.y += q.y * r * gn.y; av.z += q.z * r * gn.z; av.w += q.w * r * gn.w;
    }
    uint2 a, b;
    a.x = pack2(hn.x, hn.y); a.y = pack2(hn.z, hn.w);
    b.x = pack2(0.5f * av.x, 0.5f * av.y); b.y = pack2(0.5f * av.z, 0.5f * av.w);
    *(uint2*)(A2 + (size_t)l * 2048 + c4) = a;
    *(uint2*)(A2 + (size_t)l * 2048 + 1024 + c4) = b;
  }
}

constexpr int SC_T = 32;
constexpr int SC_ARR = SC_T * 64 * 4;
constexpr int SC_BUF = 6 * SC_ARR;
template <int E> __device__ __forceinline__ float rowsumL(float v) {
  v += dppf<0xB1>(v); v += dppf<0x4E>(v); v += dppf<0x141>(v);
  if (E == 4) v += dppf<0x140>(v);
  return v;
}

template <int E, int R = 1>
__device__ __forceinline__ void scan_item(const Params& p, int seq_loc0, int T, int head, int z, int rowbase, int nw, char* shm) {
  char* big = p.ws + OFF_BIG;
  const u16* Rb = (const u16*)(big + BIG_RKV);
  const u16* Kb = (const u16*)(big + BIG_RKV + SZ_RKV1);
  const u16* Vb = (const u16*)(big + BIG_RKV + 2 * SZ_RKV1);
  const u16* TW = (const u16*)(big + BIG_T);
  const u16* TA = (const u16*)(big + BIG_T + SZ_T1);
  u16* Y = (u16*)(big + (z ? BIG_Y1 : BIG_Y0));
  float* bonus = (float*)(p.ws + OFF_BONUS) + (size_t)z * MR * 16;
  const u16* W2 = (const u16*)(p.ws + OFF_W2W) + (size_t)z * 1024 * 64;
  const u16* A2w = (const u16*)(p.ws + OFF_W2A) + (size_t)z * 1024 * 64;
  const float* w0 = p.in[14] + z * 1024 + head * 64;
  const float* a0 = p.in[17] + z * 1024 + head * 64;
  const int tid = otid(), wv = tid >> 6, lane = tid & 63, fr = lane & 15, fq = lane >> 4;
  float* Ybuf = (float*)(shm + 2 * SC_BUF);
  const int si = tid >> 4, ec4 = (tid & 15) * 4;
  float4 ckk = *(const float4*)(p.in[22] + head * 64 + ec4);
  float4 cka = *(const float4*)(p.in[23] + head * 64 + ec4);
  float4 crk = *(const float4*)(p.in[24] + head * 64 + ec4);
  const int mt = wv >> 2, ntl = wv & 3;
  bf16x8 Bw[2], Ba[2];
#pragma unroll
  for (int ks = 0; ks < 2; ++ks) {
    Bw[ks] = *(const bf16x8*)(W2 + (size_t)(head * 64 + ntl * 16 + fr) * 64 + ks * 32 + fq * 8);
    Ba[ks] = *(const bf16x8*)(A2w + (size_t)(head * 64 + ntl * 16 + fr) * 64 + ks * 32 + fq * 8);
  }
  const float w0c = w0[ntl * 16 + fr], a0c = a0[ntl * 16 + fr];
  constexpr int LPR = 64 / E, RPW = R * (64 / LPR), NP = E / 2, NQ = E / 4;
  const int le = lane % LPR, row0 = rowbase + wv * RPW + (lane / LPR) * R;
  f32x2 st[R][NP];
#pragma unroll
  for (int r = 0; r < R; ++r)
#pragma unroll
    for (int q = 0; q < NP; ++q) st[r][q] = f32x2{0.f, 0.f};
  float skc = 0.f, sklast = 0.f;
  f32x2 ulast0 = {0.f, 0.f}, ulast1 = {0.f, 0.f};
  f32x4 kalast = {0.f, 0.f, 0.f, 0.f};
  const int nch = T / SC_T;
  uint2 pr, pk, pv; bf16x8 Aw[2], Aa[2];
  auto tok_of = [&](int t) { return seq_loc0 + (z ? (T - 1 - t) : t); };
#define SC_LOAD(c) do { \
    int tk_ = tok_of((c) * SC_T + si); \
    pr = *(const uint2*)(Rb + (size_t)tk_ * D + head * 64 + ec4); \
    pk = *(const uint2*)(Kb + (size_t)tk_ * D + head * 64 + ec4); \
    pv = *(const uint2*)(Vb + (size_t)tk_ * D + head * 64 + ec4); \
    int tm_ = tok_of((c) * SC_T + mt * 16 + fr); \
    _Pragma("unroll") for (int ks = 0; ks < 2; ++ks) { \
      Aw[ks] = *(const bf16x8*)(TW + (size_t)tm_ * 128 + z * 64 + ks * 32 + fq * 8); \
      Aa[ks] = *(const bf16x8*)(TA + (size_t)tm_ * 128 + z * 64 + ks * 32 + fq * 8); } } while (0)
#define SC_LORA(b) do { \
    f32x4 cw = {0.f, 0.f, 0.f, 0.f}, ca = {0.f, 0.f, 0.f, 0.f}; \
    _Pragma("unroll") for (int ks = 0; ks < 2; ++ks) { \
      cw = __builtin_amdgcn_mfma_f32_16x16x32_bf16(Aw[ks], Bw[ks], cw, 0, 0, 0); \
      ca = __builtin_amdgcn_mfma_f32_16x16x32_bf16(Aa[ks], Ba[ks], ca, 0, 0, 0); } \
    float* Wl_ = (float*)(shm + (b) * SC_BUF); float* Al_ = (float*)(shm + (b) * SC_BUF + 3 * SC_ARR); \
    _Pragma("unroll") for (int j = 0; j < 4; ++j) { \
      int st_ = mt * 16 + fq * 4 + j; \
      Wl_[st_ * 64 + ntl * 16 + fr] = __expf(-0.6065306597126334f * sigm(w0c + cw[j])); \
      Al_[st_ * 64 + ntl * 16 + fr] = sigm(a0c + ca[j]); } } while (0)
#define SC_ELEM(b, c) do { \
    char* bb_ = shm + (b) * SC_BUF; \
    float4 a4 = *(const float4*)(bb_ + 3 * SC_ARR + (si * 64 + ec4) * 4); \
    float r0 = bf2f((u16)(pr.x & 0xffff)), r1 = bf2f((u16)(pr.x >> 16)), r2 = bf2f((u16)(pr.y & 0xffff)), r3 = bf2f((u16)(pr.y >> 16)); \
    float k0 = bf2f((u16)(pk.x & 0xffff)), k1 = bf2f((u16)(pk.x >> 16)), k2 = bf2f((u16)(pk.y & 0xffff)), k3 = bf2f((u16)(pk.y >> 16)); \
    float v0 = bf2f((u16)(pv.x & 0xffff)), v1 = bf2f((u16)(pv.x >> 16)), v2 = bf2f((u16)(pv.y & 0xffff)), v3 = bf2f((u16)(pv.y >> 16)); \
    float q0 = k0 * ckk.x, q1 = k1 * ckk.y, q2 = k2 * ckk.z, q3 = k3 * ckk.w; \
    float n2 = rowsum16(q0 * q0 + q1 * q1 + q2 * q2 + q3 * q3); \
    float inv_ = rsqrtf(fmaxf(n2, 1e-24f)); \
    q0 *= inv_; q1 *= inv_; q2 *= inv_; q3 *= inv_; \
    float d0 = k0 * (1.f + (a4.x - 1.f) * cka.x), d1 = k1 * (1.f + (a4.y - 1.f) * cka.y), d2 = k2 * (1.f + (a4.z - 1.f) * cka.z), d3 = k3 * (1.f + (a4.w - 1.f) * cka.w); \
    float bn = rowsum16(r0 * d0 * crk.x + r1 * d1 * crk.y + r2 * d2 * crk.z + r3 * d3 * crk.w); \
    if (rowbase == 0 && (tid & 15) == 0) bonus[(size_t)tok_of((c) * SC_T + si) * 16 + head] = bn; \
    *(float4*)(bb_ + 1 * SC_ARR + (si * 64 + ec4) * 4) = float4{q0, q1, q2, q3}; \
    *(float4*)(bb_ + 2 * SC_ARR + (si * 64 + ec4) * 4) = float4{d0, d1, d2, d3}; \
    *(float4*)(bb_ + 3 * SC_ARR + (si * 64 + ec4) * 4) = float4{q0 * a4.x, q1 * a4.y, q2 * a4.z, q3 * a4.w}; \
    *(float4*)(bb_ + 4 * SC_ARR + (si * 64 + ec4) * 4) = float4{r0, r1, r2, r3}; \
    *(float4*)(bb_ + 5 * SC_ARR + (si * 64 + ec4) * 4) = float4{v0, v1, v2, v3}; } while (0)

  __syncthreads();
  SC_LOAD(0);
  SC_LORA(0);
  __syncthreads();
  SC_ELEM(0, 0);
  __syncthreads();
  for (int c = 0; c < nch; ++c) {
    const int b = c & 1;
    if (c + 1 < nch) SC_LOAD(c + 1);
    const char* bb = shm + b * SC_BUF;
    if (wv < nw) {
      f32x4 cw[NQ], ckq[NQ], ckd[NQ], cka4[NQ], cr[NQ]; float vv[R];
#define SC_LD(i_, W_, KK_, KD_, KA_, R_, V_) do { _Pragma("unroll") for (int q = 0; q < NQ; ++q) { \
        W_[q] = *(const f32x4*)(bb + 0 * SC_ARR + ((i_) * 64 + le * E + q * 4) * 4); \
        KK_[q] = *(const f32x4*)(bb + 1 * SC_ARR + ((i_) * 64 + le * E + q * 4) * 4); \
        KD_[q] = *(const f32x4*)(bb + 2 * SC_ARR + ((i_) * 64 + le * E + q * 4) * 4); \
        KA_[q] = *(const f32x4*)(bb + 3 * SC_ARR + ((i_) * 64 + le * E + q * 4) * 4); \
        R_[q] = *(const f32x4*)(bb + 4 * SC_ARR + ((i_) * 64 + le * E + q * 4) * 4); } \
        _Pragma("unroll") for (int r = 0; r < R; ++r) V_[r] = *(const float*)(bb + 5 * SC_ARR + ((i_) * 64 + row0 + r) * 4); } while (0)
      SC_LD(0, cw, ckq, ckd, cka4, cr, vv);
      f32x4 mw_[NQ], mkq[NQ], mkd[NQ], mka[NQ], mr[NQ]; float mvv[R];
      if constexpr (E == 4) {
        SC_LD(1, mw_, mkq, mkd, mka, mr, mvv);
        f32x2 pu = ulast0 * ckq[0].lo + ulast1 * ckq[0].hi;
        f32x2 pc = kalast.lo * ckq[0].lo + kalast.hi * ckq[0].hi;
        skc = rowsumL<E>(pu.x + pu.y) - sklast * rowsumL<E>(pc.x + pc.y);
      }
#pragma unroll 8
      for (int i = 0; i < SC_T; ++i) {
        f32x4 nw_[NQ], nkq[NQ], nkd[NQ], nka[NQ], nr[NQ]; float nvv[R];
        const int in_ = (i + (E == 4 ? 2 : 1)) & (SC_T - 1);
        SC_LD(in_, nw_, nkq, nkd, nka, nr, nvv);
        float sk[R], yy[R];
        f32x2 uq[R][NP];
        if constexpr (E == 4) {
          f32x2 u0 = st[0][0] * cw[0].lo + ckd[0].lo * vv[0];
          f32x2 u1 = st[0][1] * cw[0].hi + ckd[0].hi * vv[0];
          st[0][0] = u0 - cka4[0].lo * skc;
          st[0][1] = u1 - cka4[0].hi * skc;
          f32x2 pu = u0 * mkq[0].lo + u1 * mkq[0].hi;
          f32x2 pc = cka4[0].lo * mkq[0].lo + cka4[0].hi * mkq[0].hi;
          const float rr_ = rowsumL<E>(pu.x + pu.y), cc_ = rowsumL<E>(pc.x + pc.y);
          ulast0 = u0; ulast1 = u1; kalast = cka4[0]; sklast = skc;
          skc = rr_ - skc * cc_;
          f32x2 ya = st[0][0] * cr[0].lo + st[0][1] * cr[0].hi;
          yy[0] = ya.x + ya.y;
        } else {
#pragma unroll
        for (int r = 0; r < R; ++r) {
          f32x2 da = st[r][0] * ckq[0].lo;
#pragma unroll
          for (int q = 1; q < NP; ++q) da += st[r][q] * ((q & 1) ? ckq[q >> 1].hi : ckq[q >> 1].lo);
#pragma unroll
          for (int q = 0; q < NP; ++q) {
            f32x2 kdq = (q & 1) ? ckd[q >> 1].hi : ckd[q >> 1].lo;
            f32x2 wq = (q & 1) ? cw[q >> 1].hi : cw[q >> 1].lo;
            uq[r][q] = st[r][q] * wq + kdq * vv[r];
          }
          sk[r] = da.x + da.y;
        }
#pragma unroll
        for (int r = 0; r < R; ++r) sk[r] = rowsumL<E>(sk[r]);
#pragma unroll
        for (int r = 0; r < R; ++r) {
#pragma unroll
          for (int q = 0; q < NP; ++q) {
            f32x2 kaq = (q & 1) ? cka4[q >> 1].hi : cka4[q >> 1].lo;
            st[r][q] = uq[r][q] - kaq * sk[r];
          }
          f32x2 ya = st[r][0] * cr[0].lo;
#pragma unroll
          for (int q = 1; q < NP; ++q) ya += st[r][q] * ((q & 1) ? cr[q >> 1].hi : cr[q >> 1].lo);
          yy[r] = ya.x + ya.y;
        }
        }
#pragma unroll
        for (int r = 0; r < R; ++r) yy[r] = rowsumL<E>(yy[r]);
        if (le == 0) {
#pragma unroll
          for (int r = 0; r < R; ++r) Ybuf[i * 64 + row0 + r] = yy[r];
        }
        if constexpr (E == 4) {
#pragma unroll
          for (int q = 0; q < NQ; ++q) { cw[q] = mw_[q]; ckq[q] = mkq[q]; ckd[q] = mkd[q]; cka4[q] = mka[q]; cr[q] = mr[q];
                                         mw_[q] = nw_[q]; mkq[q] = nkq[q]; mkd[q] = nkd[q]; mka[q] = nka[q]; mr[q] = nr[q]; }
#pragma unroll
          for (int r = 0; r < R; ++r) { vv[r] = mvv[r]; mvv[r] = nvv[r]; }
        } else {
#pragma unroll
          for (int q = 0; q < NQ; ++q) { cw[q] = nw_[q]; ckq[q] = nkq[q]; ckd[q] = nkd[q]; cka4[q] = nka[q]; cr[q] = nr[q]; }
#pragma unroll
          for (int r = 0; r < R; ++r) vv[r] = nvv[r];
        }
      }
#undef SC_LD
    }
    if (c + 1 < nch) SC_LORA(b ^ 1);
    __syncthreads();
    if (c + 1 < nch) SC_ELEM(b ^ 1, c + 1);
    {
      int tk = tok_of(c * SC_T + si);
      int rr = (tid & 15) * 4;
      if (rr >= rowbase && rr < rowbase + nw * RPW) {
        float4 yv = *(const float4*)(Ybuf + si * 64 + rr);
        uint2 pk2; pk2.x = pack2(yv.x, yv.y); pk2.y = pack2(yv.z, yv.w);
        *(uint2*)(Y + (size_t)tk * D + head * 64 + rr) = pk2;
      }
    }
    __syncthreads();
  }
#undef SC_LOAD
#undef SC_LORA
#undef SC_ELEM
}

__device__ __forceinline__ void phase_scan(const Params& p, char* shm) {
  const int G = gridDim.x, b = blockIdx.x;
  const int nS = 128, nP = 16 * 32;
  int j, step;
  if (G > nS) { if (b < nS) { j = b; step = 1 << 30; } else { j = nS + (b - nS); step = G - nS; } }
  else { j = b; step = G; }
  for (; j < nS + nP; j += step) {
    if (j < nS) scan_item<4>(p, MPROMPT, 16384, (j >> 3) & 15, (j >> 2) & 1, (j & 3) * 16, 4, shm);
    else { int q = j - nS; scan_item<8, 2>(p, (q >> 5) * 2048, 2048, (q >> 1) & 15, q & 1, 0, 4, shm); }
  }
  __syncthreads();
  if (G > nS) { if (b >= nS) { prep_weights(p, shm, false, G - nS, b - nS); conv_p(p, 0, G - nS, b - nS); conv_p(p, 1, G - nS, b - nS); } }
  else { prep_weights(p, shm, false, G, b); conv_p(p, 0, G, b); conv_p(p, 1, G, b); }
}

__device__ __forceinline__ void phase_natt(const Params& p, u16* Odst, char* shm) {
  char* big = p.ws + OFF_BIG;
  const u16* Q = (const u16*)(big + BIG_Q);
  const u16* Kb = (const u16*)(big + BIG_K);
  const u16* Vt = (const u16*)(big + BIG_VT);
  const int tid = otid(), wv = tid >> 6, lane = tid & 63, fr = lane & 15, fq = lane >> 4;
  const int hg = blockIdx.x & 3, h = hg * 8 + wv;
  float* tab = (float*)(shm + wv * 3840);
  {
    const float* rp = p.in[30] + (size_t)h * 15 * 31;
    for (int idx = lane; idx < 960; idx += 64) tab[idx] = 0.f;
    asm volatile("s_waitcnt lgkmcnt(0)" ::: "memory");
    for (int idx = lane; idx < 465; idx += 64) { int r = idx / 31, c = idx - r * 31; tab[r * 64 + 16 + c] = rp[idx]; }
    asm volatile("s_waitcnt lgkmcnt(0)" ::: "memory");
  }
  const int nqb = MT / 16, qstep = gridDim.x >> 2;
  for (int qb = blockIdx.x >> 2; qb < nqb; qb += qstep) {
    int tb = qb * 16;
    int seqbase, T, loc;
    if (tb < MPROMPT) { seqbase = tb & ~2047; T = 2048; loc = tb & 2047; } else { seqbase = MPROMPT; T = 16384; loc = tb - MPROMPT; }
    int rows = T >> 6, i = loc >> 6, cbq = (loc & 63) >> 4;
    int rs = min(max(i - 4, 0), rows - 8);
    int kvs = min(max(cbq * 16 - 8, 0), 32);
    int qc = cbq * 16 + fr;
    int ws_ = min(max(qc - 8, 0), 48);
    bf16x8 qf = *(const bf16x8*)(Q + (size_t)(tb + fr) * D + h * 32 + fq * 8);
    unsigned vm = 0;
#pragma unroll
    for (int e = 0; e < 8; ++e) { int kcol = kvs + fq * 8 + e; vm |= ((kcol >= ws_) && (kcol < ws_ + 16)) ? (1u << e) : 0u; }
    const float* trow = tab + (rs - i + 7) * 64 + 16 + (kvs + fq * 8 - qc + 15);
    bf16x8 kf[8][2];
#pragma unroll
    for (int r = 0; r < 8; ++r)
#pragma unroll
      for (int hb2 = 0; hb2 < 2; ++hb2) {
        int kcolA = kvs + (fr >> 2) * 8 + hb2 * 4 + (fr & 3);
        size_t ktok = (size_t)seqbase + (size_t)(rs + r) * 64 + kcolA;
        kf[r][hb2] = *(const bf16x8*)(Kb + ktok * D + h * 32 + fq * 8);
      }
    f32x4 sc[8][2];
    float mx = -1e30f;
#pragma unroll
    for (int r = 0; r < 8; ++r) {
#pragma unroll
      for (int hb2 = 0; hb2 < 2; ++hb2) {
        f32x4 a = __builtin_amdgcn_mfma_f32_16x16x32_bf16(kf[r][hb2], qf, f32x4{0.f, 0.f, 0.f, 0.f}, 0, 0, 0);
#pragma unroll
        for (int j = 0; j < 4; ++j) {
          float sv = ((vm >> (hb2 * 4 + j)) & 1u) ? a[j] + trow[r * 64 + hb2 * 4 + j] : -1e30f;
          a[j] = sv; mx = fmaxf(mx, sv);
        }
        sc[r][hb2] = a;
      }
    }
    mx = fmaxf(mx, __shfl_xor(mx, 16));
    mx = fmaxf(mx, __shfl_xor(mx, 32));
    float sum = 0.f;
    f32x4 o0 = {0.f, 0.f, 0.f, 0.f}, o1 = {0.f, 0.f, 0.f, 0.f};
#pragma unroll
    for (int r = 0; r < 8; ++r) {
      bf16x8 pf;
#pragma unroll
      for (int e = 0; e < 8; ++e) {
        float pe = __expf(sc[r][e >> 2][e & 3] - mx);
        sum += pe;
        pf[e] = (short)f2bf(pe);
      }
      size_t vbase = (size_t)seqbase + (size_t)(rs + r) * 64 + kvs + fq * 8;
      bf16x8 v0 = *(const bf16x8*)(Vt + (size_t)(h * 32 + fr) * MT + vbase);
      bf16x8 v1 = *(const bf16x8*)(Vt + (size_t)(h * 32 + 16 + fr) * MT + vbase);
      o0 = __builtin_amdgcn_mfma_f32_16x16x32_bf16(v0, pf, o0, 0, 0, 0);
      o1 = __builtin_amdgcn_mfma_f32_16x16x32_bf16(v1, pf, o1, 0, 0, 0);
    }
    sum += __shfl_xor(sum, 16);
    sum += __shfl_xor(sum, 32);
    float inv = 1.f / sum;
    uint2 w0, w1;
    w0.x = pack2(o0[0] * inv, o0[1] * inv); w0.y = pack2(o0[2] * inv, o0[3] * inv);
    w1.x = pack2(o1[0] * inv, o1[1] * inv); w1.y = pack2(o1[2] * inv, o1[3] * inv);
    *(uint2*)(Odst + (size_t)(tb + fr) * D + h * 32 + fq * 4) = w0;
    *(uint2*)(Odst + (size_t)(tb + fr) * D + h * 32 + 16 + fq * 4) = w1;
  }
}

__device__ __forceinline__ void phase_final(const Params& p) {
  const float* ss8 = (const float*)(p.ws + OFF_SS) + (size_t)8 * MT;
  const float* gain = p.in[11];
  int tid = otid(), half = tid >> 8, c4 = (tid & 255) * 4;
  float4 gn = *(const float4*)(gain + c4);
  for (int r0 = blockIdx.x * 2; r0 < MT; r0 += gridDim.x * 2) {
    int row = r0 + half;
    float rs = rstd_of(ss8[row]);
    float4 v = *(float4*)(p.h + (size_t)row * D + c4);
    v.x *= rs * gn.x; v.y *= rs * gn.y; v.z *= rs * gn.z; v.w *= rs * gn.w;
    *(float4*)(p.h + (size_t)row * D + c4) = v;
  }
}

constexpr int NPHASE = 20;
#ifndef PROBE_MASK
#define PROBE_MASK 0ull
#endif

enum { K_NONE = 0, K_PREP, K_FFN1, K_FFN2, K_MIX, K_RKV, K_SCAN, K_FIN, K_RWO, K_PPROJ, K_PGATE, K_CONVH, K_QKV, K_NATT, K_NAO, K_FINAL };

__device__ __forceinline__ void run_phase(const Params& p, int ph, LDSC* shml) {
  char* shm = (char*)shml;
  char* ws = p.ws;
  float* ss = (float*)(ws + OFF_SS);
  u16* hb = (u16*)(ws + OFF_HB);
  char* big = ws + OFF_BIG;
  int kind = K_NONE, a = 0, b = 0, c = 0, d = 0;
  switch (ph) {
    case 0: kind = K_PREP; break;
    case 1: kind = K_FFN1; a = 0; b = 0; c = 0; d = 0; break;
    case 2: kind = K_FFN2; a = 0; b = 0; c = 1; break;
    case 3: kind = K_MIX; break;
    case 4: kind = K_RKV; break;
    case 5: kind = K_SCAN; break;
    case 6: kind = K_FIN; break;
    case 7: kind = K_RWO; break;
    case 8: kind = K_FFN1; a = 0; b = 1; c = 2; d = 1; break;
    case 9: kind = K_FFN2; a = 0; b = 1; c = 3; break;
    case 10: kind = K_PGATE; a = 0; b = 3; c = 4; break;
    case 11: kind = K_FFN1; a = 1; b = 0; c = 4; d = 0; break;
    case 12: kind = K_FFN2; a = 1; b = 0; c = 5; break;
    case 13: kind = K_QKV; break;
    case 14: kind = K_NATT; break;
    case 15: kind = K_NAO; break;
    case 16: kind = K_FFN1; a = 1; b = 1; c = 6; d = 1; break;
    case 17: kind = K_FFN2; a = 1; b = 1; c = 7; break;
    case 18: kind = K_PGATE; a = 1; b = 7; c = 8; break;
    case 19: kind = K_FINAL; break;
    default: break;
  }
  GA g;
  g.A = nullptr; g.Bt = nullptr; g.K = 0; g.N = 0; g.mtiles = 0; g.ntiles = 0; g.rowoff = 0;
  g.ss_in = nullptr; g.ss_out = nullptr; g.bias = nullptr; g.scale = 1.f; g.h = p.h; g.hb = hb;
  g.o0 = nullptr; g.o1 = nullptr; g.o2 = nullptr; g.f0 = nullptr; g.f1 = nullptr; g.f2 = nullptr;
  GA g2 = g;
  int epi = -1;
  const int tok0 = 0, ntok = MT;
  switch (kind) {
    case K_PREP: phase_prep(p, shm); break;
    case K_FFN1:
      g.A = (a == 1 && b == 0) ? (const u16*)(big + BIG_HBALT) : hb;
      g.Bt = (const u16*)(ws + OFF_WIN + (size_t)(a * 2 + b) * SZ_WIN); g.K = 1024; g.N = 5632;
      g.mtiles = MT / 256; g.ntiles = 22; g.ss_in = ss + (size_t)c * MT; g.o0 = (u16*)(big + BIG_ACTB);
      epi = E_SWIGLU; break;
    case K_FFN2:
      g.A = (const u16*)(big + BIG_ACTB); g.Bt = (const u16*)(ws + OFF_WOUT + (size_t)(a * 2 + b) * SZ_WOUT); g.K = DFF; g.N = 1024;
      g.mtiles = MT / 256; g.ntiles = 4; g.ss_out = ss + (size_t)c * MT; g.scale = 0.5f;
      if (a == 0 && b == 0) g.hb = nullptr;
      epi = E_RESID; break;
    case K_MIX: phase_mix(p, tok0, ntok); break;
    case K_RKV:
      g.A = (const u16*)(big + BIG_A2); g.Bt = (const u16*)(ws + OFF_WRKV); g.K = 2048; g.N = 3456;
      g.mtiles = ntok / 256; g.ntiles = 14; g.o0 = (u16*)(big + BIG_RKV); g.o1 = (u16*)(big + BIG_T);
      epi = E_RKV; break;
    case K_SCAN: phase_scan(p, shm); break;
    case K_FIN:
      g.A = (const u16*)(big + BIG_T + 2 * SZ_T1); g.Bt = (const u16*)(ws + OFF_WG2); g.K = 128; g.N = 1024;
      g.mtiles = ntok / 256; g.ntiles = 4;
      g.o0 = (u16*)(big + BIG_Y0); g.o1 = (u16*)(big + BIG_Y1); g.o2 = (u16*)(big + BIG_RKV + 2 * SZ_RKV1);
      g.hb = (u16*)(big + BIG_RKV + SZ_RKV1);
      g.f0 = (const float*)(ws + OFF_BONUS); g.f1 = p.in[25]; g.f2 = p.in[26];
      epi = E_RWFIN; break;
    case K_RWO:
      g.A = (const u16*)(big + BIG_RKV + SZ_RKV1); g.Bt = (const u16*)(ws + OFF_WRWO); g.K = 1024; g.N = 1024;
      g.mtiles = ntok / 256; g.ntiles = 4; g.rowoff = tok0; g.ss_out = ss + (size_t)2 * MT; g.scale = 1.f;
      epi = E_RESID; break;
    case K_PGATE:
      g2 = g;
      g2.A = (const u16*)(ws + OFF_PBI) + (size_t)a * MT * 256; g2.Bt = (const u16*)(ws + OFF_WPP) + (size_t)a * 1024 * 256; g2.K = 256; g2.N = 1024;
      g2.mtiles = MT / 256; g2.ntiles = 4; g2.o0 = (u16*)(big + BIG_PB);
      g.hb = a == 0 ? (u16*)(big + BIG_HBALT) : nullptr;
      g.A = hb; g.Bt = (const u16*)(ws + OFF_WPG) + (size_t)a * 1024 * 1024; g.K = 1024; g.N = 1024;
      g.mtiles = MT / 256; g.ntiles = 4; g.ss_in = ss + (size_t)b * MT; g.ss_out = ss + (size_t)c * MT; g.o0 = (u16*)(big + BIG_PB);
      epi = E_PLEGATE; break;
    case K_QKV:
      g.A = hb; g.Bt = (const u16*)(ws + OFF_WQKV); g.K = 1024; g.N = 3072; g.mtiles = MT / 256; g.ntiles = 12;
      g.ss_in = ss + (size_t)5 * MT; g.bias = p.in[29];
      g.o0 = (u16*)(big + BIG_Q); g.o1 = (u16*)(big + BIG_K); g.o2 = (u16*)(big + BIG_VT);
      epi = E_QKV; break;
    case K_NATT:
#ifdef PROBE_NATT
      phase_natt(p, hb, shm); __syncthreads();
#endif
      phase_natt(p, (u16*)(big + BIG_Q), shm); break;
    case K_NAO:
      g.A = (const u16*)(big + BIG_Q); g.Bt = (const u16*)(ws + OFF_WNAO); g.K = 1024; g.N = 1024; g.mtiles = MT / 256; g.ntiles = 4;
      g.ss_out = ss + (size_t)6 * MT; g.bias = p.in[32]; g.scale = 1.f;
      epi = E_RESID; break;
    case K_FINAL: phase_final(p); break;
    default: break;
  }
  switch (epi) {
    case E_SWIGLU: gemm_phase<E_SWIGLU>(g, g2, shml); break;
    case E_RESID: gemm_phase<E_RESID>(g, g2, shml); break;
    case E_PLEGATE: gemm_phase<E_PLEGATE>(g, g2, shml); break;
    case E_RKV: gemm_phase<E_RKV>(g, g2, shml); break;
    case E_RWFIN: gemm_phase<E_RWFIN>(g, g2, shml); break;
    case E_QKV: gemm_phase<E_QKV>(g, g2, shml); break;
    default: break;
  }
}

__device__ __forceinline__ void grid_barrier(unsigned* bar, unsigned& nbar) {
  asm volatile("s_waitcnt vmcnt(0)" ::: "memory");
  __syncthreads();
  nbar += 1;
  if (otid() == 0) {
    __builtin_amdgcn_s_waitcnt(0);
    __builtin_amdgcn_fence(__ATOMIC_RELEASE, "agent");
    asm volatile("s_waitcnt vmcnt(0)" ::: "memory");
    __hip_atomic_fetch_add(bar, 1u, __ATOMIC_RELAXED, __HIP_MEMORY_SCOPE_AGENT);
    const unsigned target = nbar * gridDim.x;
    while (__hip_atomic_load(bar, __ATOMIC_RELAXED, __HIP_MEMORY_SCOPE_AGENT) < target) __builtin_amdgcn_s_sleep(1);
    __builtin_amdgcn_fence(__ATOMIC_ACQUIRE, "agent");
    asm volatile("s_waitcnt vmcnt(0)" ::: "memory");
  }
  __syncthreads();
}

__global__ void __launch_bounds__(NTHR, 2) fwd_megakernel(Params p, int ph_lo, int ph_hi) {
  __shared__ __attribute__((aligned(1024))) char shm[131072];
  cg::grid_group grid = cg::this_grid();
  unsigned* bar = (unsigned*)(p.ws + OFF_BAR);
  if (blockIdx.x == 0 && otid() == 0) __hip_atomic_store(bar, 0u, __ATOMIC_RELAXED, __HIP_MEMORY_SCOPE_AGENT);
  unsigned nbar = 0;
  for (int ph = ph_lo; ph < ph_hi; ++ph) {
#if PROBE_MASK
    if ((PROBE_MASK >> ph) & 1ull) { run_phase(p, ph, (LDSC*)shm); if (ph == ph_lo) grid.sync(); else grid_barrier(bar, nbar); }
#endif
    run_phase(p, ph, (LDSC*)shm);
    if (ph + 1 < ph_hi) {
      if (ph == ph_lo) grid.sync(); else grid_barrier(bar, nbar);
    }
  }
}

extern "C" void kernel_launch(void* const* d_in, const int* in_sizes, int n_in, void* d_out, int out_size, void* d_ws, size_t ws_size,
                              hipStream_t stream) {
  static int grid_blocks = 0;
  if (!grid_blocks) {
    int dev = 0, cus = 0, per_cu = 0;
    hipGetDevice(&dev);
    hipDeviceGetAttribute(&cus, hipDeviceAttributeMultiprocessorCount, dev);
    hipOccupancyMaxActiveBlocksPerMultiprocessor(&per_cu, fwd_megakernel, NTHR, 0);
    (void)per_cu;
    grid_blocks = 256;
    if (cus < 256) { fprintf(stderr, "device has %d CUs, this kernel needs 256\n", cus); grid_blocks = -1; }
  }
  if (grid_blocks < 0) return;
  if (ws_size < OFF_BIG + BIG_T + 3 * SZ_T1) return;
  Params p{};
  for (int i = 0; i < 33; ++i) p.in[i] = (const float*)d_in[i];
  p.h = (float*)d_out;
  p.ws = (char*)d_ws;
  int lo = 0, hi = NPHASE;
  void* args[] = {&p, &lo, &hi};
  hipError_t e = hipLaunchCooperativeKernel((void*)fwd_megakernel, dim3(grid_blocks), dim3(NTHR), args, 0, stream);
  if (e != hipSuccess) fprintf(stderr, "cooperative launch failed: %s (grid %d)\n", hipGetErrorString(e), grid_blocks);
}
```

```cpp
#include <hip/hip_runtime.h>
#include <hip/hip_cooperative_groups.h>
#include <cstdio>
#include <cstdint>
namespace cg = cooperative_groups;

typedef unsigned short u16;
using bf16x8 = __attribute__((ext_vector_type(8))) short;
using f32x4 = __attribute__((ext_vector_type(4))) float;
using f32x2 = __attribute__((ext_vector_type(2))) float;
using i32x4 = __attribute__((ext_vector_type(4))) int;
typedef __attribute__((address_space(3))) char LDSC;
typedef __attribute__((address_space(3))) unsigned LDSU;
typedef __attribute__((address_space(3))) bf16x8 LDS_BF8;

constexpr int MT = 49152;
constexpr int MPROMPT = 32768;
constexpr int MR = MT;
constexpr int D = 1024;
constexpr int DFF = 2816;
constexpr int NTHR = 512;

constexpr size_t SZ_WIN = (size_t)5632 * 1024 * 2;
constexpr size_t SZ_WOUT = (size_t)1024 * 2816 * 2;
constexpr size_t OFF_WIN = 0;
constexpr size_t OFF_WOUT = OFF_WIN + 4 * SZ_WIN;
constexpr size_t OFF_WPG = OFF_WOUT + 4 * SZ_WOUT;
constexpr size_t OFF_WPP = OFF_WPG + 2 * (size_t)1024 * 1024 * 2;
constexpr size_t OFF_WRKV = OFF_WPP + 2 * (size_t)1024 * 256 * 2;
constexpr size_t OFF_W2W = OFF_WRKV + (size_t)3584 * 2048 * 2;
constexpr size_t OFF_W2A = OFF_W2W + 2 * (size_t)1024 * 64 * 2;
constexpr size_t OFF_WG2 = OFF_W2A + 2 * (size_t)1024 * 64 * 2;
constexpr size_t OFF_WRWO = OFF_WG2 + (size_t)1024 * 128 * 2;
constexpr size_t OFF_WQKV = OFF_WRWO + (size_t)1024 * 1024 * 2;
constexpr size_t OFF_WNAO = OFF_WQKV + (size_t)3072 * 1024 * 2;
constexpr size_t OFF_SS = OFF_WNAO + (size_t)1024 * 1024 * 2;
constexpr size_t OFF_BONUS = OFF_SS + 9 * (size_t)MT * 4;
constexpr size_t OFF_BAR = OFF_BONUS + 2 * (size_t)MR * 16 * 4;
constexpr size_t OFF_HB = OFF_BAR + 256;
constexpr size_t OFF_PBI = OFF_HB + (size_t)MT * 1024 * 2;
constexpr size_t OFF_BIG = OFF_PBI + 2 * (size_t)MT * 256 * 2;
constexpr size_t BIG_ACTB = 0;
constexpr size_t BIG_PB = 0;
constexpr size_t BIG_HBALT = (size_t)MT * 2816 * 2;
constexpr size_t BIG_A2 = 0;
constexpr size_t BIG_Y0 = 0;
constexpr size_t BIG_Y1 = (size_t)MR * 1024 * 2;
constexpr size_t BIG_RKV = (size_t)MR * 2048 * 2;
constexpr size_t SZ_RKV1 = (size_t)MR * 1024 * 2;
constexpr size_t BIG_T = BIG_RKV + 3 * SZ_RKV1;
constexpr size_t SZ_T1 = (size_t)MR * 128 * 2;
constexpr size_t BIG_Q = 0;
constexpr size_t BIG_K = (size_t)MT * 1024 * 2;
constexpr size_t BIG_VT = 2 * (size_t)MT * 1024 * 2;

struct Params {
  const float* in[33];
  float* h;
  char* ws;
};

__device__ __forceinline__ u16 f2bf(float f) {
  unsigned u = __float_as_uint(f);
  u += 0x7fffu + ((u >> 16) & 1u);
  return (u16)(u >> 16);
}
__device__ __forceinline__ float bf2f(u16 h) { return __uint_as_float(((unsigned)h) << 16); }
__device__ __forceinline__ unsigned pack2(float a, float b) { return (unsigned)f2bf(a) | ((unsigned)f2bf(b) << 16); }
__device__ __forceinline__ float sigm(float x) { return __builtin_amdgcn_rcpf(1.f + __expf(-x)); }
template <int CTRL> __device__ __forceinline__ float dppf(float v) {
  return __int_as_float(__builtin_amdgcn_update_dpp(0, __float_as_int(v), CTRL, 0xf, 0xf, true));
}
__device__ __forceinline__ float rowsum16(float v) {
  v += dppf<0xB1>(v);
  v += dppf<0x4E>(v);
  v += dppf<0x141>(v);
  v += dppf<0x140>(v);
  return v;
}
__device__ __forceinline__ int otid() { int t = __builtin_amdgcn_workitem_id_x(); asm volatile("" : "+v"(t)); return t; }
__device__ __forceinline__ float rstd_of(float ss) { return rsqrtf(ss * (1.f / 1024.f) + 1e-6f); }

struct PrepJob {
  const float* src; int K, N, ldsrc;
  u16* dst; int dld, koff, noff;
  const float* sc; int mode;
  int perm;
};

__device__ __forceinline__ void prep_tiles(const PrepJob& j, char* shm, int nblk, int bid) {
  u16* tl = (u16*)shm;
  int kt = j.K >> 6, nt = j.N >> 6, tiles = kt * nt;
  int tid = otid();
  for (int t = bid; t < tiles; t += nblk) {
    int k0 = (t / nt) << 6, n0 = (t % nt) << 6;
#pragma unroll
    for (int it = 0; it < 2; ++it) {
      int kk = (tid >> 4) + 32 * it, nn4 = (tid & 15) * 4;
      float4 v = *(const float4*)(j.src + (size_t)(k0 + kk) * j.ldsrc + n0 + nn4);
      float s = 1.f;
      if (j.mode == 1 || j.mode == 3) s = j.sc[k0 + kk];
      else if (j.mode == 2) s = 1.f - j.sc[k0 + kk];
      tl[(nn4 + 0) * 72 + kk] = f2bf(v.x * s);
      tl[(nn4 + 1) * 72 + kk] = f2bf(v.y * s);
      tl[(nn4 + 2) * 72 + kk] = f2bf(v.z * s);
      tl[(nn4 + 3) * 72 + kk] = f2bf(v.w * s);
    }
    __syncthreads();
    {
      int nn = tid >> 3, kk8 = (tid & 7) * 8;
      int c = n0 + nn, drow;
      if (j.perm) { int half = c / DFF, cp = c % DFF; drow = (cp >> 5) * 64 + half * 32 + (cp & 31); }
      else drow = c;
      i32x4 v = *(const i32x4*)(tl + nn * 72 + kk8);
      *(i32x4*)(j.dst + (size_t)(j.noff + drow) * j.dld + j.koff + k0 + kk8) = v;
    }
    __syncthreads();
  }
}

__device__ __forceinline__ bool prep_is_early(int jj) { return jj == 0 || jj == 4 || (jj >= 12 && jj < 32); }
__device__ __forceinline__ void prep_weights(const Params& p, char* shm, bool early, int nblk, int bid) {
  char* ws = p.ws;
  for (int jj = 0; jj < 36; ++jj) {
    if (prep_is_early(jj) != early) continue;
    PrepJob j; j.mode = 0; j.sc = nullptr; j.perm = 0; j.koff = 0; j.noff = 0;
    if (jj < 4) {
      j.src = p.in[5] + (size_t)jj * 1024 * 5632; j.K = 1024; j.N = 5632; j.ldsrc = 5632;
      j.dst = (u16*)(ws + OFF_WIN + jj * SZ_WIN); j.dld = 1024; j.sc = p.in[4] + jj * 1024; j.mode = 1; j.perm = 1;
    } else if (jj < 8) {
      int q = jj - 4;
      j.src = p.in[6] + (size_t)q * 2816 * 1024; j.K = 2816; j.N = 1024; j.ldsrc = 1024;
      j.dst = (u16*)(ws + OFF_WOUT + q * SZ_WOUT); j.dld = 2816;
    } else if (jj < 10) {
      int q = jj - 8;
      j.src = p.in[9] + (size_t)q * 1024 * 1024; j.K = 1024; j.N = 1024; j.ldsrc = 1024;
      j.dst = (u16*)(ws + OFF_WPG) + (size_t)q * 1024 * 1024; j.dld = 1024; j.sc = p.in[8] + q * 1024; j.mode = 1;
    } else if (jj < 12) {
      int q = jj - 10;
      j.src = p.in[10] + (size_t)q * 256 * 1024; j.K = 256; j.N = 1024; j.ldsrc = 1024;
      j.dst = (u16*)(ws + OFF_WPP) + (size_t)q * 1024 * 256; j.dld = 256;
    } else if (jj < 28) {
      int q = (jj - 12) >> 1, hf = (jj - 12) & 1;
      j.K = 1024; j.dst = (u16*)(ws + OFF_WRKV); j.dld = 2048; j.koff = hf * 1024; j.mode = hf ? 3 : 2;
      if (q < 3) { j.src = p.in[13] + (size_t)q * 1024 * 1024; j.N = 1024; j.ldsrc = 1024; j.noff = q * 1024; j.sc = p.in[12] + q * 1024; }
      else if (q < 5) { int z = q - 3; j.src = p.in[15] + (size_t)z * 1024 * 64; j.N = 64; j.ldsrc = 64; j.noff = 3072 + z * 64; j.sc = p.in[12] + 3 * 1024; }
      else if (q < 7) { int z = q - 5; j.src = p.in[18] + (size_t)z * 1024 * 64; j.N = 64; j.ldsrc = 64; j.noff = 3200 + z * 64; j.sc = p.in[12] + 4 * 1024; }
      else { j.src = p.in[20]; j.N = 128; j.ldsrc = 128; j.noff = 3328; j.sc = p.in[12] + 5 * 1024; }
    } else if (jj < 30) {
      int z = jj - 28;
      j.src = p.in[16] + (size_t)z * 64 * 1024; j.K = 64; j.N = 1024; j.ldsrc = 1024;
      j.dst = (u16*)(ws + OFF_W2W) + (size_t)z * 1024 * 64; j.dld = 64;
    } else if (jj < 32) {
      int z = jj - 30;
      j.src = p.in[19] + (size_t)z * 64 * 1024; j.K = 64; j.N = 1024; j.ldsrc = 1024;
      j.dst = (u16*)(ws + OFF_W2A) + (size_t)z * 1024 * 64; j.dld = 64;
    } else if (jj == 32) {
      j.src = p.in[21]; j.K = 128; j.N = 1024; j.ldsrc = 1024; j.dst = (u16*)(ws + OFF_WG2); j.dld = 128;
    } else if (jj == 33) {
      j.src = p.in[27]; j.K = 1024; j.N = 1024; j.ldsrc = 1024; j.dst = (u16*)(ws + OFF_WRWO); j.dld = 1024;
    } else if (jj == 34) {
      j.src = p.in[28]; j.K = 1024; j.N = 3072; j.ldsrc = 3072; j.dst = (u16*)(ws + OFF_WQKV); j.dld = 1024; j.sc = p.in[7] + 1024; j.mode = 1;
    } else if (jj == 35) {
      j.src = p.in[31]; j.K = 1024; j.N = 1024; j.ldsrc = 1024; j.dst = (u16*)(ws + OFF_WNAO); j.dld = 1024;
    } else continue;
    prep_tiles(j, shm, nblk, bid);
  }
}

__device__ __forceinline__ void phase_prep(const Params& p, char* shm) {
  char* ws = p.ws;
  prep_weights(p, shm, true, gridDim.x, blockIdx.x);
  float* ss = (float*)(ws + OFF_SS);
  u16* hb = (u16*)(ws + OFF_HB);
  int tid = otid(), half = tid >> 8, t4 = (tid & 255) * 4;
  float* red = (float*)shm;
  for (int r0 = blockIdx.x * 2; r0 < MT; r0 += gridDim.x * 2) {
    int row = r0 + half;
    const float* src = row < MPROMPT ? p.in[0] + (size_t)row * D : p.in[1] + (size_t)(row - MPROMPT) * D;
    float4 v = *(const float4*)(src + t4);
    uint2 pk; pk.x = pack2(v.x, v.y); pk.y = pack2(v.z, v.w);
    *(uint2*)(hb + (size_t)row * D + t4) = pk;
    float s = v.x * v.x + v.y * v.y + v.z * v.z + v.w * v.w;
#pragma unroll
    for (int o = 32; o > 0; o >>= 1) s += __shfl_xor(s, o);
    __syncthreads();
    if ((tid & 63) == 0) red[tid >> 6] = s;
    __syncthreads();
    if ((tid & 255) == 0) {
      float tot = red[half * 4] + red[half * 4 + 1] + red[half * 4 + 2] + red[half * 4 + 3];
      ss[row] = tot;
#pragma unroll
      for (int q = 1; q < 9; ++q) ss[(size_t)q * MT + row] = 0.f;
    }
  }
}

__device__ __forceinline__ void conv_p(const Params& p, int layer, int nblk, int bid) {
  u16* pbi = (u16*)(p.ws + OFF_PBI) + (size_t)layer * MT * 256;
  const float* pp = p.in[2] + (size_t)layer * MPROMPT * 256;
  const float* ps = p.in[3] + (size_t)layer * (MT - MPROMPT) * 256;
  size_t n4 = (size_t)MT * 256 / 4;
  for (size_t i = (size_t)bid * NTHR + otid(); i < n4; i += (size_t)nblk * NTHR) {
    size_t e = i * 4;
    const float* s = e < (size_t)MPROMPT * 256 ? pp + e : ps + (e - (size_t)MPROMPT * 256);
    float4 v = *(const float4*)s;
    uint2 pk; pk.x = pack2(v.x, v.y); pk.y = pack2(v.z, v.w);
    *(uint2*)(pbi + e) = pk;
  }
}

__device__ __forceinline__ void conv_h(const Params& p) {
  u16* hb = (u16*)(p.ws + OFF_HB);
  size_t n4 = (size_t)MT * D / 4;
  for (size_t i = (size_t)blockIdx.x * NTHR + otid(); i < n4; i += (size_t)gridDim.x * NTHR) {
    float4 v = *(const float4*)(p.h + i * 4);
    uint2 pk; pk.x = pack2(v.x, v.y); pk.y = pack2(v.z, v.w);
    *(uint2*)(hb + i * 4) = pk;
  }
}

enum { E_SWIGLU = 0, E_RESID = 1, E_PLEPROJ = 2, E_PLEGATE = 3, E_RKV = 4, E_RWFIN = 5, E_QKV = 6 };

struct GA {
  const u16* A; const u16* Bt; int K; int N;
  int mtiles, ntiles;
  int rowoff;
  const float* ss_in; float* ss_out;
  const float* bias; float scale;
  float* h; u16* hb;
  u16* o0; u16* o1; u16* o2;
  const float* f0; const float* f1; const float* f2;
  const float* hin0; const float* hin1;
};

template <int KS> __device__ __forceinline__ int lds_byte(int r, int c) {
  int st = (r >> 4) * KS + (c >> 5), ob = (r & 15) * 64 + (c & 31) * 2;
  return st * 1024 + (ob ^ (((ob >> 9) & 1) << 5));
}
template <int KS> __device__ __forceinline__ void stage_rc(int b, int& R, int& C) {
  int st = b >> 10, sb = b & 1023, swz = sb ^ (((sb >> 9) & 1) << 5);
  R = (st / KS) * 16 + swz / 64;
  C = (st % KS) * 32 + (swz % 64) / 2;
}

template <int EPI>
__device__ __forceinline__ void gemm_tile(const GA& g, int pm, int pn, bool prefetched, bool has_next, int pm_next, int pn_next, LDSC* shm) {
  constexpr int BK = 64, KS = 2, TILE_B = 256 * BK * 2, GL = 4, STAGE_B = 2 * TILE_B;
  const int K = g.K;
  const int tid = otid(), wid = tid >> 6, lane = tid & 63, wr = wid >> 2, wc = wid & 3, fr = lane & 15, fq = lane >> 4;
  const int brow = pm * 256, bcol = pn * 256;
  const u16* Ab = g.A + (size_t)brow * K;
  const u16* Bb = g.Bt + (size_t)bcol * K;
  const u16* Abn = g.A + (size_t)(pm_next * 256) * K;
  const u16* Bbn = g.Bt + (size_t)(pn_next * 256) * K;
  int sO[GL];
#pragma unroll
  for (int i = 0; i < GL; ++i) { int r_, c_; stage_rc<KS>(wid * 1024 + i * 8192 + lane * 16, r_, c_); sO[i] = r_ * K + c_; }
  f32x4 acc[8][4];
#pragma unroll
  for (int m = 0; m < 8; ++m)
#pragma unroll
    for (int n = 0; n < 4; ++n) acc[m][n] = f32x4{0.f, 0.f, 0.f, 0.f};
  const int nt = K / BK;
#define G_STAGE(buf, AB_, BB_, kt) do { _Pragma("unroll") for (int i = 0; i < GL; ++i) { \
    __builtin_amdgcn_global_load_lds((const unsigned*)((AB_) + (kt) * BK + sO[i]), (LDSU*)(shm + (buf) * STAGE_B + wid * 1024 + i * 8192), 16, 0, 0); \
    __builtin_amdgcn_global_load_lds((const unsigned*)((BB_) + (kt) * BK + sO[i]), (LDSU*)(shm + (buf) * STAGE_B + TILE_B + wid * 1024 + i * 8192), 16, 0, 0); } } while (0)
#define G_STAGE_H(hh, buf, AB_, BB_, kt) do { _Pragma("unroll") for (int i = (hh) * 2; i < (hh) * 2 + 2; ++i) { \
    __builtin_amdgcn_global_load_lds((const unsigned*)((AB_) + (kt) * BK + sO[i]), (LDSU*)(shm + (buf) * STAGE_B + wid * 1024 + i * 8192), 16, 0, 0); \
    __builtin_amdgcn_global_load_lds((const unsigned*)((BB_) + (kt) * BK + sO[i]), (LDSU*)(shm + (buf) * STAGE_B + TILE_B + wid * 1024 + i * 8192), 16, 0, 0); } } while (0)
  if (!prefetched) G_STAGE(0, Ab, Bb, 0);
  asm volatile("s_waitcnt vmcnt(0)" ::: "memory");
  __syncthreads();
  for (int t = 0; t < nt; ++t) {
    int cur = t & 1;
    if (t + 1 < nt) G_STAGE_H(0, cur ^ 1, Ab, Bb, t + 1);
    else if (has_next) G_STAGE_H(0, 0, Abn, Bbn, 0);
    const LDSC* SAp = shm + cur * STAGE_B;
    const LDSC* SBp = SAp + TILE_B;
#pragma unroll
    for (int ks = 0; ks < KS; ++ks) {
      if (ks == 1) {
        if (t + 1 < nt) G_STAGE_H(1, cur ^ 1, Ab, Bb, t + 1);
        else if (has_next) G_STAGE_H(1, 0, Abn, Bbn, 0);
      }
      bf16x8 At[8], Bf[4];
#pragma unroll
      for (int m = 0; m < 8; ++m) At[m] = *(const LDS_BF8*)(SAp + lds_byte<KS>(wr * 128 + m * 16 + fr, ks * 32 + fq * 8));
#pragma unroll
      for (int n = 0; n < 4; ++n) Bf[n] = *(const LDS_BF8*)(SBp + lds_byte<KS>(wc * 64 + n * 16 + fr, ks * 32 + fq * 8));
      __builtin_amdgcn_s_setprio(1);
#pragma unroll
      for (int m = 0; m < 8; ++m)
#pragma unroll
        for (int n = 0; n < 4; ++n) acc[m][n] = __builtin_amdgcn_mfma_f32_16x16x32_bf16(At[m], Bf[n], acc[m][n], 0, 0, 0);
      __builtin_amdgcn_s_setprio(0);
      __builtin_amdgcn_sched_barrier(0);
    }
    if (t + 1 < nt) asm volatile("s_waitcnt vmcnt(0)" ::: "memory");
    __syncthreads();
  }
#undef G_STAGE
#undef G_STAGE_H
  typedef __attribute__((address_space(3))) float LDSF;
  typedef __attribute__((address_space(3))) f32x4 LDSF4;
  LDSF* scr = (LDSF*)(shm + STAGE_B + wid * 4352);
  const int cb = bcol + wc * 64;
#define SLAB_WRITE(m) do { _Pragma("unroll") for (int n = 0; n < 4; ++n) _Pragma("unroll") for (int j = 0; j < 4; ++j) \
    scr[(fq * 4 + j) * 68 + n * 16 + fr] = acc[m][n][j]; asm volatile("s_waitcnt lgkmcnt(0)" ::: "memory"); } while (0)
#define SLAB_DONE() asm volatile("s_waitcnt lgkmcnt(0)" ::: "memory")
  if constexpr (EPI == E_SWIGLU) {
    const int l8 = lane & 7, r8 = lane >> 3;
    float ssv[8][2];
#pragma unroll
    for (int m = 0; m < 8; ++m)
#pragma unroll
      for (int k = 0; k < 2; ++k) ssv[m][k] = g.ss_in[g.rowoff + brow + wr * 128 + m * 16 + k * 8 + r8];
#pragma unroll
    for (int m = 0; m < 8; ++m) {
      SLAB_WRITE(m);
#pragma unroll
      for (int k = 0; k < 2; ++k) {
        int rl = k * 8 + r8, row = brow + wr * 128 + m * 16 + rl;
        f32x4 gt = *(const LDSF4*)(scr + rl * 68 + l8 * 4), up = *(const LDSF4*)(scr + rl * 68 + 32 + l8 * 4);
        float rs = rstd_of(ssv[m][k]);
        float o[4];
#pragma unroll
        for (int e = 0; e < 4; ++e) { float a = gt[e] * rs; o[e] = a * sigm(a) * (up[e] * rs); }
        uint2 pk; pk.x = pack2(o[0], o[1]); pk.y = pack2(o[2], o[3]);
        *(uint2*)(g.o0 + (size_t)row * DFF + (cb >> 1) + l8 * 4) = pk;
      }
      SLAB_DONE();
    }
  } else if constexpr (EPI == E_QKV) {
    const int which = cb >> 10, c0 = cb & 1023;
    if (which == 2) {
#pragma unroll
      for (int m = 0; m < 8; ++m) {
        int row0 = brow + wr * 128 + m * 16 + fq * 4;
        float rs[4];
#pragma unroll
        for (int j = 0; j < 4; ++j) rs[j] = rstd_of(g.ss_in[row0 + j]);
#pragma unroll
        for (int n = 0; n < 4; ++n) {
          int col = c0 + n * 16 + fr;
          float b = g.bias[cb + n * 16 + fr];
          uint2 pk; pk.x = pack2(acc[m][n][0] * rs[0] + b, acc[m][n][1] * rs[1] + b); pk.y = pack2(acc[m][n][2] * rs[2] + b, acc[m][n][3] * rs[3] + b);
          *(uint2*)(g.o2 + (size_t)col * MT + row0) = pk;
        }
      }
    } else {
      u16* dst = which == 0 ? g.o0 : g.o1;
      const float sc = which == 0 ? 0.17677669529663687f : 1.f;
      f32x4 b4 = *(const f32x4*)(g.bias + cb + fr * 4);
      float ssq[8][4];
#pragma unroll
      for (int m = 0; m < 8; ++m)
#pragma unroll
        for (int k = 0; k < 4; ++k) ssq[m][k] = g.ss_in[brow + wr * 128 + m * 16 + k * 4 + fq];
#pragma unroll
      for (int m = 0; m < 8; ++m) {
        SLAB_WRITE(m);
#pragma unroll
        for (int k = 0; k < 4; ++k) {
          int rl = k * 4 + fq, row = brow + wr * 128 + m * 16 + rl;
          f32x4 v = *(const LDSF4*)(scr + rl * 68 + fr * 4);
          float rs = rstd_of(ssq[m][k]);
          uint2 pk; pk.x = pack2((v[0] * rs + b4[0]) * sc, (v[1] * rs + b4[1]) * sc); pk.y = pack2((v[2] * rs + b4[2]) * sc, (v[3] * rs + b4[3]) * sc);
          *(uint2*)(dst + (size_t)row * D + c0 + fr * 4) = pk;
        }
        SLAB_DONE();
      }
    }
  } else {
    float lw[4] = {0.f, 0.f, 0.f, 0.f}, lb[4] = {0.f, 0.f, 0.f, 0.f}, bs[4] = {0.f, 0.f, 0.f, 0.f};
    if constexpr (EPI == E_RWFIN) {
#pragma unroll
      for (int e = 0; e < 4; ++e) { lw[e] = g.f1[cb + fr * 4 + e]; lb[e] = g.f2[cb + fr * 4 + e]; }
    }
    if constexpr (EPI == E_RESID) {
      if (g.bias) {
#pragma unroll
        for (int e = 0; e < 4; ++e) bs[e] = g.bias[cb + fr * 4 + e];
      }
    }
    f32x4 h_n[4]; uint2 a_n[4]; float f_n[4][2];
    const float* hrd = g.hin0 ? ((g.rowoff + brow) < MPROMPT ? g.hin0 : g.hin1 - (size_t)MPROMPT * D) : g.h;
#define EPI_LOAD(m_) do { _Pragma("unroll") for (int k = 0; k < 4; ++k) { \
      const int row_ = brow + wr * 128 + (m_) * 16 + k * 4 + fq, col_ = cb + fr * 4; \
      if constexpr (EPI == E_RESID || EPI == E_PLEGATE) h_n[k] = *(const f32x4*)(hrd + (size_t)(g.rowoff + row_) * D + col_); \
      if constexpr (EPI == E_PLEGATE) { a_n[k] = *(const uint2*)(g.o0 + (size_t)(g.rowoff + row_) * D + col_); f_n[k][0] = g.ss_in[g.rowoff + row_]; } \
      } } while (0)
    f32x4 h_m[4]; uint2 a_m[4]; float f_m[4][2];
    EPI_LOAD(0);
#pragma unroll
    for (int k = 0; k < 4; ++k) { h_m[k] = h_n[k]; a_m[k] = a_n[k]; f_m[k][0] = f_n[k][0]; }
    EPI_LOAD(1);
#pragma unroll
    for (int m = 0; m < 8; ++m) {
      f32x4 h_c[4]; uint2 a_c[4]; float f_c[4][2];
#pragma unroll
      for (int k = 0; k < 4; ++k) { h_c[k] = h_m[k]; a_c[k] = a_m[k]; f_c[k][0] = f_m[k][0];
                                    h_m[k] = h_n[k]; a_m[k] = a_n[k]; f_m[k][0] = f_n[k][0]; }
      if (m + 2 < 8) EPI_LOAD(m + 2);
      uint2 fy0[4], fy1[4], fvv[4]; float fbn[4];
      if constexpr (EPI == E_RWFIN) {
#pragma unroll
        for (int k = 0; k < 4; ++k) {
          const int row_ = brow + wr * 128 + m * 16 + k * 4 + fq;
          const size_t idx_ = (size_t)row_ * D + cb + fr * 4;
          fy0[k] = *(const uint2*)(g.o0 + idx_); fy1[k] = *(const uint2*)(g.o1 + idx_); fvv[k] = *(const uint2*)(g.o2 + idx_);
          fbn[k] = g.f0[(size_t)row_ * 16 + (cb >> 6)] + g.f0[(size_t)MR * 16 + (size_t)row_ * 16 + (cb >> 6)];
        }
      }
      SLAB_WRITE(m);
#pragma unroll
      for (int k = 0; k < 4; ++k) {
        const int rl = k * 4 + fq, row = brow + wr * 128 + m * 16 + rl;
        const int col = cb + fr * 4;
        f32x4 v = *(const LDSF4*)(scr + rl * 68 + fr * 4);
        if constexpr (EPI == E_RESID || EPI == E_PLEGATE) {
          size_t grow = (size_t)(g.rowoff + row);
          float* hp = g.h + grow * D + col;
          f32x4 hv = h_c[k];
          if constexpr (EPI == E_PLEGATE) {
            float rs = rstd_of(f_c[k][0]);
            uint2 pb = a_c[k];
            hv[0] += sigm(v[0] * rs) * bf2f((u16)(pb.x & 0xffff));
            hv[1] += sigm(v[1] * rs) * bf2f((u16)(pb.x >> 16));
            hv[2] += sigm(v[2] * rs) * bf2f((u16)(pb.y & 0xffff));
            hv[3] += sigm(v[3] * rs) * bf2f((u16)(pb.y >> 16));
          } else {
#pragma unroll
            for (int e = 0; e < 4; ++e) hv[e] += g.scale * v[e] + bs[e];
          }
          *(f32x4*)hp = hv;
          if (g.hb != nullptr) {
            uint2 pk; pk.x = pack2(hv[0], hv[1]); pk.y = pack2(hv[2], hv[3]);
            *(uint2*)(g.hb + grow * D + col) = pk;
          }
          float sq = rowsum16(hv[0] * hv[0] + hv[1] * hv[1] + hv[2] * hv[2] + hv[3] * hv[3]);
          if (fr == 0) atomicAdd(g.ss_out + grow, sq);
        } else if constexpr (EPI == E_PLEPROJ) {
          uint2 pk; pk.x = pack2(v[0], v[1]); pk.y = pack2(v[2], v[3]);
          *(uint2*)(g.o0 + (size_t)row * D + col) = pk;
        } else if constexpr (EPI == E_RKV) {
          if (cb < 3072) {
            u16* buf = g.o0 + (size_t)(cb >> 10) * ((size_t)MR * 1024);
            uint2 pk; pk.x = pack2(v[0], v[1]); pk.y = pack2(v[2], v[3]);
            *(uint2*)(buf + (size_t)row * D + (cb & 1023) + fr * 4) = pk;
          } else if (cb < 3456) {
            int which = (cb - 3072) >> 7, c0 = (cb - 3072) & 127;
            u16* buf = g.o1 + (size_t)which * ((size_t)MR * 128);
            if (which == 0) { v[0] = tanhf(v[0]); v[1] = tanhf(v[1]); v[2] = tanhf(v[2]); v[3] = tanhf(v[3]); }
            else if (which == 2) { v[0] = sigm(v[0]); v[1] = sigm(v[1]); v[2] = sigm(v[2]); v[3] = sigm(v[3]); }
            uint2 pk; pk.x = pack2(v[0], v[1]); pk.y = pack2(v[2], v[3]);
            *(uint2*)(buf + (size_t)row * 128 + c0 + fr * 4) = pk;
          }
        } else if constexpr (EPI == E_RWFIN) {
          const int head = cb >> 6;
          size_t idx = (size_t)row * D + col;
          uint2 a0 = fy0[k], a1 = fy1[k], vv = fvv[k];
          float y[4];
          y[0] = bf2f((u16)(a0.x & 0xffff)) + bf2f((u16)(a1.x & 0xffff));
          y[1] = bf2f((u16)(a0.x >> 16)) + bf2f((u16)(a1.x >> 16));
          y[2] = bf2f((u16)(a0.y & 0xffff)) + bf2f((u16)(a1.y & 0xffff));
          y[3] = bf2f((u16)(a0.y >> 16)) + bf2f((u16)(a1.y >> 16));
          float mean = rowsum16(y[0] + y[1] + y[2] + y[3]) * (1.f / 64.f);
#pragma unroll
          for (int e = 0; e < 4; ++e) y[e] -= mean;
          float inv = rsqrtf(rowsum16(y[0] * y[0] + y[1] * y[1] + y[2] * y[2] + y[3] * y[3]) * (1.f / 64.f) + 64e-5f);
          float bon = fbn[k];
          float vf[4] = {bf2f((u16)(vv.x & 0xffff)), bf2f((u16)(vv.x >> 16)), bf2f((u16)(vv.y & 0xffff)), bf2f((u16)(vv.y >> 16))};
          float o[4];
#pragma unroll
          for (int e = 0; e < 4; ++e) o[e] = (y[e] * inv * lw[e] + lb[e] + bon * vf[e]) * v[e];
          uint2 pk; pk.x = pack2(o[0], o[1]); pk.y = pack2(o[2], o[3]);
          *(uint2*)(g.hb + idx) = pk;
        }
      }
      SLAB_DONE();
    }
  }
#undef SLAB_WRITE
#undef EPI_LOAD
#undef SLAB_DONE
}

template <int EPI> __device__ __forceinline__ void gemm_phase(const GA& g, const GA& g2, LDSC* shm) {
  const int nM = g.mtiles, nN = g.ntiles;
  const int G = gridDim.x;
  const int PN = (nN & 3) == 0 ? 4 : 2, PM = 32 / PN;
  const int sN = nN / PN, sM = nM / PM, nsup = sN * sM;
  const int per = G >> 8;
  const int b = blockIdx.x, x = b & 7, l = (b >> 3) & 31, rep = b >> 8;
  bool pref = false;
  for (int s = x + 8 * rep; s < nsup; s += 8 * per) {
    int sm = s / sN, sn = s % sN;
    int pm = sm * PM + (l % PM), pn = sn * PN + (l / PM);
    int s2 = s + 8 * per;
    bool hn = s2 < nsup;
    int pm2 = (s2 / sN) * PM + (l % PM), pn2 = (s2 % sN) * PN + (l / PM);
    if constexpr (EPI == E_PLEGATE) {
      gemm_tile<E_PLEPROJ>(g2, pm, pn, false, false, pm, pn, shm);
      gemm_tile<E_PLEGATE>(g, pm, pn, false, false, pm, pn, shm);
    } else {
      gemm_tile<EPI>(g, pm, pn, pref, hn, hn ? pm2 : pm, hn ? pn2 : pn, shm);
      pref = hn;
    }
  }
  __syncthreads();
}

__device__ __forceinline__ void phase_mix(const Params& p, int tok0, int ntok) {
  const float* ss1 = (const float*)(p.ws + OFF_SS) + (size_t)1 * MT;
  const float* gain = p.in[7];
  u16* A2 = (u16*)(p.ws + OFF_BIG + BIG_A2);
  int tid = otid(), half = tid >> 8, c4 = (tid & 255) * 4;
  float4 gn = *(const float4*)(gain + c4);
  for (int l0 = blockIdx.x * 2; l0 < ntok; l0 += gridDim.x * 2) {
    int l = l0 + half, tok = tok0 + l;
    int pos, T;
    if (tok < MPROMPT) { pos = tok & 2047; T = 2048; } else { pos = tok - MPROMPT; T = 16384; }
    float4 c = *(const float4*)(p.h + (size_t)tok * D + c4);
    float rc = rstd_of(ss1[tok]);
    float4 hn = {c.x * rc * gn.x, c.y * rc * gn.y, c.z * rc * gn.z, c.w * rc * gn.w};
    float4 av = {0.f, 0.f, 0.f, 0.f};
    if (pos > 0) {
      float4 q = *(const float4*)(p.h + (size_t)(tok - 1) * D + c4);
      float r = rstd_of(ss1[tok - 1]);
      av.x += q.x * r * gn.x; av.y += q.y * r * gn.y; av.z += q.z * r * gn.z; av.w += q.w * r * gn.w;
    }
    if (pos < T - 1) {
      float4 q = *(const float4*)(p.h + (size_t)(tok + 1) * D + c4);
      float r = rstd_of(ss1[tok + 1]);
      av.x += q.x * r * gn.x; av.y += q.y * r * gn.y; av.z += q.z * r * gn.z; av.w += q.w * r * gn.w;
    }
    uint2 a, b;
    a.x = pack2(hn.x, hn.y); a.y = pack2(hn.z, hn.w);
    b.x = pack2(0.5f * av.x, 0.5f * av.y); b.y = pack2(0.5f * av.z, 0.5f * av.w);
    *(uint2*)(A2 + (size_t)l * 2048 + c4) = a;
    *(uint2*)(A2 + (size_t)l * 2048 + 1024 + c4) = b;
  }
}

constexpr int SC_T = 32;
constexpr int SC_ARR = SC_T * 64 * 4;
constexpr int SC_BUF = 6 * SC_ARR;
template <int E> __device__ __forceinline__ float rowsumL(float v) {
  v += dppf<0xB1>(v); v += dppf<0x4E>(v); v += dppf<0x141>(v);
  if (E == 4) v += dppf<0x140>(v);
  return v;
}

template <int E, int R = 1>
__device__ __forceinline__ void scan_item(const Params& p, int seq_loc0, int T, int head, int z, int rowbase, int nw, char* shm) {
  char* big = p.ws + OFF_BIG;
  const u16* Rb = (const u16*)(big + BIG_RKV);
  const u16* Kb = (const u16*)(big + BIG_RKV + SZ_RKV1);
  const u16* Vb = (const u16*)(big + BIG_RKV + 2 * SZ_RKV1);
  const u16* TW = (const u16*)(big + BIG_T);
  const u16* TA = (const u16*)(big + BIG_T + SZ_T1);
  u16* Y = (u16*)(big + (z ? BIG_Y1 : BIG_Y0));
  float* bonus = (float*)(p.ws + OFF_BONUS) + (size_t)z * MR * 16;
  const u16* W2 = (const u16*)(p.ws + OFF_W2W) + (size_t)z * 1024 * 64;
  const u16* A2w = (const u16*)(p.ws + OFF_W2A) + (size_t)z * 1024 * 64;
  const float* w0 = p.in[14] + z * 1024 + head * 64;
  const float* a0 = p.in[17] + z * 1024 + head * 64;
  const int tid = otid(), wv = tid >> 6, lane = tid & 63, fr = lane & 15, fq = lane >> 4;
  float* Ybuf = (float*)(shm + 2 * SC_BUF);
  const int si = tid >> 4, ec4 = (tid & 15) * 4;
  float4 ckk = *(const float4*)(p.in[22] + head * 64 + ec4);
  float4 cka = *(const float4*)(p.in[23] + head * 64 + ec4);
  float4 crk = *(const float4*)(p.in[24] + head * 64 + ec4);
  const int mt = wv >> 2, ntl = wv & 3;
  bf16x8 Bw[2], Ba[2];
#pragma unroll
  for (int ks = 0; ks < 2; ++ks) {
    Bw[ks] = *(const bf16x8*)(W2 + (size_t)(head * 64 + ntl * 16 + fr) * 64 + ks * 32 + fq * 8);
    Ba[ks] = *(const bf16x8*)(A2w + (size_t)(head * 64 + ntl * 16 + fr) * 64 + ks * 32 + fq * 8);
  }
  const float w0c = w0[ntl * 16 + fr], a0c = a0[ntl * 16 + fr];
  constexpr int LPR = 64 / E, RPW = R * (64 / LPR), NP = E / 2, NQ = E / 4;
  const int le = lane % LPR, row0 = rowbase + wv * RPW + (lane / LPR) * R;
  f32x2 st[R][NP];
#pragma unroll
  for (int r = 0; r < R; ++r)
#pragma unroll
    for (int q = 0; q < NP; ++q) st[r][q] = f32x2{0.f, 0.f};
  float skc = 0.f, sklast = 0.f;
  f32x2 ulast0 = {0.f, 0.f}, ulast1 = {0.f, 0.f};
  f32x4 kalast = {0.f, 0.f, 0.f, 0.f};
  const int nch = T / SC_T;
  uint2 pr, pk, pv; bf16x8 Aw[2], Aa[2];
  auto tok_of = [&](int t) { return seq_loc0 + (z ? (T - 1 - t) : t); };
#define SC_LOAD(c) do { \
    int tk_ = tok_of((c) * SC_T + si); \
    pr = *(const uint2*)(Rb + (size_t)tk_ * D + head * 64 + ec4); \
    pk = *(const uint2*)(Kb + (size_t)tk_ * D + head * 64 + ec4); \
    pv = *(const uint2*)(Vb + (size_t)tk_ * D + head * 64 + ec4); \
    int tm_ = tok_of((c) * SC_T + mt * 16 + fr); \
    _Pragma("unroll") for (int ks = 0; ks < 2; ++ks) { \
      Aw[ks] = *(const bf16x8*)(TW + (size_t)tm_ * 128 + z * 64 + ks * 32 + fq * 8); \
      Aa[ks] = *(const bf16x8*)(TA + (size_t)tm_ * 128 + z * 64 + ks * 32 + fq * 8); } } while (0)
#define SC_LORA(b) do { \
    f32x4 cw = {0.f, 0.f, 0.f, 0.f}, ca = {0.f, 0.f, 0.f, 0.f}; \
    _Pragma("unroll") for (int ks = 0; ks < 2; ++ks) { \
      cw = __builtin_amdgcn_mfma_f32_16x16x32_bf16(Aw[ks], Bw[ks], cw, 0, 0, 0); \
      ca = __builtin_amdgcn_mfma_f32_16x16x32_bf16(Aa[ks], Ba[ks], ca, 0, 0, 0); } \
    float* Wl_ = (float*)(shm + (b) * SC_BUF); float* Al_ = (float*)(shm + (b) * SC_BUF + 3 * SC_ARR); \
    _Pragma("unroll") for (int j = 0; j < 4; ++j) { \
      int st_ = mt * 16 + fq * 4 + j; \
      Wl_[st_ * 64 + ntl * 16 + fr] = __expf(-0.6065306597126334f * sigm(w0c + cw[j])); \
      Al_[st_ * 64 + ntl * 16 + fr] = sigm(a0c + ca[j]); } } while (0)
#define SC_ELEM(b, c) do { \
    char* bb_ = shm + (b) * SC_BUF; \
    float4 a4 = *(const float4*)(bb_ + 3 * SC_ARR + (si * 64 + ec4) * 4); \
    float r0 = bf2f((u16)(pr.x & 0xffff)), r1 = bf2f((u16)(pr.x >> 16)), r2 = bf2f((u16)(pr.y & 0xffff)), r3 = bf2f((u16)(pr.y >> 16)); \
    float k0 = bf2f((u16)(pk.x & 0xffff)), k1 = bf2f((u16)(pk.x >> 16)), k2 = bf2f((u16)(pk.y & 0xffff)), k3 = bf2f((u16)(pk.y >> 16)); \
    float v0 = bf2f((u16)(pv.x & 0xffff)), v1 = bf2f((u16)(pv.x >> 16)), v2 = bf2f((u16)(pv.y & 0xffff)), v3 = bf2f((u16)(pv.y >> 16)); \
    float q0 = k0 * ckk.x, q1 = k1 * ckk.y, q2 = k2 * ckk.z, q3 = k3 * ckk.w; \
    float n2 = rowsum16(q0 * q0 + q1 * q1 + q2 * q2 + q3 * q3); \
    float inv_ = rsqrtf(fmaxf(n2, 1e-24f)); \
    q0 *= inv_; q1 *= inv_; q2 *= inv_; q3 *= inv_; \
    float d0 = k0 * (1.f + (a4.x - 1.f) * cka.x), d1 = k1 * (1.f + (a4.y - 1.f) * cka.y), d2 = k2 * (1.f + (a4.z - 1.f) * cka.z), d3 = k3 * (1.f + (a4.w - 1.f) * cka.w); \
    float bn = rowsum16(r0 * d0 * crk.x + r1 * d1 * crk.y + r2 * d2 * crk.z + r3 * d3 * crk.w); \
    if (rowbase == 0 && (tid & 15) == 0) bonus[(size_t)tok_of((c) * SC_T + si) * 16 + head] = bn; \
    *(float4*)(bb_ + 1 * SC_ARR + (si * 64 + ec4) * 4) = float4{q0, q1, q2, q3}; \
    *(float4*)(bb_ + 2 * SC_ARR + (si * 64 + ec4) * 4) = float4{d0, d1, d2, d3}; \
    *(float4*)(bb_ + 3 * SC_ARR + (si * 64 + ec4) * 4) = float4{q0 * a4.x, q1 * a4.y, q2 * a4.z, q3 * a4.w}; \
    *(float4*)(bb_ + 4 * SC_ARR + (si * 64 + ec4) * 4) = float4{r0, r1, r2, r3}; \
    *(float4*)(bb_ + 5 * SC_ARR + (si * 64 + ec4) * 4) = float4{v0, v1, v2, v3}; } while (0)

  __syncthreads();
  SC_LOAD(0);
  SC_LORA(0);
  __syncthreads();
  SC_ELEM(0, 0);
  __syncthreads();
  for (int c = 0; c < nch; ++c) {
    const int b = c & 1;
    if (c + 1 < nch) SC_LOAD(c + 1);
    const char* bb = shm + b * SC_BUF;
    if (wv < nw) {
      f32x4 cw[NQ], ckq[NQ], ckd[NQ], cka4[NQ], cr[NQ]; float vv[R];
#define SC_LD(i_, W_, KK_, KD_, KA_, R_, V_) do { _Pragma("unroll") for (int q = 0; q < NQ; ++q) { \
        W_[q] = *(const f32x4*)(bb + 0 * SC_ARR + ((i_) * 64 + le * E + q * 4) * 4); \
        KK_[q] = *(const f32x4*)(bb + 1 * SC_ARR + ((i_) * 64 + le * E + q * 4) * 4); \
        KD_[q] = *(const f32x4*)(bb + 2 * SC_ARR + ((i_) * 64 + le * E + q * 4) * 4); \
        KA_[q] = *(const f32x4*)(bb + 3 * SC_ARR + ((i_) * 64 + le * E + q * 4) * 4); \
        R_[q] = *(const f32x4*)(bb + 4 * SC_ARR + ((i_) * 64 + le * E + q * 4) * 4); } \
        _Pragma("unroll") for (int r = 0; r < R; ++r) V_[r] = *(const float*)(bb + 5 * SC_ARR + ((i_) * 64 + row0 + r) * 4); } while (0)
      SC_LD(0, cw, ckq, ckd, cka4, cr, vv);
      f32x4 mw_[NQ], mkq[NQ], mkd[NQ], mka[NQ], mr[NQ]; float mvv[R];
      if constexpr (E == 4) {
        SC_LD(1, mw_, mkq, mkd, mka, mr, mvv);
        f32x2 pu = ulast0 * ckq[0].lo + ulast1 * ckq[0].hi;
        f32x2 pc = kalast.lo * ckq[0].lo + kalast.hi * ckq[0].hi;
        skc = rowsumL<E>(pu.x + pu.y) - sklast * rowsumL<E>(pc.x + pc.y);
      }
#pragma unroll 8
      for (int i = 0; i < SC_T; ++i) {
        f32x4 nw_[NQ], nkq[NQ], nkd[NQ], nka[NQ], nr[NQ]; float nvv[R];
        const int in_ = (i + (E == 4 ? 2 : 1)) & (SC_T - 1);
        SC_LD(in_, nw_, nkq, nkd, nka, nr, nvv);
        float sk[R], yy[R];
        f32x2 uq[R][NP];
        if constexpr (E == 4) {
          f32x2 u0 = st[0][0] * cw[0].lo + ckd[0].lo * vv[0];
          f32x2 u1 = st[0][1] * cw[0].hi + ckd[0].hi * vv[0];
          st[0][0] = u0 - cka4[0].lo * skc;
          st[0][1] = u1 - cka4[0].hi * skc;
          f32x2 pu = u0 * mkq[0].lo + u1 * mkq[0].hi;
          f32x2 pc = cka4[0].lo * mkq[0].lo + cka4[0].hi * mkq[0].hi;
          const float rr_ = rowsumL<E>(pu.x + pu.y), cc_ = rowsumL<E>(pc.x + pc.y);
          ulast0 = u0; ulast1 = u1; kalast = cka4[0]; sklast = skc;
          skc = rr_ - skc * cc_;
          f32x2 ya = st[0][0] * cr[0].lo + st[0][1] * cr[0].hi;
          yy[0] = ya.x + ya.y;
        } else {
#pragma unroll
        for (int r = 0; r < R; ++r) {
          f32x2 da = st[r][0] * ckq[0].lo;
#pragma unroll
          for (int q = 1; q < NP; ++q) da += st[r][q] * ((q & 1) ? ckq[q >> 1].hi : ckq[q >> 1].lo);
#pragma unroll
          for (int q = 0; q < NP; ++q) {
            f32x2 kdq = (q & 1) ? ckd[q >> 1].hi : ckd[q >> 1].lo;
            f32x2 wq = (q & 1) ? cw[q >> 1].hi : cw[q >> 1].lo;
            uq[r][q] = st[r][q] * wq + kdq * vv[r];
          }
          sk[r] = da.x + da.y;
        }
#pragma unroll
        for (int r = 0; r < R; ++r) sk[r] = rowsumL<E>(sk[r]);
#pragma unroll
        for (int r = 0; r < R; ++r) {
#pragma unroll
          for (int q = 0; q < NP; ++q) {
            f32x2 kaq = (q & 1) ? cka4[q >> 1].hi : cka4[q >> 1].lo;
            st[r][q] = uq[r][q] - kaq * sk[r];
          }
          f32x2 ya = st[r][0] * cr[0].lo;
#pragma unroll
          for (int q = 1; q < NP; ++q) ya += st[r][q] * ((q & 1) ? cr[q >> 1].hi : cr[q >> 1].lo);
          yy[r] = ya.x + ya.y;
        }
        }
#pragma unroll
        for (int r = 0; r < R; ++r) yy[r] = rowsumL<E>(yy[r]);
        if (le == 0) {
#pragma unroll
          for (int r = 0; r < R; ++r) Ybuf[i * 64 + row0 + r] = yy[r];
        }
        if constexpr (E == 4) {
#pragma unroll
          for (int q = 0; q < NQ; ++q) { cw[q] = mw_[q]; ckq[q] = mkq[q]; ckd[q] = mkd[q]; cka4[q] = mka[q]; cr[q] = mr[q];
                                         mw_[q] = nw_[q]; mkq[q] = nkq[q]; mkd[q] = nkd[q]; mka[q] = nka[q]; mr[q] = nr[q]; }
#pragma unroll
          for (int r = 0; r < R; ++r) { vv[r] = mvv[r]; mvv[r] = nvv[r]; }
        } else {
#pragma unroll
          for (int q = 0; q < NQ; ++q) { cw[q] = nw_[q]; ckq[q] = nkq[q]; ckd[q] = nkd[q]; cka4[q] = nka[q]; cr[q] = nr[q]; }
#pragma unroll
          for (int r = 0; r < R; ++r) vv[r] = nvv[r];
        }
      }
#undef SC_LD
    }
    if (c + 1 < nch) SC_LORA(b ^ 1);
    __syncthreads();
    if (c + 1 < nch) SC_ELEM(b ^ 1, c + 1);
    {
      int tk = tok_of(c * SC_T + si);
      int rr = (tid & 15) * 4;
      if (rr >= rowbase && rr < rowbase + nw * RPW) {
        float4 yv = *(const float4*)(Ybuf + si * 64 + rr);
        uint2 pk2; pk2.x = pack2(yv.x, yv.y); pk2.y = pack2(yv.z, yv.w);
        *(uint2*)(Y + (size_t)tk * D + head * 64 + rr) = pk2;
      }
    }
    __syncthreads();
  }
#undef SC_LOAD
#undef SC_LORA
#undef SC_ELEM
}

__device__ __forceinline__ void phase_scan(const Params& p, char* shm) {
  const int G = gridDim.x, b = blockIdx.x;
  const int nS = 128, nP = 16 * 32;
  int j, step;
  if (G > nS) { if (b < nS) { j = b; step = 1 << 30; } else { j = nS + (b - nS); step = G - nS; } }
  else { j = b; step = G; }
  for (; j < nS + nP; j += step) {
    if (j < nS) scan_item<4>(p, MPROMPT, 16384, (j >> 3) & 15, (j >> 2) & 1, (j & 3) * 16, 4, shm);
    else { int q = j - nS; scan_item<8, 2>(p, (q >> 5) * 2048, 2048, (q >> 1) & 15, q & 1, 0, 4, shm); }
  }
  __syncthreads();
  if (G > nS) { if (b >= nS) { prep_weights(p, shm, false, G - nS, b - nS); conv_p(p, 0, G - nS, b - nS); conv_p(p, 1, G - nS, b - nS); } }
  else { prep_weights(p, shm, false, G, b); conv_p(p, 0, G, b); conv_p(p, 1, G, b); }
}

__device__ __forceinline__ void phase_natt(const Params& p, u16* Odst, char* shm) {
  char* big = p.ws + OFF_BIG;
  const u16* Q = (const u16*)(big + BIG_Q);
  const u16* Kb = (const u16*)(big + BIG_K);
  const u16* Vt = (const u16*)(big + BIG_VT);
  const int tid = otid(), wv = tid >> 6, lane = tid & 63, fr = lane & 15, fq = lane >> 4;
  const int hg = blockIdx.x & 3, h = hg * 8 + wv;
  float* tab = (float*)(shm + wv * 3840);
  {
    const float* rp = p.in[30] + (size_t)h * 15 * 31;
    for (int idx = lane; idx < 960; idx += 64) tab[idx] = 0.f;
    asm volatile("s_waitcnt lgkmcnt(0)" ::: "memory");
    for (int idx = lane; idx < 465; idx += 64) { int r = idx / 31, c = idx - r * 31; tab[r * 64 + 16 + c] = rp[idx]; }
    asm volatile("s_waitcnt lgkmcnt(0)" ::: "memory");
  }
  const int nqb = MT / 16, qstep = gridDim.x >> 2;
  for (int qb = blockIdx.x >> 2; qb < nqb; qb += qstep) {
    int tb = qb * 16;
    int seqbase, T, loc;
    if (tb < MPROMPT) { seqbase = tb & ~2047; T = 2048; loc = tb & 2047; } else { seqbase = MPROMPT; T = 16384; loc = tb - MPROMPT; }
    int rows = T >> 6, i = loc >> 6, cbq = (loc & 63) >> 4;
    int rs = min(max(i - 4, 0), rows - 8);
    int kvs = min(max(cbq * 16 - 8, 0), 32);
    int qc = cbq * 16 + fr;
    int ws_ = min(max(qc - 8, 0), 48);
    bf16x8 qf = *(const bf16x8*)(Q + (size_t)(tb + fr) * D + h * 32 + fq * 8);
    unsigned vm = 0;
#pragma unroll
    for (int e = 0; e < 8; ++e) { int kcol = kvs + fq * 8 + e; vm |= ((kcol >= ws_) && (kcol < ws_ + 16)) ? (1u << e) : 0u; }
    const float* trow = tab + (rs - i + 7) * 64 + 16 + (kvs + fq * 8 - qc + 15);
    bf16x8 kf[8][2];
#pragma unroll
    for (int r = 0; r < 8; ++r)
#pragma unroll
      for (int hb2 = 0; hb2 < 2; ++hb2) {
        int kcolA = kvs + (fr >> 2) * 8 + hb2 * 4 + (fr & 3);
        size_t ktok = (size_t)seqbase + (size_t)(rs + r) * 64 + kcolA;
        kf[r][hb2] = *(const bf16x8*)(Kb + ktok * D + h * 32 + fq * 8);
      }
    f32x4 sc[8][2];
    float mx = -1e30f;
#pragma unroll
    for (int r = 0; r < 8; ++r) {
#pragma unroll
      for (int hb2 = 0; hb2 < 2; ++hb2) {
        f32x4 a = __builtin_amdgcn_mfma_f32_16x16x32_bf16(kf[r][hb2], qf, f32x4{0.f, 0.f, 0.f, 0.f}, 0, 0, 0);
#pragma unroll
        for (int j = 0; j < 4; ++j) {
          float sv = ((vm >> (hb2 * 4 + j)) & 1u) ? a[j] + trow[r * 64 + hb2 * 4 + j] : -1e30f;
          a[j] = sv; mx = fmaxf(mx, sv);
        }
        sc[r][hb2] = a;
      }
    }
    mx = fmaxf(mx, __shfl_xor(mx, 16));
    mx = fmaxf(mx, __shfl_xor(mx, 32));
    float sum = 0.f;
    f32x4 o0 = {0.f, 0.f, 0.f, 0.f}, o1 = {0.f, 0.f, 0.f, 0.f};
#pragma unroll
    for (int r = 0; r < 8; ++r) {
      bf16x8 pf;
#pragma unroll
      for (int e = 0; e < 8; ++e) {
        float pe = __expf(sc[r][e >> 2][e & 3] - mx);
        sum += pe;
        pf[e] = (short)f2bf(pe);
      }
      size_t vbase = (size_t)seqbase + (size_t)(rs + r) * 64 + kvs + fq * 8;
      bf16x8 v0 = *(const bf16x8*)(Vt + (size_t)(h * 32 + fr) * MT + vbase);
      bf16x8 v1 = *(const bf16x8*)(Vt + (size_t)(h * 32 + 16 + fr) * MT + vbase);
      o0 = __builtin_amdgcn_mfma_f32_16x16x32_bf16(v0, pf, o0, 0, 0, 0);
      o1 = __builtin_amdgcn_mfma_f32_16x16x32_bf16(v1, pf, o1, 0, 0, 0);
    }
    sum += __shfl_xor(sum, 16);
    sum += __shfl_xor(sum, 32);
    float inv = 1.f / sum;
    uint2 w0, w1;
    w0.x = pack2(o0[0] * inv, o0[1] * inv); w0.y = pack2(o0[2] * inv, o0[3] * inv);
    w1.x = pack2(o1[0] * inv, o1[1] * inv); w1.y = pack2(o1[2] * inv, o1[3] * inv);
    *(uint2*)(Odst + (size_t)(tb + fr) * D + h * 32 + fq * 4) = w0;
    *(uint2*)(Odst + (size_t)(tb + fr) * D + h * 32 + 16 + fq * 4) = w1;
  }
}

__device__ __forceinline__ void phase_final(const Params& p) {
  const float* ss8 = (const float*)(p.ws + OFF_SS) + (size_t)8 * MT;
  const float* gain = p.in[11];
  int tid = otid(), half = tid >> 8, c4 = (tid & 255) * 4;
  float4 gn = *(const float4*)(gain + c4);
  for (int r0 = blockIdx.x * 2; r0 < MT; r0 += gridDim.x * 2) {
    int row = r0 + half;
    float rs = rstd_of(ss8[row]);
    float4 v = *(float4*)(p.h + (size_t)row * D + c4);
    v.x *= rs * gn.x; v.y *= rs * gn.y; v.z *= rs * gn.z; v.w *= rs * gn.w;
    *(float4*)(p.h + (size_t)row * D + c4) = v;
  }
}

constexpr int NPHASE = 20;
#ifndef PROBE_MASK
#define PROBE_MASK 0ull
#endif

enum { K_NONE = 0, K_PREP, K_FFN1, K_FFN2, K_MIX, K_RKV, K_SCAN, K_FIN, K_RWO, K_PPROJ, K_PGATE, K_CONVH, K_QKV, K_NATT, K_NAO, K_FINAL };

__device__ __forceinline__ void run_phase(const Params& p, int ph, LDSC* shml) {
  char* shm = (char*)shml;
  char* ws = p.ws;
  float* ss = (float*)(ws + OFF_SS);
  u16* hb = (u16*)(ws + OFF_HB);
  char* big = ws + OFF_BIG;
  int kind = K_NONE, a = 0, b = 0, c = 0, d = 0;
  switch (ph) {
    case 0: kind = K_PREP; break;
    case 1: kind = K_FFN1; a = 0; b = 0; c = 0; d = 0; break;
    case 2: kind = K_FFN2; a = 0; b = 0; c = 1; break;
    case 3: kind = K_MIX; break;
    case 4: kind = K_RKV; break;
    case 5: kind = K_SCAN; break;
    case 6: kind = K_FIN; break;
    case 7: kind = K_RWO; break;
    case 8: kind = K_FFN1; a = 0; b = 1; c = 2; d = 1; break;
    case 9: kind = K_FFN2; a = 0; b = 1; c = 3; break;
    case 10: kind = K_PGATE; a = 0; b = 3; c = 4; break;
    case 11: kind = K_FFN1; a = 1; b = 0; c = 4; d = 0; break;
    case 12: kind = K_FFN2; a = 1; b = 0; c = 5; break;
    case 13: kind = K_QKV; break;
    case 14: kind = K_NATT; break;
    case 15: kind = K_NAO; break;
    case 16: kind = K_FFN1; a = 1; b = 1; c = 6; d = 1; break;
    case 17: kind = K_FFN2; a = 1; b = 1; c = 7; break;
    case 18: kind = K_PGATE; a = 1; b = 7; c = 8; break;
    case 19: kind = K_FINAL; break;
    default: break;
  }
  GA g;
  g.A = nullptr; g.Bt = nullptr; g.K = 0; g.N = 0; g.mtiles = 0; g.ntiles = 0; g.rowoff = 0;
  g.ss_in = nullptr; g.ss_out = nullptr; g.bias = nullptr; g.scale = 1.f; g.h = p.h; g.hb = hb;
  g.o0 = nullptr; g.o1 = nullptr; g.o2 = nullptr; g.f0 = nullptr; g.f1 = nullptr; g.f2 = nullptr;
  g.hin0 = nullptr; g.hin1 = nullptr;
  GA g2 = g;
  int epi = -1;
  const int tok0 = 0, ntok = MT;
  switch (kind) {
    case K_PREP: phase_prep(p, shm); break;
    case K_FFN1:
      g.A = (a == 1 && b == 0) ? (const u16*)(big + BIG_HBALT) : hb;
      g.Bt = (const u16*)(ws + OFF_WIN + (size_t)(a * 2 + b) * SZ_WIN); g.K = 1024; g.N = 5632;
      g.mtiles = MT / 256; g.ntiles = 22; g.ss_in = ss + (size_t)c * MT; g.o0 = (u16*)(big + BIG_ACTB);
      epi = E_SWIGLU; break;
    case K_FFN2:
      g.A = (const u16*)(big + BIG_ACTB); g.Bt = (const u16*)(ws + OFF_WOUT + (size_t)(a * 2 + b) * SZ_WOUT); g.K = DFF; g.N = 1024;
      g.mtiles = MT / 256; g.ntiles = 4; g.ss_out = ss + (size_t)c * MT; g.scale = 0.5f;
      if (a == 0 && b == 0) { g.hb = nullptr; g.hin0 = p.in[0]; g.hin1 = p.in[1]; }
      epi = E_RESID; break;
    case K_MIX: phase_mix(p, tok0, ntok); break;
    case K_RKV:
      g.A = (const u16*)(big + BIG_A2); g.Bt = (const u16*)(ws + OFF_WRKV); g.K = 2048; g.N = 3456;
      g.mtiles = ntok / 256; g.ntiles = 14; g.o0 = (u16*)(big + BIG_RKV); g.o1 = (u16*)(big + BIG_T);
      epi = E_RKV; break;
    case K_SCAN: phase_scan(p, shm); break;
    case K_FIN:
      g.A = (const u16*)(big + BIG_T + 2 * SZ_T1); g.Bt = (const u16*)(ws + OFF_WG2); g.K = 128; g.N = 1024;
      g.mtiles = ntok / 256; g.ntiles = 4;
      g.o0 = (u16*)(big + BIG_Y0); g.o1 = (u16*)(big + BIG_Y1); g.o2 = (u16*)(big + BIG_RKV + 2 * SZ_RKV1);
      g.hb = (u16*)(big + BIG_RKV + SZ_RKV1);
      g.f0 = (const float*)(ws + OFF_BONUS); g.f1 = p.in[25]; g.f2 = p.in[26];
      epi = E_RWFIN; break;
    case K_RWO:
      g.A = (const u16*)(big + BIG_RKV + SZ_RKV1); g.Bt = (const u16*)(ws + OFF_WRWO); g.K = 1024; g.N = 1024;
      g.mtiles = ntok / 256; g.ntiles = 4; g.rowoff = tok0; g.ss_out = ss + (size_t)2 * MT; g.scale = 1.f;
      epi = E_RESID; break;
    case K_PGATE:
      g2 = g;
      g2.A = (const u16*)(ws + OFF_PBI) + (size_t)a * MT * 256; g2.Bt = (const u16*)(ws + OFF_WPP) + (size_t)a * 1024 * 256; g2.K = 256; g2.N = 1024;
      g2.mtiles = MT / 256; g2.ntiles = 4; g2.o0 = (u16*)(big + BIG_PB);
      g.hb = a == 0 ? (u16*)(big + BIG_HBALT) : nullptr;
      g.A = hb; g.Bt = (const u16*)(ws + OFF_WPG) + (size_t)a * 1024 * 1024; g.K = 1024; g.N = 1024;
      g.mtiles = MT / 256; g.ntiles = 4; g.ss_in = ss + (size_t)b * MT; g.ss_out = ss + (size_t)c * MT; g.o0 = (u16*)(big + BIG_PB);
      epi = E_PLEGATE; break;
    case K_QKV:
      g.A = hb; g.Bt = (const u16*)(ws + OFF_WQKV); g.K = 1024; g.N = 3072; g.mtiles = MT / 256; g.ntiles = 12;
      g.ss_in = ss + (size_t)5 * MT; g.bias = p.in[29];
      g.o0 = (u16*)(big + BIG_Q); g.o1 = (u16*)(big + BIG_K); g.o2 = (u16*)(big + BIG_VT);
      epi = E_QKV; break;
    case K_NATT:
#ifdef PROBE_NATT
      phase_natt(p, hb, shm); __syncthreads();
#endif
      phase_natt(p, (u16*)(big + BIG_Q), shm); break;
    case K_NAO:
      g.A = (const u16*)(big + BIG_Q); g.Bt = (const u16*)(ws + OFF_WNAO); g.K = 1024; g.N = 1024; g.mtiles = MT / 256; g.ntiles = 4;
      g.ss_out = ss + (size_t)6 * MT; g.bias = p.in[32]; g.scale = 1.f;
      epi = E_RESID; break;
    case K_FINAL: phase_final(p); break;
    default: break;
  }
  switch (epi) {
    case E_SWIGLU: gemm_phase<E_SWIGLU>(g, g2, shml); break;
    case E_RESID: gemm_phase<E_RESID>(g, g2, shml); break;
    case E_PLEGATE: gemm_phase<E_PLEGATE>(g, g2, shml); break;
    case E_RKV: gemm_phase<E_RKV>(g, g2, shml); break;
    case E_RWFIN: gemm_phase<E_RWFIN>(g, g2, shml); break;
    case E_QKV: gemm_phase<E_QKV>(g, g2, shml); break;
    default: break;
  }
}

__device__ __forceinline__ void grid_barrier(unsigned* bar, unsigned& nbar) {
  asm volatile("s_waitcnt vmcnt(0)" ::: "memory");
  __syncthreads();
  nbar += 1;
  if (otid() == 0) {
    __builtin_amdgcn_s_waitcnt(0);
    __builtin_amdgcn_fence(__ATOMIC_RELEASE, "agent");
    asm volatile("s_waitcnt vmcnt(0)" ::: "memory");
    __hip_atomic_fetch_add(bar, 1u, __ATOMIC_RELAXED, __HIP_MEMORY_SCOPE_AGENT);
    const unsigned target = nbar * gridDim.x;
    while (__hip_atomic_load(bar, __ATOMIC_RELAXED, __HIP_MEMORY_SCOPE_AGENT) < target) __builtin_amdgcn_s_sleep(1);
    __builtin_amdgcn_fence(__ATOMIC_ACQUIRE, "agent");
    asm volatile("s_waitcnt vmcnt(0)" ::: "memory");
  }
  __syncthreads();
}

__global__ void __launch_bounds__(NTHR, 2) fwd_megakernel(Params p, int ph_lo, int ph_hi) {
  __shared__ __attribute__((aligned(1024))) char shm[131072];
  cg::grid_group grid = cg::this_grid();
  unsigned* bar = (unsigned*)(p.ws + OFF_BAR);
  if (blockIdx.x == 0 && otid() == 0) __hip_atomic_store(bar, 0u, __ATOMIC_RELAXED, __HIP_MEMORY_SCOPE_AGENT);
  unsigned nbar = 0;
  for (int ph = ph_lo; ph < ph_hi; ++ph) {
#if PROBE_MASK
    if ((PROBE_MASK >> ph) & 1ull) { run_phase(p, ph, (LDSC*)shm); if (ph == ph_lo) grid.sync(); else grid_barrier(bar, nbar); }
#endif
    run_phase(p, ph, (LDSC*)shm);
    if (ph + 1 < ph_hi) {
      if (ph == ph_lo) grid.sync(); else grid_barrier(bar, nbar);
    }
  }
}

extern "C" void kernel_launch(void* const* d_in, const int* in_sizes, int n_in, void* d_out, int out_size, void* d_ws, size_t ws_size,
                              hipStream_t stream) {
  static int grid_blocks = 0;
  if (!grid_blocks) {
    int dev = 0, cus = 0, per_cu = 0;
    hipGetDevice(&dev);
    hipDeviceGetAttribute(&cus, hipDeviceAttributeMultiprocessorCount, dev);
    hipOccupancyMaxActiveBlocksPerMultiprocessor(&per_cu, fwd_megakernel, NTHR, 0);
    (void)per_cu;
    grid_blocks = 256;
    if (cus < 256) { fprintf(stderr, "device has %d CUs, this kernel needs 256\n", cus); grid_blocks = -1; }
  }
  if (grid_blocks < 0) return;
  if (ws_size < OFF_BIG + BIG_T + 3 * SZ_T1) return;
  Params p{};
  for (int i = 0; i < 33; ++i) p.in[i] = (const float*)d_in[i];
  p.h = (float*)d_out;
  p.ws = (char*)d_ws;
  int lo = 0, hi = NPHASE;
  void* args[] = {&p, &lo, &hi};
  hipError_t e = hipLaunchCooperativeKernel((void*)fwd_megakernel, dim3(grid_blocks), dim3(NTHR), args, 0, stream);
  if (e != hipSuccess) fprintf(stderr, "cooperative launch failed: %s (grid %d)\n", hipGetErrorString(e), grid_blocks);
}
```

```cpp
#include <hip/hip_runtime.h>
#include <hip/hip_cooperative_groups.h>
#include <cstdio>
#include <cstdint>
namespace cg = cooperative_groups;

typedef unsigned short u16;
using bf16x8 = __attribute__((ext_vector_type(8))) short;
using f32x4 = __attribute__((ext_vector_type(4))) float;
using f32x2 = __attribute__((ext_vector_type(2))) float;
using i32x4 = __attribute__((ext_vector_type(4))) int;
typedef __attribute__((address_space(3))) char LDSC;
typedef __attribute__((address_space(3))) unsigned LDSU;
typedef __attribute__((address_space(3))) bf16x8 LDS_BF8;

constexpr int MT = 49152;
constexpr int MPROMPT = 32768;
constexpr int MR = MT;
constexpr int D = 1024;
constexpr int DFF = 2816;
constexpr int NTHR = 512;

constexpr size_t SZ_WIN = (size_t)5632 * 1024 * 2;
constexpr size_t SZ_WOUT = (size_t)1024 * 2816 * 2;
constexpr size_t OFF_WIN = 0;
constexpr size_t OFF_WOUT = OFF_WIN + 4 * SZ_WIN;
constexpr size_t OFF_WPG = OFF_WOUT + 4 * SZ_WOUT;
constexpr size_t OFF_WPP = OFF_WPG + 2 * (size_t)1024 * 1024 * 2;
constexpr size_t OFF_WRKV = OFF_WPP + 2 * (size_t)1024 * 256 * 2;
constexpr size_t OFF_W2W = OFF_WRKV + (size_t)3584 * 2048 * 2;
constexpr size_t OFF_W2A = OFF_W2W + 2 * (size_t)1024 * 64 * 2;
constexpr size_t OFF_WG2 = OFF_W2A + 2 * (size_t)1024 * 64 * 2;
constexpr size_t OFF_WRWO = OFF_WG2 + (size_t)1024 * 128 * 2;
constexpr size_t OFF_WQKV = OFF_WRWO + (size_t)1024 * 1024 * 2;
constexpr size_t OFF_WNAO = OFF_WQKV + (size_t)3072 * 1024 * 2;
constexpr size_t OFF_SS = OFF_WNAO + (size_t)1024 * 1024 * 2;
constexpr size_t OFF_BONUS = OFF_SS + 9 * (size_t)MT * 4;
constexpr size_t OFF_BAR = OFF_BONUS + 2 * (size_t)MR * 16 * 4;
constexpr size_t OFF_HB = OFF_BAR + 256;
constexpr size_t OFF_PBI = OFF_HB + (size_t)MT * 1024 * 2;
constexpr size_t OFF_BIG = OFF_PBI + 2 * (size_t)MT * 256 * 2;
constexpr size_t BIG_ACTB = 0;
constexpr size_t BIG_PB = 0;
constexpr size_t BIG_HBALT = (size_t)MT * 2816 * 2;
constexpr size_t BIG_A2 = 0;
constexpr size_t BIG_Y0 = 0;
constexpr size_t BIG_Y1 = (size_t)MR * 1024 * 2;
constexpr size_t BIG_RKV = (size_t)MR * 2048 * 2;
constexpr size_t SZ_RKV1 = (size_t)MR * 1024 * 2;
constexpr size_t BIG_T = BIG_RKV + 3 * SZ_RKV1;
constexpr size_t SZ_T1 = (size_t)MR * 128 * 2;
constexpr size_t BIG_Q = 0;
constexpr size_t BIG_K = (size_t)MT * 1024 * 2;
constexpr size_t BIG_VT = 2 * (size_t)MT * 1024 * 2;

struct Params {
  const float* in[33];
  float* h;
  char* ws;
};

__device__ __forceinline__ u16 f2bf(float f) {
  unsigned u = __float_as_uint(f);
  u += 0x7fffu + ((u >> 16) & 1u);
  return (u16)(u >> 16);
}
__device__ __forceinline__ float bf2f(u16 h) { return __uint_as_float(((unsigned)h) << 16); }
__device__ __forceinline__ unsigned pack2(float a, float b) { return (unsigned)f2bf(a) | ((unsigned)f2bf(b) << 16); }
__device__ __forceinline__ float sigm(float x) { return __builtin_amdgcn_rcpf(1.f + __expf(-x)); }
template <int CTRL> __device__ __forceinline__ float dppf(float v) {
  return __int_as_float(__builtin_amdgcn_update_dpp(0, __float_as_int(v), CTRL, 0xf, 0xf, true));
}
__device__ __forceinline__ float rowsum16(float v) {
  v += dppf<0xB1>(v);
  v += dppf<0x4E>(v);
  v += dppf<0x141>(v);
  v += dppf<0x140>(v);
  return v;
}
__device__ __forceinline__ int otid() { int t = __builtin_amdgcn_workitem_id_x(); asm volatile("" : "+v"(t)); return t; }
__device__ __forceinline__ float rstd_of(float ss) { return rsqrtf(ss * (1.f / 1024.f) + 1e-6f); }

struct PrepJob {
  const float* src; int K, N, ldsrc;
  u16* dst; int dld, koff, noff;
  const float* sc; int mode;
  int perm;
};

__device__ __forceinline__ void prep_tiles(const PrepJob& j, char* shm, int nblk, int bid, int& base) {
  u16* tl = (u16*)shm;
  int kt = j.K >> 6, nt = j.N >> 6, tiles = kt * nt;
  int tid = otid();
  int t0_ = (bid - base) % nblk; if (t0_ < 0) t0_ += nblk;
  base = (base + tiles) % nblk;
  for (int t = t0_; t < tiles; t += nblk) {
    int k0 = (t / nt) << 6, n0 = (t % nt) << 6;
#pragma unroll
    for (int it = 0; it < 2; ++it) {
      int kk = (tid >> 4) + 32 * it, nn4 = (tid & 15) * 4;
      float4 v = *(const float4*)(j.src + (size_t)(k0 + kk) * j.ldsrc + n0 + nn4);
      float s = 1.f;
      if (j.mode == 1 || j.mode == 3) s = j.sc[k0 + kk];
      else if (j.mode == 2) s = 1.f - j.sc[k0 + kk];
      tl[(nn4 + 0) * 72 + kk] = f2bf(v.x * s);
      tl[(nn4 + 1) * 72 + kk] = f2bf(v.y * s);
      tl[(nn4 + 2) * 72 + kk] = f2bf(v.z * s);
      tl[(nn4 + 3) * 72 + kk] = f2bf(v.w * s);
    }
    __syncthreads();
    {
      int nn = tid >> 3, kk8 = (tid & 7) * 8;
      int c = n0 + nn, drow;
      if (j.perm) { int half = c / DFF, cp = c % DFF; drow = (cp >> 5) * 64 + half * 32 + (cp & 31); }
      else drow = c;
      i32x4 v = *(const i32x4*)(tl + nn * 72 + kk8);
      *(i32x4*)(j.dst + (size_t)(j.noff + drow) * j.dld + j.koff + k0 + kk8) = v;
    }
    __syncthreads();
  }
}

__device__ __forceinline__ bool prep_is_early(int jj) { return jj == 0 || jj == 4 || (jj >= 12 && jj < 32); }
__device__ __forceinline__ void prep_weights(const Params& p, char* shm, bool early, int nblk, int bid) {
  char* ws = p.ws;
  int pbase = 0;
  for (int jj = 0; jj < 36; ++jj) {
    if (prep_is_early(jj) != early) continue;
    PrepJob j; j.mode = 0; j.sc = nullptr; j.perm = 0; j.koff = 0; j.noff = 0;
    if (jj < 4) {
      j.src = p.in[5] + (size_t)jj * 1024 * 5632; j.K = 1024; j.N = 5632; j.ldsrc = 5632;
      j.dst = (u16*)(ws + OFF_WIN + jj * SZ_WIN); j.dld = 1024; j.sc = p.in[4] + jj * 1024; j.mode = 1; j.perm = 1;
    } else if (jj < 8) {
      int q = jj - 4;
      j.src = p.in[6] + (size_t)q * 2816 * 1024; j.K = 2816; j.N = 1024; j.ldsrc = 1024;
      j.dst = (u16*)(ws + OFF_WOUT + q * SZ_WOUT); j.dld = 2816;
    } else if (jj < 10) {
      int q = jj - 8;
      j.src = p.in[9] + (size_t)q * 1024 * 1024; j.K = 1024; j.N = 1024; j.ldsrc = 1024;
      j.dst = (u16*)(ws + OFF_WPG) + (size_t)q * 1024 * 1024; j.dld = 1024; j.sc = p.in[8] + q * 1024; j.mode = 1;
    } else if (jj < 12) {
      int q = jj - 10;
      j.src = p.in[10] + (size_t)q * 256 * 1024; j.K = 256; j.N = 1024; j.ldsrc = 1024;
      j.dst = (u16*)(ws + OFF_WPP) + (size_t)q * 1024 * 256; j.dld = 256;
    } else if (jj < 28) {
      int q = (jj - 12) >> 1, hf = (jj - 12) & 1;
      j.K = 1024; j.dst = (u16*)(ws + OFF_WRKV); j.dld = 2048; j.koff = hf * 1024; j.mode = hf ? 3 : 2;
      if (q < 3) { j.src = p.in[13] + (size_t)q * 1024 * 1024; j.N = 1024; j.ldsrc = 1024; j.noff = q * 1024; j.sc = p.in[12] + q * 1024; }
      else if (q < 5) { int z = q - 3; j.src = p.in[15] + (size_t)z * 1024 * 64; j.N = 64; j.ldsrc = 64; j.noff = 3072 + z * 64; j.sc = p.in[12] + 3 * 1024; }
      else if (q < 7) { int z = q - 5; j.src = p.in[18] + (size_t)z * 1024 * 64; j.N = 64; j.ldsrc = 64; j.noff = 3200 + z * 64; j.sc = p.in[12] + 4 * 1024; }
      else { j.src = p.in[20]; j.N = 128; j.ldsrc = 128; j.noff = 3328; j.sc = p.in[12] + 5 * 1024; }
    } else if (jj < 30) {
      int z = jj - 28;
      j.src = p.in[16] + (size_t)z * 64 * 1024; j.K = 64; j.N = 1024; j.ldsrc = 1024;
      j.dst = (u16*)(ws + OFF_W2W) + (size_t)z * 1024 * 64; j.dld = 64;
    } else if (jj < 32) {
      int z = jj - 30;
      j.src = p.in[19] + (size_t)z * 64 * 1024; j.K = 64; j.N = 1024; j.ldsrc = 1024;
      j.dst = (u16*)(ws + OFF_W2A) + (size_t)z * 1024 * 64; j.dld = 64;
    } else if (jj == 32) {
      j.src = p.in[21]; j.K = 128; j.N = 1024; j.ldsrc = 1024; j.dst = (u16*)(ws + OFF_WG2); j.dld = 128;
    } else if (jj == 33) {
      j.src = p.in[27]; j.K = 1024; j.N = 1024; j.ldsrc = 1024; j.dst = (u16*)(ws + OFF_WRWO); j.dld = 1024;
    } else if (jj == 34) {
      j.src = p.in[28]; j.K = 1024; j.N = 3072; j.ldsrc = 3072; j.dst = (u16*)(ws + OFF_WQKV); j.dld = 1024; j.sc = p.in[7] + 1024; j.mode = 1;
    } else if (jj == 35) {
      j.src = p.in[31]; j.K = 1024; j.N = 1024; j.ldsrc = 1024; j.dst = (u16*)(ws + OFF_WNAO); j.dld = 1024;
    } else continue;
    prep_tiles(j, shm, nblk, bid, pbase);
  }
}

__device__ __forceinline__ void phase_prep(const Params& p, char* shm) {
  char* ws = p.ws;
  prep_weights(p, shm, true, gridDim.x, blockIdx.x);
  float* ss = (float*)(ws + OFF_SS);
  u16* hb = (u16*)(ws + OFF_HB);
  int tid = otid(), half = tid >> 8, t4 = (tid & 255) * 4;
  float* red = (float*)shm;
  for (int r0 = blockIdx.x * 2; r0 < MT; r0 += gridDim.x * 2) {
    int row = r0 + half;
    const float* src = row < MPROMPT ? p.in[0] + (size_t)row * D : p.in[1] + (size_t)(row - MPROMPT) * D;
    float4 v = *(const float4*)(src + t4);
    uint2 pk; pk.x = pack2(v.x, v.y); pk.y = pack2(v.z, v.w);
    *(uint2*)(hb + (size_t)row * D + t4) = pk;
    float s = v.x * v.x + v.y * v.y + v.z * v.z + v.w * v.w;
#pragma unroll
    for (int o = 32; o > 0; o >>= 1) s += __shfl_xor(s, o);
    __syncthreads();
    if ((tid & 63) == 0) red[tid >> 6] = s;
    __syncthreads();
    if ((tid & 255) == 0) {
      float tot = red[half * 4] + red[half * 4 + 1] + red[half * 4 + 2] + red[half * 4 + 3];
      ss[row] = tot;
#pragma unroll
      for (int q = 1; q < 9; ++q) ss[(size_t)q * MT + row] = 0.f;
    }
  }
}

__device__ __forceinline__ void conv_p(const Params& p, int layer, int nblk, int bid) {
  u16* pbi = (u16*)(p.ws + OFF_PBI) + (size_t)layer * MT * 256;
  const float* pp = p.in[2] + (size_t)layer * MPROMPT * 256;
  const float* ps = p.in[3] + (size_t)layer * (MT - MPROMPT) * 256;
  size_t n4 = (size_t)MT * 256 / 4;
  for (size_t i = (size_t)bid * NTHR + otid(); i < n4; i += (size_t)nblk * NTHR) {
    size_t e = i * 4;
    const float* s = e < (size_t)MPROMPT * 256 ? pp + e : ps + (e - (size_t)MPROMPT * 256);
    float4 v = *(const float4*)s;
    uint2 pk; pk.x = pack2(v.x, v.y); pk.y = pack2(v.z, v.w);
    *(uint2*)(pbi + e) = pk;
  }
}

__device__ __forceinline__ void conv_h(const Params& p) {
  u16* hb = (u16*)(p.ws + OFF_HB);
  size_t n4 = (size_t)MT * D / 4;
  for (size_t i = (size_t)blockIdx.x * NTHR + otid(); i < n4; i += (size_t)gridDim.x * NTHR) {
    float4 v = *(const float4*)(p.h + i * 4);
    uint2 pk; pk.x = pack2(v.x, v.y); pk.y = pack2(v.z, v.w);
    *(uint2*)(hb + i * 4) = pk;
  }
}

enum { E_SWIGLU = 0, E_RESID = 1, E_PLEPROJ = 2, E_PLEGATE = 3, E_RKV = 4, E_RWFIN = 5, E_QKV = 6 };

struct GA {
  const u16* A; const u16* Bt; int K; int N;
  int mtiles, ntiles;
  int rowoff;
  const float* ss_in; float* ss_out;
  const float* bias; float scale;
  float* h; u16* hb;
  u16* o0; u16* o1; u16* o2;
  const float* f0; const float* f1; const float* f2;
  const float* hin0; const float* hin1;
};

template <int KS> __device__ __forceinline__ int lds_byte(int r, int c) {
  int st = (r >> 4) * KS + (c >> 5), ob = (r & 15) * 64 + (c & 31) * 2;
  return st * 1024 + (ob ^ (((ob >> 9) & 1) << 5));
}
template <int KS> __device__ __forceinline__ void stage_rc(int b, int& R, int& C) {
  int st = b >> 10, sb = b & 1023, swz = sb ^ (((sb >> 9) & 1) << 5);
  R = (st / KS) * 16 + swz / 64;
  C = (st % KS) * 32 + (swz % 64) / 2;
}

template <int EPI>
__device__ __forceinline__ void gemm_tile(const GA& g, int pm, int pn, bool prefetched, bool has_next, int pm_next, int pn_next, LDSC* shm) {
  constexpr int BK = 64, KS = 2, TILE_B = 256 * BK * 2, GL = 4, STAGE_B = 2 * TILE_B;
  const int K = g.K;
  const int tid = otid(), wid = tid >> 6, lane = tid & 63, wr = wid >> 2, wc = wid & 3, fr = lane & 15, fq = lane >> 4;
  const int brow = pm * 256, bcol = pn * 256;
  const u16* Ab = g.A + (size_t)brow * K;
  const u16* Bb = g.Bt + (size_t)bcol * K;
  const u16* Abn = g.A + (size_t)(pm_next * 256) * K;
  const u16* Bbn = g.Bt + (size_t)(pn_next * 256) * K;
  int sO[GL];
#pragma unroll
  for (int i = 0; i < GL; ++i) { int r_, c_; stage_rc<KS>(wid * 1024 + i * 8192 + lane * 16, r_, c_); sO[i] = r_ * K + c_; }
  f32x4 acc[8][4];
#pragma unroll
  for (int m = 0; m < 8; ++m)
#pragma unroll
    for (int n = 0; n < 4; ++n) acc[m][n] = f32x4{0.f, 0.f, 0.f, 0.f};
  const int nt = K / BK;
#define G_STAGE(buf, AB_, BB_, kt) do { _Pragma("unroll") for (int i = 0; i < GL; ++i) { \
    __builtin_amdgcn_global_load_lds((const unsigned*)((AB_) + (kt) * BK + sO[i]), (LDSU*)(shm + (buf) * STAGE_B + wid * 1024 + i * 8192), 16, 0, 0); \
    __builtin_amdgcn_global_load_lds((const unsigned*)((BB_) + (kt) * BK + sO[i]), (LDSU*)(shm + (buf) * STAGE_B + TILE_B + wid * 1024 + i * 8192), 16, 0, 0); } } while (0)
#define G_STAGE_H(hh, buf, AB_, BB_, kt) do { _Pragma("unroll") for (int i = (hh) * 2; i < (hh) * 2 + 2; ++i) { \
    __builtin_amdgcn_global_load_lds((const unsigned*)((AB_) + (kt) * BK + sO[i]), (LDSU*)(shm + (buf) * STAGE_B + wid * 1024 + i * 8192), 16, 0, 0); \
    __builtin_amdgcn_global_load_lds((const unsigned*)((BB_) + (kt) * BK + sO[i]), (LDSU*)(shm + (buf) * STAGE_B + TILE_B + wid * 1024 + i * 8192), 16, 0, 0); } } while (0)
  if (!prefetched) G_STAGE(0, Ab, Bb, 0);
  asm volatile("s_waitcnt vmcnt(0)" ::: "memory");
  __syncthreads();
  for (int t = 0; t < nt; ++t) {
    int cur = t & 1;
    if (t + 1 < nt) G_STAGE_H(0, cur ^ 1, Ab, Bb, t + 1);
    else if (has_next) G_STAGE_H(0, 0, Abn, Bbn, 0);
    const LDSC* SAp = shm + cur * STAGE_B;
    const LDSC* SBp = SAp + TILE_B;
#pragma unroll
    for (int ks = 0; ks < KS; ++ks) {
      if (ks == 1) {
        if (t + 1 < nt) G_STAGE_H(1, cur ^ 1, Ab, Bb, t + 1);
        else if (has_next) G_STAGE_H(1, 0, Abn, Bbn, 0);
      }
      bf16x8 At[8], Bf[4];
#pragma unroll
      for (int m = 0; m < 8; ++m) At[m] = *(const LDS_BF8*)(SAp + lds_byte<KS>(wr * 128 + m * 16 + fr, ks * 32 + fq * 8));
#pragma unroll
      for (int n = 0; n < 4; ++n) Bf[n] = *(const LDS_BF8*)(SBp + lds_byte<KS>(wc * 64 + n * 16 + fr, ks * 32 + fq * 8));
      __builtin_amdgcn_s_setprio(1);
#pragma unroll
      for (int m = 0; m < 8; ++m)
#pragma unroll
        for (int n = 0; n < 4; ++n) acc[m][n] = __builtin_amdgcn_mfma_f32_16x16x32_bf16(At[m], Bf[n], acc[m][n], 0, 0, 0);
      __builtin_amdgcn_s_setprio(0);
      __builtin_amdgcn_sched_barrier(0);
    }
    if (t + 1 < nt) asm volatile("s_waitcnt vmcnt(0)" ::: "memory");
    __syncthreads();
  }
#undef G_STAGE
#undef G_STAGE_H
  typedef __attribute__((address_space(3))) float LDSF;
  typedef __attribute__((address_space(3))) f32x4 LDSF4;
  LDSF* scr = (LDSF*)(shm + STAGE_B + wid * 4352);
  const int cb = bcol + wc * 64;
#define SLAB_WRITE(m) do { _Pragma("unroll") for (int n = 0; n < 4; ++n) _Pragma("unroll") for (int j = 0; j < 4; ++j) \
    scr[(fq * 4 + j) * 68 + n * 16 + fr] = acc[m][n][j]; asm volatile("s_waitcnt lgkmcnt(0)" ::: "memory"); } while (0)
#define SLAB_DONE() asm volatile("s_waitcnt lgkmcnt(0)" ::: "memory")
  if constexpr (EPI == E_SWIGLU) {
    const int l8 = lane & 7, r8 = lane >> 3;
    float ssv[8][2];
#pragma unroll
    for (int m = 0; m < 8; ++m)
#pragma unroll
      for (int k = 0; k < 2; ++k) ssv[m][k] = g.ss_in[g.rowoff + brow + wr * 128 + m * 16 + k * 8 + r8];
#pragma unroll
    for (int m = 0; m < 8; ++m) {
      SLAB_WRITE(m);
#pragma unroll
      for (int k = 0; k < 2; ++k) {
        int rl = k * 8 + r8, row = brow + wr * 128 + m * 16 + rl;
        f32x4 gt = *(const LDSF4*)(scr + rl * 68 + l8 * 4), up = *(const LDSF4*)(scr + rl * 68 + 32 + l8 * 4);
        float rs = rstd_of(ssv[m][k]);
        float o[4];
#pragma unroll
        for (int e = 0; e < 4; ++e) { float a = gt[e] * rs; o[e] = a * sigm(a) * (up[e] * rs); }
        uint2 pk; pk.x = pack2(o[0], o[1]); pk.y = pack2(o[2], o[3]);
        *(uint2*)(g.o0 + (size_t)row * DFF + (cb >> 1) + l8 * 4) = pk;
      }
      SLAB_DONE();
    }
  } else if constexpr (EPI == E_QKV) {
    const int which = cb >> 10, c0 = cb & 1023;
    if (which == 2) {
#pragma unroll
      for (int m = 0; m < 8; ++m) {
        int row0 = brow + wr * 128 + m * 16 + fq * 4;
        float rs[4];
#pragma unroll
        for (int j = 0; j < 4; ++j) rs[j] = rstd_of(g.ss_in[row0 + j]);
#pragma unroll
        for (int n = 0; n < 4; ++n) {
          int col = c0 + n * 16 + fr;
          float b = g.bias[cb + n * 16 + fr];
          uint2 pk; pk.x = pack2(acc[m][n][0] * rs[0] + b, acc[m][n][1] * rs[1] + b); pk.y = pack2(acc[m][n][2] * rs[2] + b, acc[m][n][3] * rs[3] + b);
          *(uint2*)(g.o2 + (size_t)col * MT + row0) = pk;
        }
      }
    } else {
      u16* dst = which == 0 ? g.o0 : g.o1;
      const float sc = which == 0 ? 0.17677669529663687f : 1.f;
      f32x4 b4 = *(const f32x4*)(g.bias + cb + fr * 4);
      float ssq[8][4];
#pragma unroll
      for (int m = 0; m < 8; ++m)
#pragma unroll
        for (int k = 0; k < 4; ++k) ssq[m][k] = g.ss_in[brow + wr * 128 + m * 16 + k * 4 + fq];
#pragma unroll
      for (int m = 0; m < 8; ++m) {
        SLAB_WRITE(m);
#pragma unroll
        for (int k = 0; k < 4; ++k) {
          int rl = k * 4 + fq, row = brow + wr * 128 + m * 16 + rl;
          f32x4 v = *(const LDSF4*)(scr + rl * 68 + fr * 4);
          float rs = rstd_of(ssq[m][k]);
          uint2 pk; pk.x = pack2((v[0] * rs + b4[0]) * sc, (v[1] * rs + b4[1]) * sc); pk.y = pack2((v[2] * rs + b4[2]) * sc, (v[3] * rs + b4[3]) * sc);
          *(uint2*)(dst + (size_t)row * D + c0 + fr * 4) = pk;
        }
        SLAB_DONE();
      }
    }
  } else {
    float lw[4] = {0.f, 0.f, 0.f, 0.f}, lb[4] = {0.f, 0.f, 0.f, 0.f}, bs[4] = {0.f, 0.f, 0.f, 0.f};
    if constexpr (EPI == E_RWFIN) {
#pragma unroll
      for (int e = 0; e < 4; ++e) { lw[e] = g.f1[cb + fr * 4 + e]; lb[e] = g.f2[cb + fr * 4 + e]; }
    }
    if constexpr (EPI == E_RESID) {
      if (g.bias) {
#pragma unroll
        for (int e = 0; e < 4; ++e) bs[e] = g.bias[cb + fr * 4 + e];
      }
    }
    f32x4 h_n[4]; uint2 a_n[4]; float f_n[4][2];
    const float* hrd = g.hin0 ? ((g.rowoff + brow) < MPROMPT ? g.hin0 : g.hin1 - (size_t)MPROMPT * D) : g.h;
#define EPI_LOAD(m_) do { _Pragma("unroll") for (int k = 0; k < 4; ++k) { \
      const int row_ = brow + wr * 128 + (m_) * 16 + k * 4 + fq, col_ = cb + fr * 4; \
      if constexpr (EPI == E_RESID || EPI == E_PLEGATE) h_n[k] = *(const f32x4*)(hrd + (size_t)(g.rowoff + row_) * D + col_); \
      if constexpr (EPI == E_PLEGATE) { a_n[k] = *(const uint2*)(g.o0 + (size_t)(g.rowoff + row_) * D + col_); f_n[k][0] = g.ss_in[g.rowoff + row_]; } \
      } } while (0)
    f32x4 h_m[4]; uint2 a_m[4]; float f_m[4][2];
    EPI_LOAD(0);
#pragma unroll
    for (int k = 0; k < 4; ++k) { h_m[k] = h_n[k]; a_m[k] = a_n[k]; f_m[k][0] = f_n[k][0]; }
    EPI_LOAD(1);
#pragma unroll
    for (int m = 0; m < 8; ++m) {
      f32x4 h_c[4]; uint2 a_c[4]; float f_c[4][2];
#pragma unroll
      for (int k = 0; k < 4; ++k) { h_c[k] = h_m[k]; a_c[k] = a_m[k]; f_c[k][0] = f_m[k][0];
                                    h_m[k] = h_n[k]; a_m[k] = a_n[k]; f_m[k][0] = f_n[k][0]; }
      if (m + 2 < 8) EPI_LOAD(m + 2);
      uint2 fy0[4], fy1[4], fvv[4]; float fbn[4];
      if constexpr (EPI == E_RWFIN) {
#pragma unroll
        for (int k = 0; k < 4; ++k) {
          const int row_ = brow + wr * 128 + m * 16 + k * 4 + fq;
          const size_t idx_ = (size_t)row_ * D + cb + fr * 4;
          fy0[k] = *(const uint2*)(g.o0 + idx_); fy1[k] = *(const uint2*)(g.o1 + idx_); fvv[k] = *(const uint2*)(g.o2 + idx_);
          fbn[k] = g.f0[(size_t)row_ * 16 + (cb >> 6)] + g.f0[(size_t)MR * 16 + (size_t)row_ * 16 + (cb >> 6)];
        }
      }
      SLAB_WRITE(m);
#pragma unroll
      for (int k = 0; k < 4; ++k) {
        const int rl = k * 4 + fq, row = brow + wr * 128 + m * 16 + rl;
        const int col = cb + fr * 4;
        f32x4 v = *(const LDSF4*)(scr + rl * 68 + fr * 4);
        if constexpr (EPI == E_RESID || EPI == E_PLEGATE) {
          size_t grow = (size_t)(g.rowoff + row);
          float* hp = g.h + grow * D + col;
          f32x4 hv = h_c[k];
          if constexpr (EPI == E_PLEGATE) {
            float rs = rstd_of(f_c[k][0]);
            uint2 pb = a_c[k];
            hv[0] += sigm(v[0] * rs) * bf2f((u16)(pb.x & 0xffff));
            hv[1] += sigm(v[1] * rs) * bf2f((u16)(pb.x >> 16));
            hv[2] += sigm(v[2] * rs) * bf2f((u16)(pb.y & 0xffff));
            hv[3] += sigm(v[3] * rs) * bf2f((u16)(pb.y >> 16));
          } else {
#pragma unroll
            for (int e = 0; e < 4; ++e) hv[e] += g.scale * v[e] + bs[e];
          }
          *(f32x4*)hp = hv;
          if (g.hb != nullptr) {
            uint2 pk; pk.x = pack2(hv[0], hv[1]); pk.y = pack2(hv[2], hv[3]);
            *(uint2*)(g.hb + grow * D + col) = pk;
          }
          float sq = rowsum16(hv[0] * hv[0] + hv[1] * hv[1] + hv[2] * hv[2] + hv[3] * hv[3]);
          if (fr == 0) atomicAdd(g.ss_out + grow, sq);
        } else if constexpr (EPI == E_PLEPROJ) {
          uint2 pk; pk.x = pack2(v[0], v[1]); pk.y = pack2(v[2], v[3]);
          *(uint2*)(g.o0 + (size_t)row * D + col) = pk;
        } else if constexpr (EPI == E_RKV) {
          if (cb < 3072) {
            u16* buf = g.o0 + (size_t)(cb >> 10) * ((size_t)MR * 1024);
            uint2 pk; pk.x = pack2(v[0], v[1]); pk.y = pack2(v[2], v[3]);
            *(uint2*)(buf + (size_t)row * D + (cb & 1023) + fr * 4) = pk;
          } else if (cb < 3456) {
            int which = (cb - 3072) >> 7, c0 = (cb - 3072) & 127;
            u16* buf = g.o1 + (size_t)which * ((size_t)MR * 128);
            if (which == 0) { v[0] = tanhf(v[0]); v[1] = tanhf(v[1]); v[2] = tanhf(v[2]); v[3] = tanhf(v[3]); }
            else if (which == 2) { v[0] = sigm(v[0]); v[1] = sigm(v[1]); v[2] = sigm(v[2]); v[3] = sigm(v[3]); }
            uint2 pk; pk.x = pack2(v[0], v[1]); pk.y = pack2(v[2], v[3]);
            *(uint2*)(buf + (size_t)row * 128 + c0 + fr * 4) = pk;
          }
        } else if constexpr (EPI == E_RWFIN) {
          const int head = cb >> 6;
          size_t idx = (size_t)row * D + col;
          uint2 a0 = fy0[k], a1 = fy1[k], vv = fvv[k];
          float y[4];
          y[0] = bf2f((u16)(a0.x & 0xffff)) + bf2f((u16)(a1.x & 0xffff));
          y[1] = bf2f((u16)(a0.x >> 16)) + bf2f((u16)(a1.x >> 16));
          y[2] = bf2f((u16)(a0.y & 0xffff)) + bf2f((u16)(a1.y & 0xffff));
          y[3] = bf2f((u16)(a0.y >> 16)) + bf2f((u16)(a1.y >> 16));
          float mean = rowsum16(y[0] + y[1] + y[2] + y[3]) * (1.f / 64.f);
#pragma unroll
          for (int e = 0; e < 4; ++e) y[e] -= mean;
          float inv = rsqrtf(rowsum16(y[0] * y[0] + y[1] * y[1] + y[2] * y[2] + y[3] * y[3]) * (1.f / 64.f) + 64e-5f);
          float bon = fbn[k];
          float vf[4] = {bf2f((u16)(vv.x & 0xffff)), bf2f((u16)(vv.x >> 16)), bf2f((u16)(vv.y & 0xffff)), bf2f((u16)(vv.y >> 16))};
          float o[4];
#pragma unroll
          for (int e = 0; e < 4; ++e) o[e] = (y[e] * inv * lw[e] + lb[e] + bon * vf[e]) * v[e];
          uint2 pk; pk.x = pack2(o[0], o[1]); pk.y = pack2(o[2], o[3]);
          *(uint2*)(g.hb + idx) = pk;
        }
      }
      SLAB_DONE();
    }
  }
#undef SLAB_WRITE
#undef EPI_LOAD
#undef SLAB_DONE
}

template <int EPI> __device__ __forceinline__ void gemm_phase(const GA& g, const GA& g2, LDSC* shm) {
  const int nM = g.mtiles, nN = g.ntiles;
  const int G = gridDim.x;
  const int PN = (nN & 3) == 0 ? 4 : 2, PM = 32 / PN;
  const int sN = nN / PN, sM = nM / PM, nsup = sN * sM;
  const int per = G >> 8;
  const int b = blockIdx.x, x = b & 7, l = (b >> 3) & 31, rep = b >> 8;
  bool pref = false;
  for (int s = x + 8 * rep; s < nsup; s += 8 * per) {
    int sm = s / sN, sn = s % sN;
    int pm = sm * PM + (l % PM), pn = sn * PN + (l / PM);
    int s2 = s + 8 * per;
    bool hn = s2 < nsup;
    int pm2 = (s2 / sN) * PM + (l % PM), pn2 = (s2 % sN) * PN + (l / PM);
    if constexpr (EPI == E_PLEGATE) {
      gemm_tile<E_PLEPROJ>(g2, pm, pn, false, false, pm, pn, shm);
      gemm_tile<E_PLEGATE>(g, pm, pn, false, false, pm, pn, shm);
    } else {
      gemm_tile<EPI>(g, pm, pn, pref, hn, hn ? pm2 : pm, hn ? pn2 : pn, shm);
      pref = hn;
    }
  }
  __syncthreads();
}

__device__ __forceinline__ void phase_mix(const Params& p, int tok0, int ntok) {
  const float* ss1 = (const float*)(p.ws + OFF_SS) + (size_t)1 * MT;
  const float* gain = p.in[7];
  u16* A2 = (u16*)(p.ws + OFF_BIG + BIG_A2);
  int tid = otid(), half = tid >> 8, c4 = (tid & 255) * 4;
  float4 gn = *(const float4*)(gain + c4);
  for (int l0 = blockIdx.x * 2; l0 < ntok; l0 += gridDim.x * 2) {
    int l = l0 + half, tok = tok0 + l;
    int pos, T;
    if (tok < MPROMPT) { pos = tok & 2047; T = 2048; } else { pos = tok - MPROMPT; T = 16384; }
    float4 c = *(const float4*)(p.h + (size_t)tok * D + c4);
    float rc = rstd_of(ss1[tok]);
    float4 hn = {c.x * rc * gn.x, c.y * rc * gn.y, c.z * rc * gn.z, c.w * rc * gn.w};
    float4 av = {0.f, 0.f, 0.f, 0.f};
    if (pos > 0) {
      float4 q = *(const float4*)(p.h + (size_t)(tok - 1) * D + c4);
      float r = rstd_of(ss1[tok - 1]);
      av.x += q.x * r * gn.x; av.y += q.y * r * gn.y; av.z += q.z * r * gn.z; av.w += q.w * r * gn.w;
    }
    if (pos < T - 1) {
      float4 q = *(const float4*)(p.h + (size_t)(tok + 1) * D + c4);
      float r = rstd_of(ss1[tok + 1]);
      av.x += q.x * r * gn.x; av.y += q.y * r * gn.y; av.z += q.z * r * gn.z; av.w += q.w * r * gn.w;
    }
    uint2 a, b;
    a.x = pack2(hn.x, hn.y); a.y = pack2(hn.z, hn.w);
    b.x = pack2(0.5f * av.x, 0.5f * av.y); b.y = pack2(0.5f * av.z, 0.5f * av.w);
    *(uint2*)(A2 + (size_t)l * 2048 + c4) = a;
    *(uint2*)(A2 + (size_t)l * 2048 + 1024 + c4) = b;
  }
}

constexpr int SC_T = 32;
constexpr int SC_ARR = SC_T * 64 * 4;
constexpr int SC_BUF = 6 * SC_ARR;
template <int E> __device__ __forceinline__ float rowsumL(float v) {
  v += dppf<0xB1>(v); v += dppf<0x4E>(v); v += dppf<0x141>(v);
  if (E == 4) v += dppf<0x140>(v);
  return v;
}

template <int E, int R = 1>
__device__ __forceinline__ void scan_item(const Params& p, int seq_loc0, int T, int head, int z, int rowbase, int nw, char* shm) {
  char* big = p.ws + OFF_BIG;
  const u16* Rb = (const u16*)(big + BIG_RKV);
  const u16* Kb = (const u16*)(big + BIG_RKV + SZ_RKV1);
  const u16* Vb = (const u16*)(big + BIG_RKV + 2 * SZ_RKV1);
  const u16* TW = (const u16*)(big + BIG_T);
  const u16* TA = (const u16*)(big + BIG_T + SZ_T1);
  u16* Y = (u16*)(big + (z ? BIG_Y1 : BIG_Y0));
  float* bonus = (float*)(p.ws + OFF_BONUS) + (size_t)z * MR * 16;
  const u16* W2 = (const u16*)(p.ws + OFF_W2W) + (size_t)z * 1024 * 64;
  const u16* A2w = (const u16*)(p.ws + OFF_W2A) + (size_t)z * 1024 * 64;
  const float* w0 = p.in[14] + z * 1024 + head * 64;
  const float* a0 = p.in[17] + z * 1024 + head * 64;
  const int tid = otid(), wv = tid >> 6, lane = tid & 63, fr = lane & 15, fq = lane >> 4;
  float* Ybuf = (float*)(shm + 2 * SC_BUF);
  const int si = tid >> 4, ec4 = (tid & 15) * 4;
  float4 ckk = *(const float4*)(p.in[22] + head * 64 + ec4);
  float4 cka = *(const float4*)(p.in[23] + head * 64 + ec4);
  float4 crk = *(const float4*)(p.in[24] + head * 64 + ec4);
  const int mt = wv >> 2, ntl = wv & 3;
  bf16x8 Bw[2], Ba[2];
#pragma unroll
  for (int ks = 0; ks < 2; ++ks) {
    Bw[ks] = *(const bf16x8*)(W2 + (size_t)(head * 64 + ntl * 16 + fr) * 64 + ks * 32 + fq * 8);
    Ba[ks] = *(const bf16x8*)(A2w + (size_t)(head * 64 + ntl * 16 + fr) * 64 + ks * 32 + fq * 8);
  }
  const float w0c = w0[ntl * 16 + fr], a0c = a0[ntl * 16 + fr];
  constexpr int LPR = 64 / E, RPW = R * (64 / LPR), NP = E / 2, NQ = E / 4;
  const int le = lane % LPR, row0 = rowbase + wv * RPW + (lane / LPR) * R;
  f32x2 st[R][NP];
#pragma unroll
  for (int r = 0; r < R; ++r)
#pragma unroll
    for (int q = 0; q < NP; ++q) st[r][q] = f32x2{0.f, 0.f};
  float skc = 0.f, sklast = 0.f;
  f32x2 ulast0 = {0.f, 0.f}, ulast1 = {0.f, 0.f};
  f32x4 kalast = {0.f, 0.f, 0.f, 0.f};
  const int nch = T / SC_T;
  uint2 pr, pk, pv; bf16x8 Aw[2], Aa[2];
  auto tok_of = [&](int t) { return seq_loc0 + (z ? (T - 1 - t) : t); };
#define SC_LOAD(c) do { \
    int tk_ = tok_of((c) * SC_T + si); \
    pr = *(const uint2*)(Rb + (size_t)tk_ * D + head * 64 + ec4); \
    pk = *(const uint2*)(Kb + (size_t)tk_ * D + head * 64 + ec4); \
    pv = *(const uint2*)(Vb + (size_t)tk_ * D + head * 64 + ec4); \
    int tm_ = tok_of((c) * SC_T + mt * 16 + fr); \
    _Pragma("unroll") for (int ks = 0; ks < 2; ++ks) { \
      Aw[ks] = *(const bf16x8*)(TW + (size_t)tm_ * 128 + z * 64 + ks * 32 + fq * 8); \
      Aa[ks] = *(const bf16x8*)(TA + (size_t)tm_ * 128 + z * 64 + ks * 32 + fq * 8); } } while (0)
#define SC_LORA(b) do { \
    f32x4 cw = {0.f, 0.f, 0.f, 0.f}, ca = {0.f, 0.f, 0.f, 0.f}; \
    _Pragma("unroll") for (int ks = 0; ks < 2; ++ks) { \
      cw = __builtin_amdgcn_mfma_f32_16x16x32_bf16(Aw[ks], Bw[ks], cw, 0, 0, 0); \
      ca = __builtin_amdgcn_mfma_f32_16x16x32_bf16(Aa[ks], Ba[ks], ca, 0, 0, 0); } \
    float* Wl_ = (float*)(shm + (b) * SC_BUF); float* Al_ = (float*)(shm + (b) * SC_BUF + 3 * SC_ARR); \
    _Pragma("unroll") for (int j = 0; j < 4; ++j) { \
      int st_ = mt * 16 + fq * 4 + j; \
      Wl_[st_ * 64 + ntl * 16 + fr] = __expf(-0.6065306597126334f * sigm(w0c + cw[j])); \
      Al_[st_ * 64 + ntl * 16 + fr] = sigm(a0c + ca[j]); } } while (0)
#define SC_ELEM(b, c) do { \
    char* bb_ = shm + (b) * SC_BUF; \
    float4 a4 = *(const float4*)(bb_ + 3 * SC_ARR + (si * 64 + ec4) * 4); \
    float r0 = bf2f((u16)(pr.x & 0xffff)), r1 = bf2f((u16)(pr.x >> 16)), r2 = bf2f((u16)(pr.y & 0xffff)), r3 = bf2f((u16)(pr.y >> 16)); \
    float k0 = bf2f((u16)(pk.x & 0xffff)), k1 = bf2f((u16)(pk.x >> 16)), k2 = bf2f((u16)(pk.y & 0xffff)), k3 = bf2f((u16)(pk.y >> 16)); \
    float v0 = bf2f((u16)(pv.x & 0xffff)), v1 = bf2f((u16)(pv.x >> 16)), v2 = bf2f((u16)(pv.y & 0xffff)), v3 = bf2f((u16)(pv.y >> 16)); \
    float q0 = k0 * ckk.x, q1 = k1 * ckk.y, q2 = k2 * ckk.z, q3 = k3 * ckk.w; \
    float n2 = rowsum16(q0 * q0 + q1 * q1 + q2 * q2 + q3 * q3); \
    float inv_ = rsqrtf(fmaxf(n2, 1e-24f)); \
    q0 *= inv_; q1 *= inv_; q2 *= inv_; q3 *= inv_; \
    float d0 = k0 * (1.f + (a4.x - 1.f) * cka.x), d1 = k1 * (1.f + (a4.y - 1.f) * cka.y), d2 = k2 * (1.f + (a4.z - 1.f) * cka.z), d3 = k3 * (1.f + (a4.w - 1.f) * cka.w); \
    float bn = rowsum16(r0 * d0 * crk.x + r1 * d1 * crk.y + r2 * d2 * crk.z + r3 * d3 * crk.w); \
    if (rowbase == 0 && (tid & 15) == 0) bonus[(size_t)tok_of((c) * SC_T + si) * 16 + head] = bn; \
    *(float4*)(bb_ + 1 * SC_ARR + (si * 64 + ec4) * 4) = float4{q0, q1, q2, q3}; \
    *(float4*)(bb_ + 2 * SC_ARR + (si * 64 + ec4) * 4) = float4{d0, d1, d2, d3}; \
    *(float4*)(bb_ + 3 * SC_ARR + (si * 64 + ec4) * 4) = float4{q0 * a4.x, q1 * a4.y, q2 * a4.z, q3 * a4.w}; \
    *(float4*)(bb_ + 4 * SC_ARR + (si * 64 + ec4) * 4) = float4{r0, r1, r2, r3}; \
    *(float4*)(bb_ + 5 * SC_ARR + (si * 64 + ec4) * 4) = float4{v0, v1, v2, v3}; } while (0)

  __syncthreads();
  SC_LOAD(0);
  SC_LORA(0);
  __syncthreads();
  SC_ELEM(0, 0);
  __syncthreads();
  for (int c = 0; c < nch; ++c) {
    const int b = c & 1;
    if (c + 1 < nch) SC_LOAD(c + 1);
    const char* bb = shm + b * SC_BUF;
    if (wv < nw) {
      f32x4 cw[NQ], ckq[NQ], ckd[NQ], cka4[NQ], cr[NQ]; float vv[R];
#define SC_LD(i_, W_, KK_, KD_, KA_, R_, V_) do { _Pragma("unroll") for (int q = 0; q < NQ; ++q) { \
        W_[q] = *(const f32x4*)(bb + 0 * SC_ARR + ((i_) * 64 + le * E + q * 4) * 4); \
        KK_[q] = *(const f32x4*)(bb + 1 * SC_ARR + ((i_) * 64 + le * E + q * 4) * 4); \
        KD_[q] = *(const f32x4*)(bb + 2 * SC_ARR + ((i_) * 64 + le * E + q * 4) * 4); \
        KA_[q] = *(const f32x4*)(bb + 3 * SC_ARR + ((i_) * 64 + le * E + q * 4) * 4); \
        R_[q] = *(const f32x4*)(bb + 4 * SC_ARR + ((i_) * 64 + le * E + q * 4) * 4); } \
        _Pragma("unroll") for (int r = 0; r < R; ++r) V_[r] = *(const float*)(bb + 5 * SC_ARR + ((i_) * 64 + row0 + r) * 4); } while (0)
      SC_LD(0, cw, ckq, ckd, cka4, cr, vv);
      f32x4 mw_[NQ], mkq[NQ], mkd[NQ], mka[NQ], mr[NQ]; float mvv[R];
      if constexpr (E == 4) {
        SC_LD(1, mw_, mkq, mkd, mka, mr, mvv);
        f32x2 pu = ulast0 * ckq[0].lo + ulast1 * ckq[0].hi;
        f32x2 pc = kalast.lo * ckq[0].lo + kalast.hi * ckq[0].hi;
        skc = rowsumL<E>(pu.x + pu.y) - sklast * rowsumL<E>(pc.x + pc.y);
      }
#pragma unroll 8
      for (int i = 0; i < SC_T; ++i) {
        f32x4 nw_[NQ], nkq[NQ], nkd[NQ], nka[NQ], nr[NQ]; float nvv[R];
        const int in_ = (i + (E == 4 ? 2 : 1)) & (SC_T - 1);
        SC_LD(in_, nw_, nkq, nkd, nka, nr, nvv);
        float sk[R], yy[R];
        f32x2 uq[R][NP];
        if constexpr (E == 4) {
          f32x2 u0 = st[0][0] * cw[0].lo + ckd[0].lo * vv[0];
          f32x2 u1 = st[0][1] * cw[0].hi + ckd[0].hi * vv[0];
          st[0][0] = u0 - cka4[0].lo * skc;
          st[0][1] = u1 - cka4[0].hi * skc;
          f32x2 pu = u0 * mkq[0].lo + u1 * mkq[0].hi;
          f32x2 pc = cka4[0].lo * mkq[0].lo + cka4[0].hi * mkq[0].hi;
          const float rr_ = rowsumL<E>(pu.x + pu.y), cc_ = rowsumL<E>(pc.x + pc.y);
          ulast0 = u0; ulast1 = u1; kalast = cka4[0]; sklast = skc;
          skc = rr_ - skc * cc_;
          f32x2 ya = st[0][0] * cr[0].lo + st[0][1] * cr[0].hi;
          yy[0] = ya.x + ya.y;
        } else {
#pragma unroll
        for (int r = 0; r < R; ++r) {
          f32x2 da = st[r][0] * ckq[0].lo;
#pragma unroll
          for (int q = 1; q < NP; ++q) da += st[r][q] * ((q & 1) ? ckq[q >> 1].hi : ckq[q >> 1].lo);
#pragma unroll
          for (int q = 0; q < NP; ++q) {
            f32x2 kdq = (q & 1) ? ckd[q >> 1].hi : ckd[q >> 1].lo;
            f32x2 wq = (q & 1) ? cw[q >> 1].hi : cw[q >> 1].lo;
            uq[r][q] = st[r][q] * wq + kdq * vv[r];
          }
          sk[r] = da.x + da.y;
        }
#pragma unroll
        for (int r = 0; r < R; ++r) sk[r] = rowsumL<E>(sk[r]);
#pragma unroll
        for (int r = 0; r < R; ++r) {
#pragma unroll
          for (int q = 0; q < NP; ++q) {
            f32x2 kaq = (q & 1) ? cka4[q >> 1].hi : cka4[q >> 1].lo;
            st[r][q] = uq[r][q] - kaq * sk[r];
          }
          f32x2 ya = st[r][0] * cr[0].lo;
#pragma unroll
          for (int q = 1; q < NP; ++q) ya += st[r][q] * ((q & 1) ? cr[q >> 1].hi : cr[q >> 1].lo);
          yy[r] = ya.x + ya.y;
        }
        }
#pragma unroll
        for (int r = 0; r < R; ++r) yy[r] = rowsumL<E>(yy[r]);
        if (le == 0) {
#pragma unroll
          for (int r = 0; r < R; ++r) Ybuf[i * 64 + row0 + r] = yy[r];
        }
        if constexpr (E == 4) {
#pragma unroll
          for (int q = 0; q < NQ; ++q) { cw[q] = mw_[q]; ckq[q] = mkq[q]; ckd[q] = mkd[q]; cka4[q] = mka[q]; cr[q] = mr[q];
                                         mw_[q] = nw_[q]; mkq[q] = nkq[q]; mkd[q] = nkd[q]; mka[q] = nka[q]; mr[q] = nr[q]; }
#pragma unroll
          for (int r = 0; r < R; ++r) { vv[r] = mvv[r]; mvv[r] = nvv[r]; }
        } else {
#pragma unroll
          for (int q = 0; q < NQ; ++q) { cw[q] = nw_[q]; ckq[q] = nkq[q]; ckd[q] = nkd[q]; cka4[q] = nka[q]; cr[q] = nr[q]; }
#pragma unroll
          for (int r = 0; r < R; ++r) vv[r] = nvv[r];
        }
      }
#undef SC_LD
    }
    if (c + 1 < nch) SC_LORA(b ^ 1);
    __syncthreads();
    if (c + 1 < nch) SC_ELEM(b ^ 1, c + 1);
    {
      int tk = tok_of(c * SC_T + si);
      int rr = (tid & 15) * 4;
      if (rr >= rowbase && rr < rowbase + nw * RPW) {
        float4 yv = *(const float4*)(Ybuf + si * 64 + rr);
        uint2 pk2; pk2.x = pack2(yv.x, yv.y); pk2.y = pack2(yv.z, yv.w);
        *(uint2*)(Y + (size_t)tk * D + head * 64 + rr) = pk2;
      }
    }
    __syncthreads();
  }
#undef SC_LOAD
#undef SC_LORA
#undef SC_ELEM
}

__device__ __forceinline__ void phase_scan(const Params& p, char* shm) {
  const int G = gridDim.x, b = blockIdx.x;
  const int nS = 128, nP = 16 * 32;
  int j, step;
  if (G > nS) { if (b < nS) { j = b; step = 1 << 30; } else { j = nS + (b - nS); step = G - nS; } }
  else { j = b; step = G; }
  for (; j < nS + nP; j += step) {
    if (j < nS) scan_item<4>(p, MPROMPT, 16384, (j >> 3) & 15, (j >> 2) & 1, (j & 3) * 16, 4, shm);
    else { int q = j - nS; scan_item<8, 2>(p, (q >> 5) * 2048, 2048, (q >> 1) & 15, q & 1, 0, 4, shm); }
  }
  __syncthreads();
  if (G > nS) { if (b >= nS) { prep_weights(p, shm, false, G - nS, b - nS); conv_p(p, 0, G - nS, b - nS); conv_p(p, 1, G - nS, b - nS); } }
  else { prep_weights(p, shm, false, G, b); conv_p(p, 0, G, b); conv_p(p, 1, G, b); }
}

__device__ __forceinline__ void phase_natt(const Params& p, u16* Odst, char* shm) {
  char* big = p.ws + OFF_BIG;
  const u16* Q = (const u16*)(big + BIG_Q);
  const u16* Kb = (const u16*)(big + BIG_K);
  const u16* Vt = (const u16*)(big + BIG_VT);
  const int tid = otid(), wv = tid >> 6, lane = tid & 63, fr = lane & 15, fq = lane >> 4;
  const int hg = blockIdx.x & 3, h = hg * 8 + wv;
  float* tab = (float*)(shm + wv * 3840);
  {
    const float* rp = p.in[30] + (size_t)h * 15 * 31;
    for (int idx = lane; idx < 960; idx += 64) tab[idx] = 0.f;
    asm volatile("s_waitcnt lgkmcnt(0)" ::: "memory");
    for (int idx = lane; idx < 465; idx += 64) { int r = idx / 31, c = idx - r * 31; tab[r * 64 + 16 + c] = rp[idx]; }
    asm volatile("s_waitcnt lgkmcnt(0)" ::: "memory");
  }
  const int nqb = MT / 16, qstep = gridDim.x >> 2;
  for (int qb = blockIdx.x >> 2; qb < nqb; qb += qstep) {
    int tb = qb * 16;
    int seqbase, T, loc;
    if (tb < MPROMPT) { seqbase = tb & ~2047; T = 2048; loc = tb & 2047; } else { seqbase = MPROMPT; T = 16384; loc = tb - MPROMPT; }
    int rows = T >> 6, i = loc >> 6, cbq = (loc & 63) >> 4;
    int rs = min(max(i - 4, 0), rows - 8);
    int kvs = min(max(cbq * 16 - 8, 0), 32);
    int qc = cbq * 16 + fr;
    int ws_ = min(max(qc - 8, 0), 48);
    bf16x8 qf = *(const bf16x8*)(Q + (size_t)(tb + fr) * D + h * 32 + fq * 8);
    unsigned vm = 0;
#pragma unroll
    for (int e = 0; e < 8; ++e) { int kcol = kvs + fq * 8 + e; vm |= ((kcol >= ws_) && (kcol < ws_ + 16)) ? (1u << e) : 0u; }
    const float* trow = tab + (rs - i + 7) * 64 + 16 + (kvs + fq * 8 - qc + 15);
    bf16x8 kf[8][2];
#pragma unroll
    for (int r = 0; r < 8; ++r)
#pragma unroll
      for (int hb2 = 0; hb2 < 2; ++hb2) {
        int kcolA = kvs + (fr >> 2) * 8 + hb2 * 4 + (fr & 3);
        size_t ktok = (size_t)seqbase + (size_t)(rs + r) * 64 + kcolA;
        kf[r][hb2] = *(const bf16x8*)(Kb + ktok * D + h * 32 + fq * 8);
      }
    f32x4 sc[8][2];
    float mx = -1e30f;
#pragma unroll
    for (int r = 0; r < 8; ++r) {
#pragma unroll
      for (int hb2 = 0; hb2 < 2; ++hb2) {
        f32x4 a = __builtin_amdgcn_mfma_f32_16x16x32_bf16(kf[r][hb2], qf, f32x4{0.f, 0.f, 0.f, 0.f}, 0, 0, 0);
#pragma unroll
        for (int j = 0; j < 4; ++j) {
          float sv = ((vm >> (hb2 * 4 + j)) & 1u) ? a[j] + trow[r * 64 + hb2 * 4 + j] : -1e30f;
          a[j] = sv; mx = fmaxf(mx, sv);
        }
        sc[r][hb2] = a;
      }
    }
    mx = fmaxf(mx, __shfl_xor(mx, 16));
    mx = fmaxf(mx, __shfl_xor(mx, 32));
    float sum = 0.f;
    f32x4 o0 = {0.f, 0.f, 0.f, 0.f}, o1 = {0.f, 0.f, 0.f, 0.f};
#pragma unroll
    for (int r = 0; r < 8; ++r) {
      bf16x8 pf;
#pragma unroll
      for (int e = 0; e < 8; ++e) {
        float pe = __expf(sc[r][e >> 2][e & 3] - mx);
        sum += pe;
        pf[e] = (short)f2bf(pe);
      }
      size_t vbase = (size_t)seqbase + (size_t)(rs + r) * 64 + kvs + fq * 8;
      bf16x8 v0 = *(const bf16x8*)(Vt + (size_t)(h * 32 + fr) * MT + vbase);
      bf16x8 v1 = *(const bf16x8*)(Vt + (size_t)(h * 32 + 16 + fr) * MT + vbase);
      o0 = __builtin_amdgcn_mfma_f32_16x16x32_bf16(v0, pf, o0, 0, 0, 0);
      o1 = __builtin_amdgcn_mfma_f32_16x16x32_bf16(v1, pf, o1, 0, 0, 0);
    }
    sum += __shfl_xor(sum, 16);
    sum += __shfl_xor(sum, 32);
    float inv = 1.f / sum;
    uint2 w0, w1;
    w0.x = pack2(o0[0] * inv, o0[1] * inv); w0.y = pack2(o0[2] * inv, o0[3] * inv);
    w1.x = pack2(o1[0] * inv, o1[1] * inv); w1.y = pack2(o1[2] * inv, o1[3] * inv);
    *(uint2*)(Odst + (size_t)(tb + fr) * D + h * 32 + fq * 4) = w0;
    *(uint2*)(Odst + (size_t)(tb + fr) * D + h * 32 + 16 + fq * 4) = w1;
  }
}

__device__ __forceinline__ void phase_final(const Params& p) {
  const float* ss8 = (const float*)(p.ws + OFF_SS) + (size_t)8 * MT;
  const float* gain = p.in[11];
  int tid = otid(), half = tid >> 8, c4 = (tid & 255) * 4;
  float4 gn = *(const float4*)(gain + c4);
  for (int r0 = blockIdx.x * 2; r0 < MT; r0 += gridDim.x * 2) {
    int row = r0 + half;
    float rs = rstd_of(ss8[row]);
    float4 v = *(float4*)(p.h + (size_t)row * D + c4);
    v.x *= rs * gn.x; v.y *= rs * gn.y; v.z *= rs * gn.z; v.w *= rs * gn.w;
    *(float4*)(p.h + (size_t)row * D + c4) = v;
  }
}

constexpr int NPHASE = 20;
#ifndef PROBE_MASK
#define PROBE_MASK 0ull
#endif

enum { K_NONE = 0, K_PREP, K_FFN1, K_FFN2, K_MIX, K_RKV, K_SCAN, K_FIN, K_RWO, K_PPROJ, K_PGATE, K_CONVH, K_QKV, K_NATT, K_NAO, K_FINAL };

__device__ __forceinline__ void run_phase(const Params& p, int ph, LDSC* shml) {
  char* shm = (char*)shml;
  char* ws = p.ws;
  float* ss = (float*)(ws + OFF_SS);
  u16* hb = (u16*)(ws + OFF_HB);
  char* big = ws + OFF_BIG;
  int kind = K_NONE, a = 0, b = 0, c = 0, d = 0;
  switch (ph) {
    case 0: kind = K_PREP; break;
    case 1: kind = K_FFN1; a = 0; b = 0; c = 0; d = 0; break;
    case 2: kind = K_FFN2; a = 0; b = 0; c = 1; break;
    case 3: kind = K_MIX; break;
    case 4: kind = K_RKV; break;
    case 5: kind = K_SCAN; break;
    case 6: kind = K_FIN; break;
    case 7: kind = K_RWO; break;
    case 8: kind = K_FFN1; a = 0; b = 1; c = 2; d = 1; break;
    case 9: kind = K_FFN2; a = 0; b = 1; c = 3; break;
    case 10: kind = K_PGATE; a = 0; b = 3; c = 4; break;
    case 11: kind = K_FFN1; a = 1; b = 0; c = 4; d = 0; break;
    case 12: kind = K_FFN2; a = 1; b = 0; c = 5; break;
    case 13: kind = K_QKV; break;
    case 14: kind = K_NATT; break;
    case 15: kind = K_NAO; break;
    case 16: kind = K_FFN1; a = 1; b = 1; c = 6; d = 1; break;
    case 17: kind = K_FFN2; a = 1; b = 1; c = 7; break;
    case 18: kind = K_PGATE; a = 1; b = 7; c = 8; break;
    case 19: kind = K_FINAL; break;
    default: break;
  }
  GA g;
  g.A = nullptr; g.Bt = nullptr; g.K = 0; g.N = 0; g.mtiles = 0; g.ntiles = 0; g.rowoff = 0;
  g.ss_in = nullptr; g.ss_out = nullptr; g.bias = nullptr; g.scale = 1.f; g.h = p.h; g.hb = hb;
  g.o0 = nullptr; g.o1 = nullptr; g.o2 = nullptr; g.f0 = nullptr; g.f1 = nullptr; g.f2 = nullptr;
  g.hin0 = nullptr; g.hin1 = nullptr;
  GA g2 = g;
  int epi = -1;
  const int tok0 = 0, ntok = MT;
  switch (kind) {
    case K_PREP: phase_prep(p, shm); break;
    case K_FFN1:
      g.A = (a == 1 && b == 0) ? (const u16*)(big + BIG_HBALT) : hb;
      g.Bt = (const u16*)(ws + OFF_WIN + (size_t)(a * 2 + b) * SZ_WIN); g.K = 1024; g.N = 5632;
      g.mtiles = MT / 256; g.ntiles = 22; g.ss_in = ss + (size_t)c * MT; g.o0 = (u16*)(big + BIG_ACTB);
      epi = E_SWIGLU; break;
    case K_FFN2:
      g.A = (const u16*)(big + BIG_ACTB); g.Bt = (const u16*)(ws + OFF_WOUT + (size_t)(a * 2 + b) * SZ_WOUT); g.K = DFF; g.N = 1024;
      g.mtiles = MT / 256; g.ntiles = 4; g.ss_out = ss + (size_t)c * MT; g.scale = 0.5f;
      if (a == 0 && b == 0) { g.hb = nullptr; g.hin0 = p.in[0]; g.hin1 = p.in[1]; }
      epi = E_RESID; break;
    case K_MIX: phase_mix(p, tok0, ntok); break;
    case K_RKV:
      g.A = (const u16*)(big + BIG_A2); g.Bt = (const u16*)(ws + OFF_WRKV); g.K = 2048; g.N = 3456;
      g.mtiles = ntok / 256; g.ntiles = 14; g.o0 = (u16*)(big + BIG_RKV); g.o1 = (u16*)(big + BIG_T);
      epi = E_RKV; break;
    case K_SCAN: phase_scan(p, shm); break;
    case K_FIN:
      g.A = (const u16*)(big + BIG_T + 2 * SZ_T1); g.Bt = (const u16*)(ws + OFF_WG2); g.K = 128; g.N = 1024;
      g.mtiles = ntok / 256; g.ntiles = 4;
      g.o0 = (u16*)(big + BIG_Y0); g.o1 = (u16*)(big + BIG_Y1); g.o2 = (u16*)(big + BIG_RKV + 2 * SZ_RKV1);
      g.hb = (u16*)(big + BIG_RKV + SZ_RKV1);
      g.f0 = (const float*)(ws + OFF_BONUS); g.f1 = p.in[25]; g.f2 = p.in[26];
      epi = E_RWFIN; break;
    case K_RWO:
      g.A = (const u16*)(big + BIG_RKV + SZ_RKV1); g.Bt = (const u16*)(ws + OFF_WRWO); g.K = 1024; g.N = 1024;
      g.mtiles = ntok / 256; g.ntiles = 4; g.rowoff = tok0; g.ss_out = ss + (size_t)2 * MT; g.scale = 1.f;
      epi = E_RESID; break;
    case K_PGATE:
      g2 = g;
      g2.A = (const u16*)(ws + OFF_PBI) + (size_t)a * MT * 256; g2.Bt = (const u16*)(ws + OFF_WPP) + (size_t)a * 1024 * 256; g2.K = 256; g2.N = 1024;
      g2.mtiles = MT / 256; g2.ntiles = 4; g2.o0 = (u16*)(big + BIG_PB);
      g.hb = a == 0 ? (u16*)(big + BIG_HBALT) : nullptr;
      g.A = hb; g.Bt = (const u16*)(ws + OFF_WPG) + (size_t)a * 1024 * 1024; g.K = 1024; g.N = 1024;
      g.mtiles = MT / 256; g.ntiles = 4; g.ss_in = ss + (size_t)b * MT; g.ss_out = ss + (size_t)c * MT; g.o0 = (u16*)(big + BIG_PB);
      epi = E_PLEGATE; break;
    case K_QKV:
      g.A = hb; g.Bt = (const u16*)(ws + OFF_WQKV); g.K = 1024; g.N = 3072; g.mtiles = MT / 256; g.ntiles = 12;
      g.ss_in = ss + (size_t)5 * MT; g.bias = p.in[29];
      g.o0 = (u16*)(big + BIG_Q); g.o1 = (u16*)(big + BIG_K); g.o2 = (u16*)(big + BIG_VT);
      epi = E_QKV; break;
    case K_NATT:
#ifdef PROBE_NATT
      phase_natt(p, hb, shm); __syncthreads();
#endif
      phase_natt(p, (u16*)(big + BIG_Q), shm); break;
    case K_NAO:
      g.A = (const u16*)(big + BIG_Q); g.Bt = (const u16*)(ws + OFF_WNAO); g.K = 1024; g.N = 1024; g.mtiles = MT / 256; g.ntiles = 4;
      g.ss_out = ss + (size_t)6 * MT; g.bias = p.in[32]; g.scale = 1.f;
      epi = E_RESID; break;
    case K_FINAL: phase_final(p); break;
    default: break;
  }
  switch (epi) {
    case E_SWIGLU: gemm_phase<E_SWIGLU>(g, g2, shml); break;
    case E_RESID: gemm_phase<E_RESID>(g, g2, shml); break;
    case E_PLEGATE: gemm_phase<E_PLEGATE>(g, g2, shml); break;
    case E_RKV: gemm_phase<E_RKV>(g, g2, shml); break;
    case E_RWFIN: gemm_phase<E_RWFIN>(g, g2, shml); break;
    case E_QKV: gemm_phase<E_QKV>(g, g2, shml); break;
    default: break;
  }
}

__device__ __forceinline__ void grid_barrier(unsigned* bar, unsigned& nbar) {
  asm volatile("s_waitcnt vmcnt(0)" ::: "memory");
  __syncthreads();
  nbar += 1;
  if (otid() == 0) {
    __builtin_amdgcn_s_waitcnt(0);
    __builtin_amdgcn_fence(__ATOMIC_RELEASE, "agent");
    asm volatile("s_waitcnt vmcnt(0)" ::: "memory");
    __hip_atomic_fetch_add(bar, 1u, __ATOMIC_RELAXED, __HIP_MEMORY_SCOPE_AGENT);
    const unsigned target = nbar * gridDim.x;
    while (__hip_atomic_load(bar, __ATOMIC_RELAXED, __HIP_MEMORY_SCOPE_AGENT) < target) __builtin_amdgcn_s_sleep(1);
    __builtin_amdgcn_fence(__ATOMIC_ACQUIRE, "agent");
    asm volatile("s_waitcnt vmcnt(0)" ::: "memory");
  }
  __syncthreads();
}

__global__ void __launch_bounds__(NTHR, 2) fwd_megakernel(Params p, int ph_lo, int ph_hi) {
  __shared__ __attribute__((aligned(1024))) char shm[131072];
  cg::grid_group grid = cg::this_grid();
  unsigned* bar = (unsigned*)(p.ws + OFF_BAR);
  if (blockIdx.x == 0 && otid() == 0) __hip_atomic_store(bar, 0u, __ATOMIC_RELAXED, __HIP_MEMORY_SCOPE_AGENT);
  unsigned nbar = 0;
  for (int ph = ph_lo; ph < ph_hi; ++ph) {
#if PROBE_MASK
    if ((PROBE_MASK >> ph) & 1ull) { run_phase(p, ph, (LDSC*)shm); if (ph == ph_lo) grid.sync(); else grid_barrier(bar, nbar); }
#endif
    run_phase(p, ph, (LDSC*)shm);
    if (ph + 1 < ph_hi) {
      if (ph == ph_lo) grid.sync(); else grid_barrier(bar, nbar);
    }
  }
}

extern "C" void kernel_launch(void* const* d_in, const int* in_sizes, int n_in, void* d_out, int out_size, void* d_ws, size_t ws_size,
                              hipStream_t stream) {
  static int grid_blocks = 0;
  if (!grid_blocks) {
    int dev = 0, cus = 0, per_cu = 0;
    hipGetDevice(&dev);
    hipDeviceGetAttribute(&cus, hipDeviceAttributeMultiprocessorCount, dev);
    hipOccupancyMaxActiveBlocksPerMultiprocessor(&per_cu, fwd_megakernel, NTHR, 0);
    (void)per_cu;
    grid_blocks = 256;
    if (cus < 256) { fprintf(stderr, "device has %d CUs, this kernel needs 256\n", cus); grid_blocks = -1; }
  }
  if (grid_blocks < 0) return;
  if (ws_size < OFF_BIG + BIG_T + 3 * SZ_T1) return;
  Params p{};
  for (int i = 0; i < 33; ++i) p.in[i] = (const float*)d_in[i];
  p.h = (float*)d_out;
  p.ws = (char*)d_ws;
  int lo = 0, hi = NPHASE;
  void* args[] = {&p, &lo, &hi};
  hipError_t e = hipLaunchCooperativeKernel((void*)fwd_megakernel, dim3(grid_blocks), dim3(NTHR), args, 0, stream);
  if (e != hipSuccess) fprintf(stderr, "cooperative launch failed: %s (grid %d)\n", hipGetErrorString(e), grid_blocks);
}
```
